# Optimizing an MI355X kernel written in HIP

```python
import math
import jax
import jax.numpy as jnp
from jax import lax
import numpy as np

D_MODEL = 1024
BATCH = 8
SEQ = 4096
DEPTH = 2

GRID_W = 64
CTX_LEN = 256
HEAD_DIM = 64
NA_HEADS = D_MODEL // 4 // HEAD_DIM
NA_WIN_ROWS = 8
NA_WIN_COLS = 16
DA_QK_DIM = 32
DA_V_DIM = 2 * DA_QK_DIM
DA_HEADS = D_MODEL // 4 // DA_V_DIM
GLA_DV = 128
GLA_DK = GLA_DV // 2
GLA_HEADS = D_MODEL // 2 // GLA_DV
GLA_GATE_RANK = 16
GLA_GATE_NORM = 16.0
GLA_CHUNK = 64
FFN_DIM = ((8 * D_MODEL) // 3 + 127) // 128 * 128
CONV_W = 3
Q_BLOCK = 128
ROPE_THETA = 10000.0
EPS = 1e-6
NEG_INF = -1e30
F32 = jnp.float32

NA_W = NA_HEADS * HEAD_DIM
DA_QK_W = DA_HEADS * 2 * DA_QK_DIM
DA_V_W = DA_HEADS * DA_V_DIM
GLA_K_W = GLA_HEADS * GLA_DK
GLA_V_W = GLA_HEADS * GLA_DV
IN_SIZES = (('qa', NA_W), ('ka', NA_W), ('va', NA_W),
            ('qb', DA_QK_W), ('kb', DA_QK_W), ('vb', DA_V_W),
            ('qc', GLA_K_W), ('kc', GLA_K_W), ('vc', GLA_V_W), ('gc', GLA_V_W),
            ('af', GLA_GATE_RANK), ('ab', GLA_GATE_RANK))
IN_W = 3 * NA_W + 2 * DA_QK_W + DA_V_W + 2 * GLA_K_W + 2 * GLA_V_W + 2 * GLA_GATE_RANK
MIX_W = NA_W + DA_V_W + GLA_V_W

kernel_name = 'hybrid_na_diff_gla_prefix_dit'


def rms_norm(x, g):
    xf = x.astype(F32)
    y = xf * lax.rsqrt(jnp.mean(xf * xf, axis=-1, keepdims=True) + EPS)
    return (y * g.astype(F32)).astype(x.dtype)


def _heads(a, n, d):
    b, t, _ = a.shape
    return a.reshape(b, t, n, d).transpose(0, 2, 1, 3)


def _diff_heads(a):
    b, t, _ = a.shape
    return a.reshape(b, t, DA_HEADS, 2, DA_QK_DIM).transpose(0, 2, 3, 1, 4)


def _merge_heads(a):
    b, h, t, d = a.shape
    return a.transpose(0, 2, 1, 3).reshape(b, t, h * d)


def _split_in(p):
    out = {}
    o = 0
    for name, size in IN_SIZES:
        out[name] = p[..., o:o + size]
        o += size
    return out


def _flip(a):
    return jnp.flip(a, axis=2)


def rope_2d(x, row, col):
    half = x.shape[-1] // 2
    nf = half // 2
    inv = ROPE_THETA ** (-jnp.arange(nf, dtype=F32) / nf)

    def rot(xp, pos):
        ang = pos.astype(F32)[:, None] * inv[None, :]
        cos, sin = jnp.cos(ang), jnp.sin(ang)
        x1 = xp[..., :nf].astype(F32)
        x2 = xp[..., nf:].astype(F32)
        return jnp.concatenate([x1 * cos - x2 * sin, x2 * cos + x1 * sin], axis=-1)

    return jnp.concatenate([rot(x[..., :half], row), rot(x[..., half:], col)], axis=-1).astype(x.dtype)


def dense_attention(q, k, v):
    s = jnp.einsum('bhqd,bhkd->bhqk', q, k).astype(F32) * (q.shape[-1] ** -0.5)
    p = jax.nn.softmax(s, axis=-1).astype(v.dtype)
    return jnp.einsum('bhqk,bhkd->bhqd', p, v)


def neighborhood_attention(q, k, v, k_ctx, v_ctx, rpb):
    bn, h, s_len, dh = q.shape
    rows = s_len // GRID_W
    kr = min(NA_WIN_ROWS, rows)
    kc = NA_WIN_COLS
    scale = dh ** -0.5
    qg = q.reshape(bn, h, rows, GRID_W, dh)
    kg = k.reshape(bn, h, rows, GRID_W, dh)
    vg = v.reshape(bn, h, rows, GRID_W, dh)
    r = jnp.arange(rows)
    r0 = jnp.clip(r - kr // 2, 0, rows - kr)
    row_idx = r0[:, None] + jnp.arange(kr)[None, :]
    k_rows = jnp.take(kg, row_idx, axis=2)
    v_rows = jnp.take(vg, row_idx, axis=2)
    w = jnp.arange(GRID_W)
    c0 = jnp.clip(w - kc // 2, 0, GRID_W - kc)
    valid = (w[None, :] >= c0[:, None]) & (w[None, :] < c0[:, None] + kc)
    col_off = w[None, :] - w[:, None]
    ro = (row_idx - r[:, None]) + NA_WIN_ROWS - 1
    co = jnp.clip(col_off, -(NA_WIN_COLS - 1), NA_WIN_COLS - 1) + NA_WIN_COLS - 1
    bias = rpb[:, ro[:, None, :, None], co[None, :, None, :]].astype(F32)
    bias = jnp.where(valid[None, None, :, None, :], bias, NEG_INF)
    s_win = jnp.einsum('bhrwd,bhricd->bhrwic', qg, k_rows).astype(F32) * scale + bias[None]
    s_ctx = jnp.einsum('bhrwd,bhld->bhrwl', qg, k_ctx).astype(F32) * scale
    n_win = kr * GRID_W
    s_all = jnp.concatenate([s_win.reshape(bn, h, rows, GRID_W, n_win), s_ctx], axis=-1)
    p = jax.nn.softmax(s_all, axis=-1).astype(v.dtype)
    p_win = p[..., :n_win].reshape(bn, h, rows, GRID_W, kr, GRID_W)
    p_ctx = p[..., n_win:]
    o = (jnp.einsum('bhrwic,bhricd->bhrwd', p_win, v_rows)
         + jnp.einsum('bhrwl,bhld->bhrwd', p_ctx, v_ctx))
    return o.reshape(bn, h, s_len, dh)


def diff_weights(q, k, lam):
    s = jnp.einsum('bhcqd,bhckd->bhcqk', q, k).astype(F32) * (q.shape[-1] ** -0.5)
    p = jax.nn.softmax(s, axis=-1)
    return p[:, :, 0] - lam * p[:, :, 1]


def diff_attention_latent(q, k_all, v_all, lam):
    bn, h, _, s_len, d = q.shape
    nb = s_len // Q_BLOCK
    qb = q.reshape(bn, h, 2, nb, Q_BLOCK, d).transpose(3, 0, 1, 2, 4, 5)

    def block(qi):
        wts = diff_weights(qi, k_all, lam).astype(v_all.dtype)
        return jnp.einsum('bhqk,bhkv->bhqv', wts, v_all)

    o = lax.map(block, qb)
    return o.transpose(1, 2, 0, 3, 4).reshape(bn, h, s_len, v_all.shape[-1])


def gla_scan(q, k, v, g, s0):
    bn, h, t_len, dk = q.shape
    n = t_len // GLA_CHUNK
    tri = jnp.tril(jnp.ones((GLA_CHUNK, GLA_CHUNK), dtype=bool))

    def chunks(a):
        return a.reshape(bn, h, n, GLA_CHUNK, a.shape[-1]).transpose(2, 0, 1, 3, 4)

    def step(state, inp):
        qc, kc, vc, gc = inp
        b = jnp.cumsum(gc, axis=2)
        b_last = b[:, :, -1:, :]
        dec = jnp.where(tri[None, None, :, :, None], b[:, :, :, None, :] - b[:, :, None, :, :], -jnp.inf)
        attn = jnp.einsum('bhtd,bhsd,bhtsd->bhts', qc, kc, jnp.exp(dec))
        o = (jnp.einsum('bhts,bhsv->bhtv', attn, vc)
             + jnp.einsum('bhtd,bhdv->bhtv', qc * jnp.exp(b), state))
        state = (jnp.exp(b_last[:, :, 0, :])[..., None] * state
                 + jnp.einsum('bhsd,bhsv->bhdv', kc * jnp.exp(b_last - b), vc))
        return state, o

    s_fin, o = lax.scan(step, s0, (chunks(q), chunks(k), chunks(v), chunks(g)))
    return o.transpose(1, 2, 0, 3, 4).reshape(bn, h, t_len, v.shape[-1]), s_fin


def _gla_inputs(pp, lp):
    q = _heads(pp['qc'], GLA_HEADS, GLA_DK).astype(F32) * (GLA_DK ** -0.5)
    k = _heads(pp['kc'], GLA_HEADS, GLA_DK).astype(F32)
    v = _heads(pp['vc'], GLA_HEADS, GLA_DV).astype(F32)
    gf = jax.nn.log_sigmoid((pp['af'] @ lp['w_a2_f'] + lp['b_a_f']).astype(F32)) / GLA_GATE_NORM
    gb = jax.nn.log_sigmoid((pp['ab'] @ lp['w_a2_b'] + lp['b_a_b']).astype(F32)) / GLA_GATE_NORM
    return q, k, v, _heads(gf, GLA_HEADS, GLA_DK), _heads(gb, GLA_HEADS, GLA_DK)


def _gla_out(o, gate, g_norm):
    o = rms_norm(o.astype(gate.dtype), g_norm)
    return o * jax.nn.silu(_heads(gate, GLA_HEADS, GLA_DV))


def conv_ffn(xn, w_g, w_u, conv_w, conv_b, w_d):
    t_len = xn.shape[1]
    a = xn @ w_g
    ap = jnp.pad(a, ((0, 0), (CONV_W // 2, CONV_W // 2), (0, 0)))
    a = conv_b + sum(ap[:, j:j + t_len] * conv_w[j] for j in range(CONV_W))
    return (jax.nn.silu(a) * (xn @ w_u)) @ w_d


def _mixer(xn, xn_c, lp, lam_init, with_ctx_out):
    bn, s_len, _ = xn.shape
    t = jnp.arange(s_len)
    row, col = t // GRID_W, t % GRID_W
    pl = _split_in(xn @ lp['w_in'])
    pc = _split_in(xn_c @ lp['w_in'])

    qa = rms_norm(_heads(pl['qa'], NA_HEADS, HEAD_DIM), lp['qn_a'])
    ka = rms_norm(_heads(pl['ka'], NA_HEADS, HEAD_DIM), lp['kn_a'])
    va = _heads(pl['va'], NA_HEADS, HEAD_DIM)
    ka_c = rms_norm(_heads(pc['ka'], NA_HEADS, HEAD_DIM), lp['kn_a'])
    va_c = _heads(pc['va'], NA_HEADS, HEAD_DIM)
    o_a = neighborhood_attention(qa, ka, va, ka_c, va_c, lp['rpb_a'])

    lam = (jnp.exp(jnp.sum((lp['lam_q1'] * lp['lam_k1']).astype(F32)))
           - jnp.exp(jnp.sum((lp['lam_q2'] * lp['lam_k2']).astype(F32))) + lam_init)
    qb = rope_2d(rms_norm(_diff_heads(pl['qb']), lp['qn_b']), row, col)
    kb = rope_2d(rms_norm(_diff_heads(pl['kb']), lp['kn_b']), row, col)
    vb = _heads(pl['vb'], DA_HEADS, DA_V_DIM)
    kb_c = rms_norm(_diff_heads(pc['kb']), lp['kn_b'])
    vb_c = _heads(pc['vb'], DA_HEADS, DA_V_DIM)
    o_b = diff_attention_latent(qb, jnp.concatenate([kb, kb_c], axis=3),
                                jnp.concatenate([vb, vb_c], axis=2), lam)
    o_b = rms_norm(o_b, lp['subln_b']) * (1.0 - lam_init)

    qc, kc, vc, gf, gb = _gla_inputs(pl, lp)
    qc_c, kc_c, vc_c, gf_c, gb_c = _gla_inputs(pc, lp)
    s0 = jnp.zeros((bn, GLA_HEADS, GLA_DK, GLA_DV), F32)
    o_cf, s_f = gla_scan(qc_c, kc_c, vc_c, gf_c, s0)
    o_cb, s_b = gla_scan(_flip(qc_c), _flip(kc_c), _flip(vc_c), _flip(gb_c), s0)
    o_lf, _ = gla_scan(qc, kc, vc, gf, s_f)
    o_lb, _ = gla_scan(_flip(qc), _flip(kc), _flip(vc), _flip(gb), s_b)
    o_c = _gla_out(o_lf + _flip(o_lb), pl['gc'], lp['onorm_c'])

    y = jnp.concatenate([_merge_heads(o_a), _merge_heads(o_b), _merge_heads(o_c)], axis=-1) @ lp['w_out']
    if not with_ctx_out:
        return y, None

    qa_c = rms_norm(_heads(pc['qa'], NA_HEADS, HEAD_DIM), lp['qn_a'])
    o_a_c = dense_attention(qa_c, ka_c, va_c)
    qb_c = rms_norm(_diff_heads(pc['qb']), lp['qn_b'])
    wts_c = diff_weights(qb_c, kb_c, lam).astype(vb_c.dtype)
    o_b_c = rms_norm(jnp.einsum('bhqk,bhkv->bhqv', wts_c, vb_c), lp['subln_b']) * (1.0 - lam_init)
    o_c_c = _gla_out(o_cf + _flip(o_cb), pc['gc'], lp['onorm_c'])
    y_c = jnp.concatenate([_merge_heads(o_a_c), _merge_heads(o_b_c), _merge_heads(o_c_c)], axis=-1) @ lp['w_out']
    return y, y_c


def setup_inputs(seed: int = 0) -> dict:
    key = jax.random.key(seed)
    ks = iter(jax.random.split(key, 32))
    L, D = DEPTH, D_MODEL

    def nrm(shape, s):
        return jax.random.normal(next(ks), shape, F32) * s

    def gain(shape):
        return 1.0 + nrm(shape, 0.02)

    return {
        'x': nrm((BATCH, SEQ, D), 1.0),
        'c': nrm((BATCH, D), 1.0),
        'ctx': nrm((BATCH, CTX_LEN, D), 1.0),
        'c_ctx': nrm((D,), 1.0),
        'norm1': gain((L, D)),
        'norm2': gain((L, D)),
        'w_ada': nrm((L, D, 6 * D), 0.5 * D ** -0.5),
        'b_ada': nrm((L, 6 * D), 0.02),
        'w_in': nrm((L, D, IN_W), D ** -0.5),
        'qn_a': gain((L, HEAD_DIM)),
        'kn_a': gain((L, HEAD_DIM)),
        'rpb_a': nrm((L, NA_HEADS, 2 * NA_WIN_ROWS - 1, 2 * NA_WIN_COLS - 1), 0.1),
        'qn_b': gain((L, DA_QK_DIM)),
        'kn_b': gain((L, DA_QK_DIM)),
        'lam_q1': nrm((L, DA_QK_DIM), 0.1),
        'lam_k1': nrm((L, DA_QK_DIM), 0.1),
        'lam_q2': nrm((L, DA_QK_DIM), 0.1),
        'lam_k2': nrm((L, DA_QK_DIM), 0.1),
        'subln_b': gain((L, DA_V_DIM)),
        'w_a2_f': nrm((L, GLA_GATE_RANK, GLA_K_W), GLA_GATE_RANK ** -0.5),
        'b_a_f': nrm((L, GLA_K_W), 0.1),
        'w_a2_b': nrm((L, GLA_GATE_RANK, GLA_K_W), GLA_GATE_RANK ** -0.5),
        'b_a_b': nrm((L, GLA_K_W), 0.1),
        'onorm_c': gain((L, GLA_DV)),
        'w_out': nrm((L, MIX_W, D), MIX_W ** -0.5),
        'w_g': nrm((L, D, FFN_DIM), D ** -0.5),
        'w_u': nrm((L, D, FFN_DIM), D ** -0.5),
        'conv_w': nrm((L, CONV_W, FFN_DIM), CONV_W ** -0.5),
        'conv_b': nrm((L, FFN_DIM), 0.02),
        'w_d': nrm((L, FFN_DIM, D), FFN_DIM ** -0.5),
    }


def reference(x, c, ctx, c_ctx, norm1, norm2, w_ada, b_ada, w_in, qn_a, kn_a, rpb_a,
              qn_b, kn_b, lam_q1, lam_k1, lam_q2, lam_k2, subln_b, w_a2_f, b_a_f,
              w_a2_b, b_a_b, onorm_c, w_out, w_g, w_u, conv_w, conv_b, w_d):
    h, hc = x, ctx
    for l in range(DEPTH):
        with_ctx_out = l < DEPTH - 1
        lam_init = 0.8 - 0.6 * math.exp(-0.3 * l)
        lp = {'w_in': w_in[l], 'qn_a': qn_a[l], 'kn_a': kn_a[l], 'rpb_a': rpb_a[l],
              'qn_b': qn_b[l], 'kn_b': kn_b[l], 'lam_q1': lam_q1[l], 'lam_k1': lam_k1[l],
              'lam_q2': lam_q2[l], 'lam_k2': lam_k2[l], 'subln_b': subln_b[l],
              'w_a2_f': w_a2_f[l], 'b_a_f': b_a_f[l], 'w_a2_b': w_a2_b[l], 'b_a_b': b_a_b[l],
              'onorm_c': onorm_c[l], 'w_out': w_out[l]}
        sh1, sc1, g1, sh2, sc2, g2 = jnp.split((jax.nn.silu(c) @ w_ada[l] + b_ada[l])[:, None, :], 6, axis=-1)
        csh1, csc1, cg1, csh2, csc2, cg2 = jnp.split(jax.nn.silu(c_ctx) @ w_ada[l] + b_ada[l], 6, axis=-1)
        xn = rms_norm(h, norm1[l]) * (1.0 + sc1) + sh1
        xn_c = rms_norm(hc, norm1[l]) * (1.0 + csc1) + csh1
        y, y_c = _mixer(xn, xn_c, lp, lam_init, with_ctx_out)
        h = h + g1 * y
        h = h + g2 * conv_ffn(rms_norm(h, norm2[l]) * (1.0 + sc2) + sh2,
                              w_g[l], w_u[l], conv_w[l], conv_b[l], w_d[l])
        if with_ctx_out:
            hc = hc + cg1 * y_c
            hc = hc + cg2 * conv_ffn(rms_norm(hc, norm2[l]) * (1.0 + csc2) + csh2,
                                     w_g[l], w_u[l], conv_w[l], conv_b[l], w_d[l])
    return h
```

```cpp
#include <hip/hip_runtime.h>
#include <cstdio>
#include <cstdint>
#include <cstring>
#include <cmath>
#define HD __device__ __attribute__((always_inline))
#ifdef HOST_TEST
constexpr int D = HT_D, BATCH = HT_B, SEQ = HT_S, CTX = HT_C;
#else
constexpr int D = 1024, BATCH = 8, SEQ = 4096, CTX = 256;
#endif
constexpr int DEPTH = 2, GRID_W = 64, ROWS = SEQ / GRID_W;
constexpr int NAH = D / 256, DAH = D / 256, GLH = D / 256;
constexpr int NA_W = NAH * 64, DQK_W = DAH * 64, DV_W = DAH * 64, GK_W = GLH * 64, GV_W = GLH * 128;
constexpr int FFN = ((8 * D) / 3 + 127) / 128 * 128;
constexpr int IN_W = 3 * NA_W + 2 * DQK_W + DV_W + 2 * GK_W + 2 * GV_W + 32;
constexpr int PW = IN_W - 32;
constexpr int C_QA = 0, C_KA = NA_W, C_VA = 2 * NA_W, C_QB = 3 * NA_W, C_KB = C_QB + DQK_W, C_VB = C_KB + DQK_W;
constexpr int C_QC = C_VB + DV_W, C_KC = C_QC + GK_W, C_VC = C_KC + GK_W, C_GC = C_VC + GV_W;
constexpr int ML = BATCH * SEQ, MC = BATCH * CTX, M = ML + MC;
constexpr int MO_A = 0, MO_B = NA_W, MO_C = NA_W + DV_W;
constexpr int NT_F = FFN / 128;
constexpr int NT_H0 = (NT_F + 1) / 2;
constexpr int GUP = 256 * NT_H0;
constexpr float EPS = 1e-6f, LOG2E = 1.4426950408889634f;

#define UNR _Pragma("unroll")
typedef unsigned short bf16;
HD inline float bf2f(bf16 v) { unsigned u = (unsigned)v << 16; float f; __builtin_memcpy(&f, &u, 4); return f; }
HD inline bf16 f2bf(float f) { unsigned u; __builtin_memcpy(&u, &f, 4); return (bf16)((u + 0x7fffu + ((u >> 16) & 1u)) >> 16); }

struct alignas(16) U4 { unsigned x, y, z, w; };
HD inline void ld8(const bf16* p, float* o) {
    const U4 v = *(const U4*)p;
    unsigned u;
    u = v.x << 16; __builtin_memcpy(&o[0], &u, 4); u = v.x & 0xffff0000u; __builtin_memcpy(&o[1], &u, 4);
    u = v.y << 16; __builtin_memcpy(&o[2], &u, 4); u = v.y & 0xffff0000u; __builtin_memcpy(&o[3], &u, 4);
    u = v.z << 16; __builtin_memcpy(&o[4], &u, 4); u = v.z & 0xffff0000u; __builtin_memcpy(&o[5], &u, 4);
    u = v.w << 16; __builtin_memcpy(&o[6], &u, 4); u = v.w & 0xffff0000u; __builtin_memcpy(&o[7], &u, 4);
}
struct Params {
    const float *x, *c, *ctx, *c_ctx, *norm1, *norm2, *w_ada, *b_ada, *w_in, *qn_a, *kn_a, *rpb_a, *qn_b, *kn_b;
    const float *lam_q1, *lam_k1, *lam_q2, *lam_k2, *subln_b, *w_a2_f, *b_a_f, *w_a2_b, *b_a_b, *onorm_c, *w_out, *w_g, *w_u, *conv_w, *conv_b, *w_d;
    float* out;
    unsigned char* ws;
    float* MOD;
    float* ROPE;
    float* HC;
    bf16* XN;
    bf16* AFB;
    bf16* P;
    bf16* GU;
    float* GO;
    float* ALF;
    float* ALB;
    float* DT;
    bf16* ACT;
    bf16 *WIN_T, *WOUT_T, *WGU_T, *WD_T;
};

HD inline float silu_f(float x) { return x / (1.0f + expf(-x)); }
HD inline float logsigmoid_f(float x) { return fminf(x, 0.0f) - log1pf(expf(-fabsf(x))); }
HD inline int clampi(int v, int lo, int hi) { return v < lo ? lo : (v > hi ? hi : v); }
HD inline int row_batch_slot(int m) { return m < ML ? m / SEQ : BATCH; }
HD inline const float* mod_vec(const Params& p, int l, int m, int which) {
    const int j = m < ML ? m / SEQ : BATCH;
    return p.MOD + ((size_t)(l * (BATCH + 1) + j) * 6 + which) * D;
}
HD inline float* hrow(const Params& p, int m) { return m < ML ? p.out + (size_t)m * D : p.HC + (size_t)(m - ML) * D; }
HD inline const float* xrow(const Params& p, int m) { return m < ML ? p.x + (size_t)m * D : p.ctx + (size_t)(m - ML) * D; }

HD inline void ph_mod(const Params& p, long gtid, long gsize) {
    const long N = (long)DEPTH * (BATCH + 1) * 6 * D;
    for (long i = gtid; i < N; i += gsize) {
        const int n = (int)(i % (6 * D)); const int j = (int)((i / (6 * D)) % (BATCH + 1)); const int l = (int)(i / ((long)6 * D * (BATCH + 1)));
        const float* cv = j < BATCH ? p.c + (size_t)j * D : p.c_ctx;
        const float* w = p.w_ada + (size_t)l * D * 6 * D + n;
        float acc = 0.f;
        for (int k = 0; k < D; ++k) acc += silu_f(cv[k]) * w[(size_t)k * 6 * D];
        p.MOD[i] = acc + p.b_ada[(size_t)l * 6 * D + n];
    }
    for (long i = gtid; i < 64 * 8; i += gsize) {
        const int pos = (int)(i / 8), f = (int)(i % 8);
        const float inv = expf(-((float)f / 8.0f) * logf(10000.0f));
        const float ang = (float)pos * inv;
        p.ROPE[2 * i] = cosf(ang); p.ROPE[2 * i + 1] = sinf(ang);
    }
}

HD inline void ph_norm_naive(const Params& p, int l, int which, bool from_input, int mrows, long gtid, long gsize) {
    for (long m = gtid; m < mrows; m += gsize) {
        const float* h = from_input ? xrow(p, (int)m) : hrow(p, (int)m);
        const float* g = (which ? p.norm2 : p.norm1) + (size_t)l * D;
        const float* sh = mod_vec(p, l, (int)m, which ? 3 : 0); const float* sc = mod_vec(p, l, (int)m, which ? 4 : 1);
        float ss = 0.f; for (int k = 0; k < D; ++k) ss += h[k] * h[k];
        const float rstd = 1.0f / sqrtf(ss / D + EPS);
        bf16* o = p.XN + (size_t)m * D;
        for (int k = 0; k < D; ++k) o[k] = f2bf((h[k] * rstd * g[k]) * (1.0f + sc[k]) + sh[k]);
    }
}

constexpr int POST_ITEMS = 2 * NAH + 4 * DAH + GLH + 2 * GLH;
HD inline void ph_post_naive(const Params& p, int l, long gtid, long gsize) {
    const long N = (long)M * POST_ITEMS;
    for (long i = gtid; i < N; i += gsize) {
        const int m = (int)(i / POST_ITEMS); int it = (int)(i % POST_ITEMS);
        bf16* pr = p.P + (size_t)m * PW;
        if (it < 2 * NAH) {
            const bool isq = it < NAH; const int h = isq ? it : it - NAH;
            bf16* v = pr + (isq ? C_QA : C_KA) + h * 64; const float* g = (isq ? p.qn_a : p.kn_a) + l * 64;
            float x[64], ss = 0.f; UNR for (int d = 0; d < 64; ++d) { x[d] = bf2f(v[d]); ss += x[d] * x[d]; }
            const float r = 1.0f / sqrtf(ss / 64 + EPS) * (isq ? 0.125f * LOG2E : 1.0f);
            UNR for (int d = 0; d < 64; ++d) v[d] = f2bf(x[d] * r * g[d]);
            continue;
        }
        it -= 2 * NAH;
        if (it < 4 * DAH) {
            const bool isq = it < 2 * DAH; const int hc = isq ? it : it - 2 * DAH;
            bf16* v = pr + (isq ? C_QB : C_KB) + hc * 32; const float* g = (isq ? p.qn_b : p.kn_b) + l * 32;
            float x[32], ss = 0.f; UNR for (int d = 0; d < 32; ++d) { x[d] = bf2f(v[d]); ss += x[d] * x[d]; }
            const float r = 1.0f / sqrtf(ss / 32 + EPS);
            UNR for (int d = 0; d < 32; ++d) x[d] = x[d] * r * g[d];
            if (m < ML) {
                const int t = m % SEQ, row = t / GRID_W, col = t % GRID_W;
                UNR for (int f = 0; f < 8; ++f) {
                    const float cr = p.ROPE[(row * 8 + f) * 2], sr = p.ROPE[(row * 8 + f) * 2 + 1];
                    const float a = x[f], b = x[f + 8]; x[f] = a * cr - b * sr; x[f + 8] = b * cr + a * sr;
                    const float cc = p.ROPE[(col * 8 + f) * 2], sn = p.ROPE[(col * 8 + f) * 2 + 1];
                    const float a2 = x[16 + f], b2 = x[24 + f]; x[16 + f] = a2 * cc - b2 * sn; x[24 + f] = b2 * cc + a2 * sn;
                }
            }
            const float s = isq ? 0.17677669529663687f * LOG2E : 1.0f;
            UNR for (int d = 0; d < 32; ++d) v[d] = f2bf(x[d] * s);
            continue;
        }
        it -= 4 * DAH;
        if (it < GLH) {
            bf16* v = pr + C_QC + it * 64;
            UNR for (int d = 0; d < 64; ++d) v[d] = f2bf(bf2f(v[d]) * 0.125f);
            continue;
        }
        it -= GLH;
        {
            const int dir = it / GLH, h = it % GLH;
            const bf16* a = p.AFB + (size_t)m * 32 + dir * 16;
            const float* w2 = (dir ? p.w_a2_b : p.w_a2_f) + (size_t)l * 16 * GK_W + h * 64;
            const float* bb = (dir ? p.b_a_b : p.b_a_f) + (size_t)l * GK_W + h * 64;
            float* o = (dir ? p.ALB : p.ALF) + (size_t)m * GK_W + h * 64;
            float av[16]; UNR for (int r = 0; r < 16; ++r) av[r] = bf2f(a[r]);
            UNR for (int d = 0; d < 64; ++d) {
                float xx = bb[d]; UNR for (int r = 0; r < 16; ++r) xx += av[r] * w2[(size_t)r * GK_W + d];
                o[d] = expf(logsigmoid_f(xx) * (1.0f / 16.0f));
            }
        }
    }
}

HD inline void ph_na_naive(const Params& p, int l, bool with_ctx, long gtid, long gsize) {
    const int mq = with_ctx ? M : ML; const long N = (long)NAH * mq;
    for (long i = gtid; i < N; i += gsize) {
        const int m = (int)(i % mq), h = (int)(i / mq);
        float q[64], o[64]; const bf16* qp = p.P + (size_t)m * PW + C_QA + h * 64;
        UNR for (int d = 0; d < 64; ++d) { q[d] = bf2f(qp[d]); o[d] = 0.f; }
        float mx = -1e30f, ls = 0.f;
        const int b = m < ML ? m / SEQ : (m - ML) / CTX;
        if (m < ML) {
            const int t = m % SEQ, r = t / GRID_W, w = t % GRID_W;
            const int r0 = clampi(r - 4, 0, ROWS - 8), c0 = clampi(w - 8, 0, GRID_W - 16);
            const float* rpb = p.rpb_a + ((size_t)l * NAH + h) * 15 * 31;
            for (int kk = 0; kk < 128; ++kk) {
                const int kr = r0 + (kk >> 4), kc = c0 + (kk & 15); const int km = b * SEQ + kr * GRID_W + kc;
                const bf16* kp = p.P + (size_t)km * PW + C_KA + h * 64; const bf16* vp = p.P + (size_t)km * PW + C_VA + h * 64;
                float s = 0.f; UNR for (int d8 = 0; d8 < 8; ++d8) { float t[8]; ld8(kp + 8 * d8, t); UNR for (int e = 0; e < 8; ++e) s += q[8 * d8 + e] * t[e]; }
                s += rpb[(kr - r + 7) * 31 + (kc - w + 15)] * LOG2E;
                const float mn = fmaxf(mx, s), al = exp2f(mx - mn), pe = exp2f(s - mn);
                ls = ls * al + pe; UNR for (int d8 = 0; d8 < 8; ++d8) { float t[8]; ld8(vp + 8 * d8, t); UNR for (int e = 0; e < 8; ++e) o[8 * d8 + e] = o[8 * d8 + e] * al + pe * t[e]; } mx = mn;
            }
        }
        for (int j = 0; j < CTX; ++j) {
            const int km = ML + b * CTX + j;
            const bf16* kp = p.P + (size_t)km * PW + C_KA + h * 64; const bf16* vp = p.P + (size_t)km * PW + C_VA + h * 64;
            float s = 0.f; UNR for (int d8 = 0; d8 < 8; ++d8) { float t[8]; ld8(kp + 8 * d8, t); UNR for (int e = 0; e < 8; ++e) s += q[8 * d8 + e] * t[e]; }
            const float mn = fmaxf(mx, s), al = exp2f(mx - mn), pe = exp2f(s - mn);
            ls = ls * al + pe; UNR for (int d8 = 0; d8 < 8; ++d8) { float t[8]; ld8(vp + 8 * d8, t); UNR for (int e = 0; e < 8; ++e) o[8 * d8 + e] = o[8 * d8 + e] * al + pe * t[e]; } mx = mn;
        }
        bf16* op = p.XN + (size_t)m * D + MO_A + h * 64; const float il = 1.0f / ls;
        UNR for (int d = 0; d < 64; ++d) op[d] = f2bf(o[d] * il);
    }
}

HD inline float lam_of(const Params& p, int l, float lam_init) {
    float s1 = 0.f, s2 = 0.f;
    for (int i = 0; i < 32; ++i) { s1 += p.lam_q1[l * 32 + i] * p.lam_k1[l * 32 + i]; s2 += p.lam_q2[l * 32 + i] * p.lam_k2[l * 32 + i]; }
    return expf(s1) - expf(s2) + lam_init;
}
HD inline float lam_init_of(int l) { return 0.8f - 0.6f * expf(-0.3f * (float)l); }

HD inline void ph_diff_naive(const Params& p, int l, bool with_ctx, long gtid, long gsize) {
    const int mq = with_ctx ? M : ML; const long N = (long)DAH * mq;
    const float lam_init = lam_init_of(l), lam = lam_of(p, l, lam_init);
    for (long i = gtid; i < N; i += gsize) {
        const int m = (int)(i % mq), h = (int)(i / mq);
        const int b = m < ML ? m / SEQ : (m - ML) / CTX;
        float* dt = p.DT + (size_t)m * DV_W + h * 64;
        float o[64];
        for (int c = 0; c < 2; ++c) {
            float q[32]; const bf16* qp = p.P + (size_t)m * PW + C_QB + h * 64 + c * 32;
            UNR for (int d = 0; d < 32; ++d) q[d] = bf2f(qp[d]);
            UNR for (int d = 0; d < 64; ++d) o[d] = 0.f;
            float mx = -1e30f, ls = 0.f;
            const int nk = (m < ML ? SEQ : 0) + CTX;
            for (int kk = 0; kk < nk; ++kk) {
                const int km = (m < ML) ? (kk < SEQ ? b * SEQ + kk : ML + b * CTX + (kk - SEQ)) : ML + b * CTX + kk;
                const bf16* kp = p.P + (size_t)km * PW + C_KB + h * 64 + c * 32; const bf16* vp = p.P + (size_t)km * PW + C_VB + h * 64;
                float s = 0.f; UNR for (int d8 = 0; d8 < 4; ++d8) { float t[8]; ld8(kp + 8 * d8, t); UNR for (int e = 0; e < 8; ++e) s += q[8 * d8 + e] * t[e]; }
                const float mn = fmaxf(mx, s), al = exp2f(mx - mn), pe = exp2f(s - mn);
                ls = ls * al + pe; UNR for (int d8 = 0; d8 < 8; ++d8) { float t[8]; ld8(vp + 8 * d8, t); UNR for (int e = 0; e < 8; ++e) o[8 * d8 + e] = o[8 * d8 + e] * al + pe * t[e]; } mx = mn;
            }
            const float il = 1.0f / ls;
            if (c == 0) { UNR for (int d = 0; d < 64; ++d) dt[d] = o[d] * il; }
            else { UNR for (int d = 0; d < 64; ++d) o[d] = dt[d] - lam * (o[d] * il); }
        }
        float* res = o;
        float ss = 0.f; UNR for (int d = 0; d < 64; ++d) ss += res[d] * res[d];
        const float r = 1.0f / sqrtf(ss / 64 + EPS) * (1.0f - lam_init);
        bf16* op = p.XN + (size_t)m * D + MO_B + h * 64;
        UNR for (int d = 0; d < 64; ++d) op[d] = f2bf(res[d] * r * p.subln_b[l * 64 + d]);
    }
}

HD inline void ph_gla_naive(const Params& p, long gtid, long gsize) {
    const long N = (long)BATCH * GLH * 128;
    for (long i = gtid; i < N; i += gsize) {
        const int v = (int)(i % 128), h = (int)((i / 128) % GLH), b = (int)(i / (128 * GLH));
        for (int dir = 0; dir < 2; ++dir) {
            float S[64]; UNR for (int d = 0; d < 64; ++d) S[d] = 0.f;
            const float* AL = dir ? p.ALB : p.ALF;
            for (int s = 0; s < CTX + SEQ; ++s) {
                int m;
                if (s < CTX) m = ML + b * CTX + (dir ? CTX - 1 - s : s);
                else m = b * SEQ + (dir ? SEQ - 1 - (s - CTX) : (s - CTX));
                const bf16* pr = p.P + (size_t)m * PW; const float* al = AL + (size_t)m * GK_W + h * 64;
                const float vv = bf2f(pr[C_VC + h * 128 + v]);
                float o = 0.f;
                UNR for (int d8 = 0; d8 < 8; ++d8) { float tk[8], tq[8]; ld8(pr + C_KC + h * 64 + 8 * d8, tk); ld8(pr + C_QC + h * 64 + 8 * d8, tq);
                    UNR for (int e = 0; e < 8; ++e) { const int d = 8 * d8 + e; S[d] = al[d] * S[d] + tk[e] * vv; o += tq[e] * S[d]; } }
                float* go = p.GO + (size_t)m * GV_W + h * 128 + v;
                if (dir == 0) *go = o; else *go += o;
            }
        }
    }
}
HD inline void ph_gla_out_naive(const Params& p, int l, bool with_ctx, long gtid, long gsize) {
    const int mq = with_ctx ? M : ML; const long N = (long)GLH * mq;
    for (long i = gtid; i < N; i += gsize) {
        const int m = (int)(i % mq), h = (int)(i / mq);
        const float* go = p.GO + (size_t)m * GV_W + h * 128; const bf16* gc = p.P + (size_t)m * PW + C_GC + h * 128;
        float ss = 0.f; for (int v = 0; v < 128; ++v) ss += go[v] * go[v];
        const float r = 1.0f / sqrtf(ss / 128 + EPS);
        bf16* op = p.XN + (size_t)m * D + MO_C + h * 128;
        for (int v = 0; v < 128; ++v) op[v] = f2bf(go[v] * r * p.onorm_c[l * 128 + v] * silu_f(bf2f(gc[v])));
    }
}

HD inline void ph_act_naive(const Params& p, int l, int half, int mrows, long gtid, long gsize) {
    const int t0 = half ? NT_H0 : 0, nt = half ? NT_F - NT_H0 : NT_H0; const int nf = nt * 128;
    const long N = (long)mrows * nf;
    for (long i = gtid; i < N; i += gsize) {
        const int m = (int)(i / nf), fl = (int)(i % nf); const int j = fl / 128, ii = fl % 128; const int f = (t0 + j) * 128 + ii;
        int pos, len; if (m < ML) { pos = m % SEQ; len = SEQ; } else { pos = (m - ML) % CTX; len = CTX; }
        const bf16* g = p.GU + (size_t)m * GUP + j * 256 + ii;
        const float* cw = p.conv_w + (size_t)l * 3 * FFN;
        float a = p.conv_b[(size_t)l * FFN + f] + cw[FFN + f] * bf2f(g[0]);
        if (pos > 0) a += cw[f] * bf2f(g[-(long)GUP]);
        if (pos < len - 1) a += cw[2 * FFN + f] * bf2f(g[GUP]);
        p.ACT[(size_t)m * FFN + f] = f2bf(silu_f(a) * bf2f(g[128]));
    }
}
namespace pg8 {
#define PG8_LAS __attribute__((address_space(3)))
typedef unsigned short bf16_t;
typedef short bf16x8 __attribute__((ext_vector_type(8)));
typedef float f32x4 __attribute__((ext_vector_type(4)));
typedef unsigned u32x4 __attribute__((ext_vector_type(4)));
constexpr int BM = 256, BK = 64, HALF = 128, HTB = HALF * BK * 2  , STAGE_BYTES = 8 * HTB, NXCD = 8, WGM = 8;

__host__ __device__ __forceinline__ int lds_byte(int r, int c) { const int st = (r >> 4) * 2 + (c >> 5), rr = r & 15, cc = c & 31, ob = rr * 64 + cc * 2; return st * 1024 + (ob ^ (((ob >> 9) & 1) << 5)); }
__host__ __device__ __forceinline__ void stage_rc(int b, int& R, int& C) { const int st = b / 1024, sb = b % 1024, swz = sb ^ (((sb >> 9) & 1) << 5); R = (st >> 1) * 16 + swz / 64; C = (st & 1) * 32 + (swz % 64) / 2; }
__host__ __device__ __forceinline__ int perm32(int rho) { const int n = rho >> 4, i = rho & 15; return 8 * (i >> 2) + 4 * n + (i & 3); }

struct Unit { int pm, pn; };
struct Gemm { const bf16_t* A; const bf16_t* Bt; int M, N, K; };

struct StaticOrder {
    int nM, nN, nwg, G, c;
    __host__ __device__ void init(int M, int N, int G_, int c_) { nM = M / BM; nN = N / BM; nwg = nM * nN; G = G_; c = c_; }
    __host__ __device__ bool next(int i, Unit& u) const {
        const long L = (long)i * G + c; if (L >= nwg) return false;
        int wgid = (int)L; { const int q = nwg / NXCD, r = nwg % NXCD, xcd = wgid % NXCD, off = wgid / NXCD; wgid = (xcd < r ? xcd * (q + 1) : r * (q + 1) + (xcd - r) * q) + off; }
        const int nig = WGM * nN, gid = wgid / nig, fm = gid * WGM, gsz = (nM - fm) < WGM ? (nM - fm) : WGM;
        u.pm = fm + ((wgid % nig) % gsz); u.pn = (wgid % nig) / gsz; return true;
    }
    __device__ __forceinline__ void a_ready(const Unit&) const {}
    __device__ __forceinline__ void done(const Unit&) const {}
};

__device__ __forceinline__ unsigned cvt_pk_bf16(float lo, float hi) { unsigned r; asm volatile("v_cvt_pk_bf16_f32 %0, %1, %2" : "=v"(r) : "v"(lo), "v"(hi)); return r; }
template <class Epi, class Sched, bool ALIGN_EPI = false, bool SP2 = false>
__device__ __forceinline__ void gemm_phase(PG8_LAS unsigned char* lds, const Gemm g, const Sched& S, const Epi& E) {
    const int tid = threadIdx.x, wid = __builtin_amdgcn_readfirstlane(tid >> 6), lane = tid & 63, wr = wid >> 2, wc = wid & 3, fr = lane & 15, fq = lane >> 4;
    const int K = g.K, nt = K / BK;
    unsigned voffA[2], voffB[2];
#pragma unroll
    for (int i = 0; i < 2; ++i) { int R, C; stage_rc(tid * 16 + i * 8192, R, C); const int Rb = Epi::PERM ? ((R & ~31) + perm32(R & 31)) : R;
        voffA[i] = (unsigned)(R * K + C) * 2u; voffB[i] = (unsigned)(Rb * K + C) * 2u; }
    const size_t kstep = (size_t)(BK * 2);
    const size_t hstep = (size_t)HALF * K * 2;
    const size_t tstep = 2 * hstep;
    const unsigned ldsw = (unsigned)wid * 1024u;
    const int aoff = lds_byte(wr * 64 + fr, fq * 8), boff = lds_byte(wc * 32 + fr, fq * 8);
#define PG8_SA(b, h) (((b) * 2 + (h)) * HTB)
#define PG8_SB(b, h) ((4 + (b) * 2 + (h)) * HTB)
#define PG8_STAGE(bufoff, gbase, voff) do { _Pragma("unroll") for (int _i = 0; _i < 2; ++_i) \
        __builtin_amdgcn_global_load_lds((const unsigned*)((const char*)(gbase) + (voff)[_i]), (PG8_LAS unsigned*)(lds + (bufoff) + ldsw + _i * 8192), 16, 0, 0); } while (0)
#define PG8_LDA(dst, b, h) do { _Pragma("unroll") for (int m = 0; m < 4; ++m) _Pragma("unroll") for (int k = 0; k < 2; ++k) dst[m][k] = *(const PG8_LAS bf16x8*)(lds + PG8_SA(b, h) + aoff + m * 2048 + k * 1024); } while (0)
#define PG8_LDB(dst, b, h) do { _Pragma("unroll") for (int n = 0; n < 2; ++n) _Pragma("unroll") for (int k = 0; k < 2; ++k) dst[n][k] = *(const PG8_LAS bf16x8*)(lds + PG8_SB(b, h) + boff + n * 2048 + k * 1024); } while (0)
#define PG8_MMA(ai, bj, At, Bt) do { __builtin_amdgcn_s_setprio(1); _Pragma("unroll") for (int m = 0; m < 4; ++m) _Pragma("unroll") for (int n = 0; n < 2; ++n) _Pragma("unroll") for (int k = 0; k < 2; ++k) \
        acc[ai][bj][m][n] = __builtin_amdgcn_mfma_f32_16x16x32_bf16(Bt[n][k], At[m][k], acc[ai][bj][m][n], 0, 0, 0); __builtin_amdgcn_s_setprio(0); } while (0)
#define PG8_WAIT_V(n) asm volatile("s_waitcnt vmcnt(" #n ")" ::: "memory")
#define PG8_WAIT_L(n) asm volatile("s_waitcnt lgkmcnt(" #n ")" ::: "memory")
#define PG8_BAR __builtin_amdgcn_s_barrier()
#define PG8_SCHED __builtin_amdgcn_sched_barrier(0)
    Unit cur, nxt; int ui = 0;
    if (!S.next(0, cur)) return;
    f32x4 acc[2][2][4][2];
#pragma unroll
    for (int a = 0; a < 2; ++a)
#pragma unroll
        for (int b = 0; b < 2; ++b)
#pragma unroll
            for (int m = 0; m < 4; ++m)
#pragma unroll
                for (int n = 0; n < 2; ++n) acc[a][b][m][n] = (f32x4){0.f, 0.f, 0.f, 0.f};
    bf16x8 At[4][2], B0[2][2], B1[2][2];
    const char* cA = (const char*)g.A + (size_t)cur.pm * tstep; const char* cB = (const char*)g.Bt + (size_t)cur.pn * tstep;
    S.a_ready(cur);
    if constexpr (SP2) {
        PG8_STAGE(PG8_SB(0, 0), cB, voffB); PG8_STAGE(PG8_SB(0, 1), cB + hstep, voffB); PG8_STAGE(PG8_SA(0, 0), cA, voffA); PG8_STAGE(PG8_SA(0, 1), cA + hstep, voffA);
        if (wr == 1) PG8_BAR;
        PG8_WAIT_V(2); PG8_BAR;
        PG8_STAGE(PG8_SB(1, 0), cB + kstep, voffB); PG8_STAGE(PG8_SA(1, 0), cA + kstep, voffA); PG8_STAGE(PG8_SB(1, 1), cB + hstep + kstep, voffB);
        PG8_WAIT_V(6); PG8_BAR;
    } else {
        PG8_STAGE(PG8_SB(0, 0), cB, voffB); PG8_STAGE(PG8_SA(0, 0), cA, voffA); PG8_STAGE(PG8_SB(0, 1), cB + hstep, voffB); PG8_STAGE(PG8_SA(0, 1), cA + hstep, voffA);
        if (wr == 1) PG8_BAR;
        PG8_WAIT_V(4); PG8_BAR;
        PG8_STAGE(PG8_SB(1, 0), cB + kstep, voffB); PG8_STAGE(PG8_SA(1, 0), cA + kstep, voffA); PG8_STAGE(PG8_SB(1, 1), cB + hstep + kstep, voffB);
        PG8_WAIT_V(6); PG8_BAR;
    }
    for (;;) {
        const bool has_next = S.next(ui + 1, nxt);
        const char* nA = has_next ? (const char*)g.A + (size_t)nxt.pm * tstep : cA; const char* nB = has_next ? (const char*)g.Bt + (size_t)nxt.pn * tstep : cB;
        for (int t = 0; t < nt; t += 2) {
            const bool last = (t == nt - 2);
            const char* a1 = cA + (size_t)(t + 1) * kstep;
            const char* a2 = last ? nA : cA + (size_t)(t + 2) * kstep; const char* b2 = last ? nB : cB + (size_t)(t + 2) * kstep;
            const char* a3 = a2 + kstep; const char* b3 = b2 + kstep;
            if (last && has_next) S.a_ready(nxt);
            if constexpr (SP2) {
            PG8_LDB(B0, 0, 0); PG8_LDB(B1, 0, 1); PG8_SCHED; PG8_LDA(At, 0, 0); PG8_STAGE(PG8_SA(1, 1), a1 + hstep, voffA);
            PG8_WAIT_V(8); PG8_WAIT_L(0); PG8_BAR; PG8_MMA(0, 0, At, B0); PG8_MMA(0, 1, At, B1); PG8_BAR; PG8_SCHED;
            PG8_LDA(At, 0, 1); PG8_STAGE(PG8_SB(0, 0), b2, voffB); PG8_STAGE(PG8_SB(0, 1), b2 + hstep, voffB); PG8_STAGE(PG8_SA(0, 0), a2, voffA);
            PG8_WAIT_V(8); PG8_WAIT_L(0); PG8_BAR; PG8_MMA(1, 0, At, B0); PG8_MMA(1, 1, At, B1); PG8_BAR; PG8_SCHED;
            PG8_LDB(B0, 1, 0); PG8_LDB(B1, 1, 1); PG8_SCHED; PG8_LDA(At, 1, 0); PG8_STAGE(PG8_SA(0, 1), a2 + hstep, voffA);
            PG8_WAIT_V(8); PG8_WAIT_L(0); PG8_BAR; PG8_MMA(0, 0, At, B0); PG8_MMA(0, 1, At, B1); PG8_BAR; PG8_SCHED;
            PG8_LDA(At, 1, 1); PG8_STAGE(PG8_SB(1, 0), b3, voffB); PG8_STAGE(PG8_SB(1, 1), b3 + hstep, voffB); PG8_STAGE(PG8_SA(1, 0), a3, voffA);
            PG8_WAIT_V(8); PG8_WAIT_L(0); PG8_BAR; PG8_MMA(1, 0, At, B0); PG8_MMA(1, 1, At, B1); PG8_BAR; PG8_SCHED;
            } else {
            PG8_LDB(B0, 0, 0); PG8_SCHED; PG8_LDA(At, 0, 0); PG8_STAGE(PG8_SA(1, 1), a1 + hstep, voffA);
            PG8_WAIT_L(8); PG8_BAR; PG8_WAIT_L(0); PG8_MMA(0, 0, At, B0); PG8_BAR; PG8_SCHED;
            PG8_LDB(B1, 0, 1); PG8_STAGE(PG8_SB(0, 0), b2, voffB);
            PG8_BAR; PG8_WAIT_L(0); PG8_MMA(0, 1, At, B1); PG8_BAR;
            PG8_LDA(At, 0, 1); PG8_STAGE(PG8_SA(0, 0), a2, voffA);
            PG8_BAR; PG8_WAIT_L(0); PG8_MMA(1, 0, At, B0); PG8_BAR; PG8_SCHED;
            PG8_STAGE(PG8_SB(0, 1), b2 + hstep, voffB);
            PG8_WAIT_V(6); PG8_BAR; PG8_MMA(1, 1, At, B1); PG8_BAR;
            PG8_LDB(B0, 1, 0); PG8_SCHED; PG8_LDA(At, 1, 0); PG8_STAGE(PG8_SA(0, 1), a2 + hstep, voffA);
            PG8_WAIT_L(8); PG8_BAR; PG8_WAIT_L(0); PG8_MMA(0, 0, At, B0); PG8_BAR; PG8_SCHED;
            PG8_LDB(B1, 1, 1); PG8_STAGE(PG8_SB(1, 0), b3, voffB);
            PG8_BAR; PG8_WAIT_L(0); PG8_MMA(0, 1, At, B1); PG8_BAR;
            PG8_LDA(At, 1, 1); PG8_STAGE(PG8_SA(1, 0), a3, voffA);
            PG8_BAR; PG8_WAIT_L(0); PG8_MMA(1, 0, At, B0); PG8_BAR; PG8_SCHED;
            PG8_STAGE(PG8_SB(1, 1), b3 + hstep, voffB);
            PG8_WAIT_V(6); PG8_BAR; PG8_MMA(1, 1, At, B1); PG8_BAR;
            }
        }
        if constexpr (ALIGN_EPI) { if (wr == 0) PG8_BAR; }
        if constexpr (!Epi::AFTER_DRAIN) { E(acc, cur, wr, wc, fr, fq); S.done(cur); }
        if (!has_next) break;
#pragma unroll
        for (int a = 0; a < 2; ++a)
#pragma unroll
            for (int b = 0; b < 2; ++b)
#pragma unroll
                for (int m = 0; m < 4; ++m)
#pragma unroll
                    for (int n = 0; n < 2; ++n) acc[a][b][m][n] = (f32x4){0.f, 0.f, 0.f, 0.f};
        cur = nxt; cA = nA; cB = nB; ++ui;
        if constexpr (ALIGN_EPI) { if (wr == 1) PG8_BAR; }
    }
    PG8_WAIT_V(0);
    if constexpr (!ALIGN_EPI) { if (wr == 0) PG8_BAR; }
    PG8_BAR;
    if constexpr (Epi::AFTER_DRAIN) { E.fused(acc, cur, wr, wc, fr, fq, lds, wid, lane); S.done(cur); }
#undef PG8_SA
#undef PG8_SB
#undef PG8_STAGE
#undef PG8_LDA
#undef PG8_LDB
#undef PG8_MMA
#undef PG8_WAIT_V
#undef PG8_WAIT_L
#undef PG8_BAR
#undef PG8_SCHED
}
}

#ifndef PG8_SP2
#define PG8_SP2 true
#endif
#define GAS __attribute__((address_space(1)))
#define LAS __attribute__((address_space(3)))
typedef unsigned v4u __attribute__((ext_vector_type(4)));
typedef float f32x4 __attribute__((ext_vector_type(4)));
typedef short bf16x8 __attribute__((ext_vector_type(8)));
typedef GAS unsigned gu32;
typedef GAS unsigned long long gu64;
#define RLX_AGENT __ATOMIC_RELAXED, __HIP_MEMORY_SCOPE_AGENT
#define LDS_WAIT() asm volatile("s_waitcnt lgkmcnt(0)" ::: "memory")
#define VM_WAIT() asm volatile("s_waitcnt vmcnt(0)" ::: "memory")
__device__ __forceinline__ unsigned long long rt() { return __builtin_amdgcn_s_memrealtime(); }
__device__ __forceinline__ unsigned pk2(float lo, float hi) { return (unsigned)f2bf(lo) | ((unsigned)f2bf(hi) << 16); }
#define XB_TMO      128
#define XB_XCNT(j)  (256  + 64 * (j))
#define XB_XSUB(j)  (1280 + 64 * (j))
#define XB_XGEN(j)  (2304 + 64 * (j))
#define XB_TOP      3328
#define XB_TOPGEN   3392
#define XCD_BAR_WORDS 3456
#define XB_SPIN_CAP (1u << 18)

__device__ __forceinline__ unsigned xb_ld(unsigned* p)              { return __hip_atomic_load(p, __ATOMIC_RELAXED, __HIP_MEMORY_SCOPE_AGENT); }
__device__ __forceinline__ unsigned xb_add(unsigned* p, unsigned v) { return __hip_atomic_fetch_add(p, v, __ATOMIC_RELAXED, __HIP_MEMORY_SCOPE_AGENT); }
__device__ __forceinline__ unsigned xb_xcc_id() { return (unsigned)__builtin_amdgcn_s_getreg((3 << 11) | 20) & 0xFu; }
#define XB_SPIN(cond, bar) do { unsigned _sp = 0; while (cond) { __builtin_amdgcn_s_sleep(1); \
    if ((++_sp & 255u) == 0u) { if (xb_ld(&(bar)[XB_TMO])) break; if (_sp > XB_SPIN_CAP) { atomicAdd(&(bar)[XB_TMO], 1u); break; } } } } while (0)

struct XcdBarrier {
    unsigned* bar; unsigned x;
    volatile LAS unsigned* st;
};

__device__ __forceinline__ XcdBarrier xcd_barrier_post(unsigned* bar, volatile LAS unsigned* st) {
    XcdBarrier b; b.bar = bar; b.x = xb_xcc_id(); b.st = st;
    if (threadIdx.x == 0) (void)xb_add(&bar[XB_XCNT(b.x)], 1u);
    return b;
}
__device__ __forceinline__ void xcd_barrier_complete(unsigned* bar, unsigned x, unsigned& nloc, unsigned& nx) {
    const unsigned G = gridDim.x * gridDim.y * gridDim.z;
    unsigned sum, cnt, mine, sp = 0u;
    for (;;) {
        sum = 0u; cnt = 0u; mine = 0u;
#pragma unroll
        for (unsigned j = 0; j < 16; ++j) { const unsigned c = xb_ld(&bar[XB_XCNT(j)]); sum += c; cnt += (c > 0u) ? 1u : 0u; mine = (j == x) ? c : mine; }
        if (sum == G) break;
        __builtin_amdgcn_s_sleep(1);
        if ((++sp & 255u) == 0u) { if (xb_ld(&bar[XB_TMO])) break; if (sp > XB_SPIN_CAP) { atomicAdd(&bar[XB_TMO], 1u); break; } }
    }
    nloc = mine > 0u ? mine : 1u; nx = cnt > 0u ? cnt : 1u;
}

__device__ __forceinline__ void xcd_barrier(const XcdBarrier& b) {
    asm volatile("s_waitcnt vmcnt(0)" ::: "memory");
    __syncthreads();
    if (threadIdx.x == 0) {
        unsigned* bar = b.bar;
        __builtin_amdgcn_s_waitcnt(0);
        unsigned nloc = b.st[0], nx = b.st[1];
        if (nloc == 0u) { xcd_barrier_complete(bar, b.x, nloc, nx); b.st[0] = nloc; b.st[1] = nx; }
        const unsigned old = xb_add(&bar[XB_XSUB(b.x)], 1u);
        const unsigned gen = old / nloc;
        if (old + 1u == (gen + 1u) * nloc) {
            __builtin_amdgcn_fence(__ATOMIC_RELEASE, "agent");
            asm volatile("s_waitcnt vmcnt(0)" ::: "memory");
            const unsigned og = xb_add(&bar[XB_TOP], 1u);
            const unsigned tg = og / nx;
            if (og + 1u == (tg + 1u) * nx) xb_add(&bar[XB_TOPGEN], 1u);
            else XB_SPIN(xb_ld(&bar[XB_TOPGEN]) == tg, bar);
            __builtin_amdgcn_fence(__ATOMIC_ACQUIRE, "agent");
            xb_add(&bar[XB_XGEN(b.x)], 1u);
            asm volatile("s_waitcnt vmcnt(0)" ::: "memory");
        } else {
            XB_SPIN(xb_ld(&bar[XB_XGEN(b.x)]) == gen, bar);
            __builtin_amdgcn_fence(__ATOMIC_ACQUIRE, "agent");
            asm volatile("s_waitcnt vmcnt(0)" ::: "memory");
        }
    }
    __syncthreads();
}
namespace pg8 {
struct EpiInproj {
    static constexpr bool PERM = true, AFTER_DRAIN = false;
    bf16_t* P; bf16_t* AFB;
    __device__ __forceinline__ void operator()(const f32x4 (&acc)[2][2][4][2], const Unit& u, int wr, int wc, int fr, int fq) const {
        const int row0 = u.pm * BM + wr * 64 + fr; const int col0 = u.pn * BM + wc * 32 + 8 * fq;
#pragma unroll
        for (int ai = 0; ai < 2; ++ai)
#pragma unroll
            for (int m = 0; m < 4; ++m) { const size_t row = (size_t)(row0 + ai * HALF + m * 16);
#pragma unroll
                for (int bj = 0; bj < 2; ++bj) { const f32x4 v0 = acc[ai][bj][m][0], v1 = acc[ai][bj][m][1]; const int col = col0 + bj * HALF;
                    u32x4 w; w.x = cvt_pk_bf16(v0[0], v0[1]); w.y = cvt_pk_bf16(v0[2], v0[3]); w.z = cvt_pk_bf16(v1[0], v1[1]); w.w = cvt_pk_bf16(v1[2], v1[3]);
                    if (col < PW) *(u32x4*)(P + row * PW + col) = w;
                    else if (col < PW + 32) *(u32x4*)(AFB + row * 32 + (col - PW)) = w; } }
    }
};
struct EpiBf16Plain {
    static constexpr bool PERM = true, AFTER_DRAIN = false;
    bf16_t* O; int ldc;
    __device__ __forceinline__ void operator()(const f32x4 (&acc)[2][2][4][2], const Unit& u, int wr, int wc, int fr, int fq) const {
        const int row0 = u.pm * BM + wr * 64 + fr; const int col0 = u.pn * BM + wc * 32 + 8 * fq;
#pragma unroll
        for (int ai = 0; ai < 2; ++ai)
#pragma unroll
            for (int m = 0; m < 4; ++m) { bf16_t* rowp = O + (size_t)(row0 + ai * HALF + m * 16) * ldc + col0;
#pragma unroll
                for (int bj = 0; bj < 2; ++bj) { const f32x4 v0 = acc[ai][bj][m][0], v1 = acc[ai][bj][m][1];
                    u32x4 w; w.x = cvt_pk_bf16(v0[0], v0[1]); w.y = cvt_pk_bf16(v0[2], v0[3]); w.z = cvt_pk_bf16(v1[0], v1[1]); w.w = cvt_pk_bf16(v1[2], v1[3]);
                    *(u32x4*)(rowp + bj * HALF) = w; } }
    }
};
struct EpiResid {
    static constexpr bool PERM = false, AFTER_DRAIN = false;
    const float* base_lat; const float* base_ctx; float* out_lat; float* out_ctx; const float* gate;
    __device__ __forceinline__ void operator()(const f32x4 (&acc)[2][2][4][2], const Unit& u, int wr, int wc, int fr, int fq) const {
        const bool lat = u.pm * BM < ML;
        const int slot = lat ? (u.pm * BM) / SEQ : BATCH;
        const int lrow0 = (lat ? u.pm * BM : u.pm * BM - ML) + wr * 64 + fr;
        const float* bs = lat ? base_lat : base_ctx; float* os = lat ? out_lat : out_ctx;
        const float* g = gate + (size_t)slot * 6 * D;
        const int col0 = u.pn * BM + wc * 32 + 4 * fq;
        f32x4 gv[2][2];
#pragma unroll
        for (int bj = 0; bj < 2; ++bj)
#pragma unroll
            for (int n = 0; n < 2; ++n) gv[bj][n] = *(const f32x4*)(g + col0 + bj * HALF + n * 16);
#pragma unroll
        for (int ai = 0; ai < 2; ++ai)
#pragma unroll
            for (int m = 0; m < 4; ++m) { const size_t off = (size_t)(lrow0 + ai * HALF + m * 16) * D + col0;
#pragma unroll
                for (int bj = 0; bj < 2; ++bj)
#pragma unroll
                    for (int n = 0; n < 2; ++n) { const f32x4 b = *(const f32x4*)(bs + off + bj * HALF + n * 16);
                        *(f32x4*)(os + off + bj * HALF + n * 16) = b + gv[bj][n] * acc[ai][bj][m][n]; } }
    }
};
}

constexpr size_t MiB = 1u << 20;
constexpr size_t WS_CTL = 0, CTL_ZERO_BYTES = 1 * MiB;
constexpr size_t WS_MOD = 1 * MiB, WS_ROPE = 2 * MiB;
constexpr size_t WS_WIN = 3 * MiB, WS_WOUT = 10 * MiB, WS_WGU = 12 * MiB, WS_WD = 23 * MiB;
constexpr size_t WS_HC = 29 * MiB, WS_XN = 37 * MiB, WS_AFB = 105 * MiB, WS_R1 = 108 * MiB, WS_R2 = 312 * MiB;
constexpr size_t WS_GO = WS_R2, WS_ALF = WS_R2 + 68 * MiB, WS_ALB = WS_R2 + 102 * MiB, WS_DT = WS_R2 + 136 * MiB, WS_END = 499 * MiB;
constexpr int NPAD_IN = (IN_W + 255) / 256 * 256;
static_assert(WS_WIN + (size_t)NPAD_IN * D * 2 <= WS_WOUT && WS_WOUT + (size_t)D * D * 2 <= WS_WGU && WS_WGU + (size_t)2 * FFN * D * 2 <= WS_WD && WS_WD + (size_t)D * FFN * 2 <= WS_HC, "weights map");
static_assert(WS_HC + (size_t)MC * D * 4 <= WS_XN && WS_XN + (size_t)M * D * 2 <= WS_AFB && WS_AFB + (size_t)M * 32 * 2 <= WS_R1, "ws map 1");
static_assert(WS_R1 + (size_t)M * PW * 2 <= WS_R2 && WS_R1 + (size_t)M * GUP * 2 <= WS_R2 && WS_R2 + (size_t)M * FFN * 2 <= WS_END, "ws map 2");
static_assert(WS_ALB + (size_t)M * GK_W * 4 <= WS_DT && WS_DT + (size_t)M * DV_W * 4 <= WS_END, "ws map 4");
static_assert(WS_GO + (size_t)M * GV_W * 4 <= WS_ALF && WS_ALF + (size_t)M * GK_W * 4 <= WS_ALB && WS_ALB + (size_t)M * GK_W * 4 <= WS_END, "ws map 3");
constexpr int CW_BAR = 4096;
constexpr int RING_OFF = 0, RING_BYTES = 131072;
constexpr int LDSCTL_OFF = RING_BYTES, MISC_OFF = LDSCTL_OFF + 320;
constexpr int LDS_BYTES = 147456;
constexpr int NWAVES = 8, NTHREADS = 512;

__device__ __forceinline__ void transpose_item(const float* W, int ldw, bf16* WT, int ldt, int k0, int n0, int dst_row0, LAS float* scr, int lane) {
#pragma unroll 8
    for (int i = 0; i < 32; ++i) { const int kk = 2 * i + (lane >> 5); scr[kk * 33 + (lane & 31)] = W[(size_t)(k0 + kk) * ldw + n0 + (lane & 31)]; }
    LDS_WAIT(); asm volatile("" ::: "memory");
    const int c = lane & 7;
#pragma unroll
    for (int j = 0; j < 4; ++j) { const int n = (lane >> 3) + 8 * j; const LAS float* s = scr + (8 * c) * 33 + n;
        v4u o; o.x = pk2(s[0 * 33], s[1 * 33]); o.y = pk2(s[2 * 33], s[3 * 33]); o.z = pk2(s[4 * 33], s[5 * 33]); o.w = pk2(s[6 * 33], s[7 * 33]);
        *(GAS v4u*)(WT + (size_t)(dst_row0 + n) * ldt + k0 + 8 * c) = o; }
    LDS_WAIT(); asm volatile("" ::: "memory");
}
__device__ __forceinline__ void ph_weights(const Params& p, int l, LAS unsigned char* lds, int gw, int NGW, int wave, int lane) {
    LAS float* scr = (LAS float*)(lds + RING_OFF + wave * 16384);
    constexpr int NB_IN = IN_W / 32, I_IN = (D / 64) * NB_IN, I_OUT = (D / 64) * (D / 32), I_G = (D / 64) * (FFN / 32), I_D = (FFN / 64) * (D / 32);
    constexpr int NITEMS = I_IN + I_OUT + 2 * I_G + I_D;
    static_assert(IN_W % 32 == 0 && FFN % 64 == 0, "transpose items");
    for (int it = gw; it < NITEMS; it += NGW) {
        int r = it;
        if (r < I_IN) { const int kb = r / NB_IN, nb = r % NB_IN; transpose_item(p.w_in + (size_t)l * D * IN_W, IN_W, p.WIN_T, D, 64 * kb, 32 * nb, 32 * nb, scr, lane); continue; } r -= I_IN;
        if (r < I_OUT) { const int kb = r / (D / 32), nb = r % (D / 32); transpose_item(p.w_out + (size_t)l * D * D, D, p.WOUT_T, D, 64 * kb, 32 * nb, 32 * nb, scr, lane); continue; } r -= I_OUT;
        if (r < 2 * I_G) { const int s = r / I_G; r -= s * I_G; const int kb = r / (FFN / 32), nb = r % (FFN / 32); const int n0 = 32 * nb;
            transpose_item((s ? p.w_u : p.w_g) + (size_t)l * D * FFN, FFN, p.WGU_T, D, 64 * kb, n0, 256 * (n0 / 128) + 128 * s + (n0 % 128), scr, lane); continue; } r -= 2 * I_G;
        { const int kb = r / (D / 32), nb = r % (D / 32); transpose_item(p.w_d + (size_t)l * FFN * D, D, p.WD_T, FFN, 64 * kb, 32 * nb, 32 * nb, scr, lane); }
    }
    { const int tot = (NPAD_IN - IN_W) * D / 8; v4u z = {0u, 0u, 0u, 0u};
      for (int i = gw * 64 + lane; i < tot; i += NGW * 64) *(GAS v4u*)(p.WIN_T + (size_t)IN_W * D + (size_t)i * 8) = z; }
}

struct Args { Params p; int ph_lo, ph_hi; };
constexpr int PH_PER_LAYER = 12, N_PHASES = 1 + DEPTH * PH_PER_LAYER;

struct Ctx { LAS unsigned char* lds; long gtid, gsize; int gw, NGW, wave, lane, G; };

template <int PH> __device__ __forceinline__ void run_phase(const Params& p, const Ctx& c) {
    if constexpr (PH == 0) {
        ph_mod(p, c.gtid, c.gsize);
        ph_weights(p, 0, c.lds, c.gw, c.NGW, c.wave, c.lane);
    } else {
        constexpr int l = (PH - 1) / PH_PER_LAYER, s = (PH - 1) % PH_PER_LAYER;
        constexpr bool wc = l < DEPTH - 1; constexpr int mrows = wc ? M : ML;
        const float* modl = p.MOD + (size_t)l * (BATCH + 1) * 6 * D;
        if constexpr (s == 0) { if (l > 0) ph_weights(p, l, c.lds, c.gw, c.NGW, c.wave, c.lane);
                                ph_norm_naive(p, l, 0, l == 0, M, c.gtid, c.gsize); }
        if constexpr (s == 1) { pg8::Gemm g{p.XN, p.WIN_T, M, NPAD_IN, D}; pg8::StaticOrder S; S.init(M, NPAD_IN, c.G, (int)blockIdx.x);
                      pg8::EpiInproj E{p.P, p.AFB}; pg8::gemm_phase<pg8::EpiInproj, pg8::StaticOrder, true, true>(c.lds + RING_OFF, g, S, E); }
        if constexpr (s == 2) ph_post_naive(p, l, c.gtid, c.gsize);
        if constexpr (s == 3) { if (c.wave == 0) ph_gla_naive(p, (long)blockIdx.x * 64 + c.lane, (long)c.G * 64);
                    ph_na_naive(p, l, wc, c.gtid, c.gsize);
                    ph_diff_naive(p, l, wc, c.gtid, c.gsize); }
        if constexpr (s == 4) ph_gla_out_naive(p, l, wc, c.gtid, c.gsize);
        if constexpr (s == 5) { pg8::Gemm g{p.XN, p.WOUT_T, mrows, D, D}; pg8::StaticOrder S; S.init(mrows, D, c.G, (int)blockIdx.x);
                      pg8::EpiResid E{l == 0 ? p.x : p.out, l == 0 ? p.ctx : p.HC, p.out, p.HC, modl + 2 * D};
                      pg8::gemm_phase<pg8::EpiResid, pg8::StaticOrder, true, true>(c.lds + RING_OFF, g, S, E); }
        if constexpr (s == 6) ph_norm_naive(p, l, 1, false, mrows, c.gtid, c.gsize);
        if constexpr (s == 7 || s == 9) { constexpr int half = s == 9; constexpr int t0 = half ? NT_H0 : 0, nt = half ? NT_F - NT_H0 : NT_H0;
                      pg8::Gemm g{p.XN, p.WGU_T + (size_t)t0 * 256 * D, mrows, nt * 256, D}; pg8::StaticOrder S; S.init(mrows, nt * 256, c.G, (int)blockIdx.x);
                      pg8::EpiBf16Plain E{p.GU, GUP}; pg8::gemm_phase<pg8::EpiBf16Plain, pg8::StaticOrder, true, true>(c.lds + RING_OFF, g, S, E); }
        if constexpr (s == 8 || s == 10) ph_act_naive(p, l, s == 10, mrows, c.gtid, c.gsize);
        if constexpr (s == 11) { pg8::Gemm g{p.ACT, p.WD_T, mrows, D, FFN}; pg8::StaticOrder S; S.init(mrows, D, c.G, (int)blockIdx.x);
                      pg8::EpiResid E{p.out, p.HC, p.out, p.HC, modl + 5 * D};
                      pg8::gemm_phase<pg8::EpiResid, pg8::StaticOrder, true, true>(c.lds + RING_OFF, g, S, E); }
    }
}

template <int PH> __device__ __forceinline__ void run_from(const Params& p, const Ctx& c, const XcdBarrier& bar, int lo, int hi) {
    if constexpr (PH < N_PHASES) {
        if (lo <= PH && PH < hi) { run_phase<PH>(p, c); if (PH + 1 < hi) xcd_barrier(bar); }
        run_from<PH + 1>(p, c, bar, lo, hi);
    }
}

#ifdef PHASE_PROBE
template <int PH> __global__ void __launch_bounds__(NTHREADS, 2) k_probe(Args args) {
    extern __shared__ __attribute__((aligned(16))) unsigned char lds_raw[];
    Ctx c; c.lds = (LAS unsigned char*)lds_raw; c.lane = threadIdx.x & 63; c.wave = __builtin_amdgcn_readfirstlane(threadIdx.x >> 6); c.G = gridDim.x;
    c.gtid = (long)blockIdx.x * NTHREADS + threadIdx.x; c.gsize = (long)c.G * NTHREADS; c.gw = blockIdx.x * NWAVES + c.wave; c.NGW = c.G * NWAVES;
    run_phase<PH>(args.p, c);
}
template __global__ void k_probe<0>(Args); template __global__ void k_probe<1>(Args); template __global__ void k_probe<2>(Args); template __global__ void k_probe<3>(Args);
template __global__ void k_probe<4>(Args); template __global__ void k_probe<5>(Args); template __global__ void k_probe<6>(Args); template __global__ void k_probe<7>(Args);
template __global__ void k_probe<8>(Args); template __global__ void k_probe<9>(Args); template __global__ void k_probe<12>(Args); template __global__ void k_probe<13>(Args);
#endif

__global__ void __launch_bounds__(NTHREADS, 2) mk_fwd(Args args) {
    extern __shared__ __attribute__((aligned(16))) unsigned char lds_raw[];
    LAS unsigned char* lds = (LAS unsigned char*)lds_raw;
    const Params& p = args.p;
    const int tid = threadIdx.x;
    Ctx c; c.lds = lds; c.lane = tid & 63; c.wave = __builtin_amdgcn_readfirstlane(tid >> 6); c.G = gridDim.x;
    volatile LAS unsigned* MISC = (volatile LAS unsigned*)(lds + MISC_OFF);
    for (int u = tid; u < (LDS_BYTES - LDSCTL_OFF) / 4; u += NTHREADS) ((LAS unsigned*)(lds + LDSCTL_OFF))[u] = 0u;
    __syncthreads();
    gu32* ctl = (gu32*)(p.ws + WS_CTL);
    XcdBarrier bar = xcd_barrier_post((unsigned*)(ctl + CW_BAR), MISC + 8);
    c.gtid = (long)blockIdx.x * NTHREADS + tid; c.gsize = (long)c.G * NTHREADS;
    c.gw = blockIdx.x * NWAVES + c.wave; c.NGW = c.G * NWAVES;
    run_from<0>(p, c, bar, args.ph_lo, args.ph_hi);
}

#ifndef MK_MULTI
#define MK_MULTI 0
#endif
extern "C" void kernel_launch(void* const* d_in, const int* in_sizes, int n_in, void* d_out, int out_size, void* d_ws, size_t ws_size, hipStream_t stream) {
    static int grid = 0;
    if (grid == 0) {
        if (n_in != 30 || in_sizes[0] != ML * D || out_size != ML * D || ws_size < WS_END) { fprintf(stderr, "kernel_launch: unexpected shapes: n_in %d in0 %d out %d ws %zu (need %zu)\n", n_in, n_in > 0 ? in_sizes[0] : -1, out_size, ws_size, (size_t)WS_END); grid = -1; return; }
        int dev = 0, cus = 0, per_cu = 0;
        if (hipGetDevice(&dev) != hipSuccess || hipDeviceGetAttribute(&cus, hipDeviceAttributeMultiprocessorCount, dev) != hipSuccess) { grid = -1; return; }
        if (hipFuncSetAttribute((const void*)mk_fwd, hipFuncAttributeMaxDynamicSharedMemorySize, LDS_BYTES) != hipSuccess) { fprintf(stderr, "kernel_launch: hipFuncSetAttribute failed\n"); grid = -1; return; }
        if (hipOccupancyMaxActiveBlocksPerMultiprocessor(&per_cu, (const void*)mk_fwd, NTHREADS, LDS_BYTES) != hipSuccess || per_cu < 1) fprintf(stderr, "kernel_launch: occupancy query says %d\n", per_cu);
        (void)hipGetLastError();
        grid = cus;
    }
    if (grid < 0) return;
    if (hipMemsetAsync((char*)d_ws + WS_CTL, 0, CTL_ZERO_BYTES, stream) != hipSuccess) { fprintf(stderr, "kernel_launch: memset failed\n"); return; }
    Args a; memset(&a, 0, sizeof(a));
    Params& p = a.p;
    const float* const* in = (const float* const*)d_in;
    p.x = in[0]; p.c = in[1]; p.ctx = in[2]; p.c_ctx = in[3]; p.norm1 = in[4]; p.norm2 = in[5]; p.w_ada = in[6]; p.b_ada = in[7]; p.w_in = in[8];
    p.qn_a = in[9]; p.kn_a = in[10]; p.rpb_a = in[11]; p.qn_b = in[12]; p.kn_b = in[13]; p.lam_q1 = in[14]; p.lam_k1 = in[15]; p.lam_q2 = in[16]; p.lam_k2 = in[17];
    p.subln_b = in[18]; p.w_a2_f = in[19]; p.b_a_f = in[20]; p.w_a2_b = in[21]; p.b_a_b = in[22]; p.onorm_c = in[23]; p.w_out = in[24]; p.w_g = in[25]; p.w_u = in[26];
    p.conv_w = in[27]; p.conv_b = in[28]; p.w_d = in[29];
    unsigned char* ws = (unsigned char*)d_ws;
    p.out = (float*)d_out; p.ws = ws;
    p.MOD = (float*)(ws + WS_MOD); p.ROPE = (float*)(ws + WS_ROPE); p.HC = (float*)(ws + WS_HC); p.XN = (bf16*)(ws + WS_XN); p.AFB = (bf16*)(ws + WS_AFB);
    p.P = (bf16*)(ws + WS_R1); p.GU = (bf16*)(ws + WS_R1); p.GO = (float*)(ws + WS_GO); p.ALF = (float*)(ws + WS_ALF); p.ALB = (float*)(ws + WS_ALB); p.DT = (float*)(ws + WS_DT); p.ACT = (bf16*)(ws + WS_R2);
    p.WIN_T = (bf16*)(ws + WS_WIN); p.WOUT_T = (bf16*)(ws + WS_WOUT); p.WGU_T = (bf16*)(ws + WS_WGU); p.WD_T = (bf16*)(ws + WS_WD);
#if MK_MULTI
    for (int ph = 0; ph < N_PHASES; ++ph) { a.ph_lo = ph; a.ph_hi = ph + 1; hipLaunchKernelGGL(mk_fwd, dim3(grid), dim3(NTHREADS), LDS_BYTES, stream, a); }
#else
    a.ph_lo = 0; a.ph_hi = N_PHASES;
    hipLaunchKernelGGL(mk_fwd, dim3(grid), dim3(NTHREADS), LDS_BYTES, stream, a);
#endif
    const hipError_t le = hipPeekAtLastError();
    if (le != hipSuccess) fprintf(stderr, "kernel_launch: launch failed: %s\n", hipGetErrorName(le));
}
```

```cpp
#include <hip/hip_runtime.h>
#include <cstdio>
#include <cstdint>
#include <cstring>
#include <cmath>
#define HD __device__ __attribute__((always_inline))
#define NAIVE_GLA_GATES 0
#ifdef HOST_TEST
constexpr int D = HT_D, BATCH = HT_B, SEQ = HT_S, CTX = HT_C;
#else
constexpr int D = 1024, BATCH = 8, SEQ = 4096, CTX = 256;
#endif
constexpr int DEPTH = 2, GRID_W = 64, ROWS = SEQ / GRID_W;
constexpr int NAH = D / 256, DAH = D / 256, GLH = D / 256;
constexpr int NA_W = NAH * 64, DQK_W = DAH * 64, DV_W = DAH * 64, GK_W = GLH * 64, GV_W = GLH * 128;
constexpr int FFN = ((8 * D) / 3 + 127) / 128 * 128;
constexpr int IN_W = 3 * NA_W + 2 * DQK_W + DV_W + 2 * GK_W + 2 * GV_W + 32;
constexpr int PW = IN_W - 32;
constexpr int C_QA = 0, C_KA = NA_W, C_VA = 2 * NA_W, C_QB = 3 * NA_W, C_KB = C_QB + DQK_W, C_VB = C_KB + DQK_W;
constexpr int C_QC = C_VB + DV_W, C_KC = C_QC + GK_W, C_VC = C_KC + GK_W, C_GC = C_VC + GV_W;
constexpr int ML = BATCH * SEQ, MC = BATCH * CTX, M = ML + MC;
constexpr int MO_A = 0, MO_B = NA_W, MO_C = NA_W + DV_W;
constexpr int NT_F = FFN / 128;
constexpr int NT_H0 = (NT_F + 1) / 2;
constexpr int GUP = 256 * NT_H0;
constexpr float EPS = 1e-6f, LOG2E = 1.4426950408889634f;

#define UNR _Pragma("unroll")
typedef unsigned short bf16;
HD inline float bf2f(bf16 v) { unsigned u = (unsigned)v << 16; float f; __builtin_memcpy(&f, &u, 4); return f; }
HD inline bf16 f2bf(float f) { unsigned u; __builtin_memcpy(&u, &f, 4); return (bf16)((u + 0x7fffu + ((u >> 16) & 1u)) >> 16); }

struct alignas(16) U4 { unsigned x, y, z, w; };
HD inline void ld8(const bf16* p, float* o) {
    const U4 v = *(const U4*)p;
    unsigned u;
    u = v.x << 16; __builtin_memcpy(&o[0], &u, 4); u = v.x & 0xffff0000u; __builtin_memcpy(&o[1], &u, 4);
    u = v.y << 16; __builtin_memcpy(&o[2], &u, 4); u = v.y & 0xffff0000u; __builtin_memcpy(&o[3], &u, 4);
    u = v.z << 16; __builtin_memcpy(&o[4], &u, 4); u = v.z & 0xffff0000u; __builtin_memcpy(&o[5], &u, 4);
    u = v.w << 16; __builtin_memcpy(&o[6], &u, 4); u = v.w & 0xffff0000u; __builtin_memcpy(&o[7], &u, 4);
}
struct Params {
    const float *x, *c, *ctx, *c_ctx, *norm1, *norm2, *w_ada, *b_ada, *w_in, *qn_a, *kn_a, *rpb_a, *qn_b, *kn_b;
    const float *lam_q1, *lam_k1, *lam_q2, *lam_k2, *subln_b, *w_a2_f, *b_a_f, *w_a2_b, *b_a_b, *onorm_c, *w_out, *w_g, *w_u, *conv_w, *conv_b, *w_d;
    float* out;
    unsigned char* ws;
    float* MOD;
    float* ROPE;
    float* HC;
    bf16* XN;
    bf16* AFB;
    bf16* P;
    bf16* GU;
    float* GO;
    float* ALF;
    float* ALB;
    float* DT;
    float* US;
    float* AD;
    bf16* EA;
    bf16* EU;
    bf16* HB;
    bf16* XN2;
    float* SS1; float* SS2;
    float* B2IN; float* B2GU;
    bf16* ACT;
    bf16 *WIN_T, *WOUT_T, *WGU_T, *WD_T;
};

HD inline float silu_f(float x) { return x / (1.0f + expf(-x)); }
HD inline float logsigmoid_f(float x) { return fminf(x, 0.0f) - log1pf(expf(-fabsf(x))); }
HD inline int clampi(int v, int lo, int hi) { return v < lo ? lo : (v > hi ? hi : v); }
HD inline int row_batch_slot(int m) { return m < ML ? m / SEQ : BATCH; }
HD inline const float* mod_vec(const Params& p, int l, int m, int which) {
    const int j = m < ML ? m / SEQ : BATCH;
    return p.MOD + ((size_t)(l * (BATCH + 1) + j) * 6 + which) * D;
}
HD inline float* hrow(const Params& p, int m) { return m < ML ? p.out + (size_t)m * D : p.HC + (size_t)(m - ML) * D; }
HD inline const float* xrow(const Params& p, int m) { return m < ML ? p.x + (size_t)m * D : p.ctx + (size_t)(m - ML) * D; }

HD inline void ph_mod(const Params& p, long gtid, long gsize) {
    const long N = (long)DEPTH * (BATCH + 1) * 6 * D;
    for (long i = gtid; i < N; i += gsize) {
        const int n = (int)(i % (6 * D)); const int j = (int)((i / (6 * D)) % (BATCH + 1)); const int l = (int)(i / ((long)6 * D * (BATCH + 1)));
        const float* cv = j < BATCH ? p.c + (size_t)j * D : p.c_ctx;
        const float* w = p.w_ada + (size_t)l * D * 6 * D + n;
        float acc = 0.f;
        for (int k = 0; k < D; ++k) acc += silu_f(cv[k]) * w[(size_t)k * 6 * D];
        p.MOD[i] = acc + p.b_ada[(size_t)l * 6 * D + n];
    }
    for (long i = gtid; i < 64 * 8; i += gsize) {
        const int pos = (int)(i / 8), f = (int)(i % 8);
        const float inv = expf(-((float)f / 8.0f) * logf(10000.0f));
        const float ang = (float)pos * inv;
        p.ROPE[2 * i] = cosf(ang); p.ROPE[2 * i + 1] = sinf(ang);
    }
}

HD inline void ph_norm_naive(const Params& p, int l, int which, bool from_input, int mrows, long gtid, long gsize) {
    for (long m = gtid; m < mrows; m += gsize) {
        const float* h = from_input ? xrow(p, (int)m) : hrow(p, (int)m);
        const float* g = (which ? p.norm2 : p.norm1) + (size_t)l * D;
        const float* sh = mod_vec(p, l, (int)m, which ? 3 : 0); const float* sc = mod_vec(p, l, (int)m, which ? 4 : 1);
        float ss = 0.f; for (int k = 0; k < D; ++k) ss += h[k] * h[k];
        const float rstd = 1.0f / sqrtf(ss / D + EPS);
        bf16* o = p.XN + (size_t)m * D;
        for (int k = 0; k < D; ++k) o[k] = f2bf((h[k] * rstd * g[k]) * (1.0f + sc[k]) + sh[k]);
    }
}

#ifndef NAIVE_GLA_GATES
#define NAIVE_GLA_GATES 1
#endif
constexpr int POST_ITEMS = 2 * NAH + 4 * DAH + GLH + (NAIVE_GLA_GATES ? 2 * GLH : 0);
HD inline void ph_post_naive(const Params& p, int l, long gtid, long gsize) {
    const long N = (long)M * POST_ITEMS;
    for (long i = gtid; i < N; i += gsize) {
        const int m = (int)(i / POST_ITEMS); int it = (int)(i % POST_ITEMS);
        bf16* pr = p.P + (size_t)m * PW;
        if (it < 2 * NAH) {
            const bool isq = it < NAH; const int h = isq ? it : it - NAH;
            bf16* v = pr + (isq ? C_QA : C_KA) + h * 64; const float* g = (isq ? p.qn_a : p.kn_a) + l * 64;
            float x[64], ss = 0.f; UNR for (int d = 0; d < 64; ++d) { x[d] = bf2f(v[d]); ss += x[d] * x[d]; }
            const float r = 1.0f / sqrtf(ss / 64 + EPS) * (isq ? 0.125f * LOG2E : 1.0f);
            UNR for (int d = 0; d < 64; ++d) v[d] = f2bf(x[d] * r * g[d]);
            continue;
        }
        it -= 2 * NAH;
        if (it < 4 * DAH) {
            const bool isq = it < 2 * DAH; const int hc = isq ? it : it - 2 * DAH;
            bf16* v = pr + (isq ? C_QB : C_KB) + hc * 32; const float* g = (isq ? p.qn_b : p.kn_b) + l * 32;
            float x[32], ss = 0.f; UNR for (int d = 0; d < 32; ++d) { x[d] = bf2f(v[d]); ss += x[d] * x[d]; }
            const float r = 1.0f / sqrtf(ss / 32 + EPS);
            UNR for (int d = 0; d < 32; ++d) x[d] = x[d] * r * g[d];
            if (m < ML) {
                const int t = m % SEQ, row = t / GRID_W, col = t % GRID_W;
                UNR for (int f = 0; f < 8; ++f) {
                    const float cr = p.ROPE[(row * 8 + f) * 2], sr = p.ROPE[(row * 8 + f) * 2 + 1];
                    const float a = x[f], b = x[f + 8]; x[f] = a * cr - b * sr; x[f + 8] = b * cr + a * sr;
                    const float cc = p.ROPE[(col * 8 + f) * 2], sn = p.ROPE[(col * 8 + f) * 2 + 1];
                    const float a2 = x[16 + f], b2 = x[24 + f]; x[16 + f] = a2 * cc - b2 * sn; x[24 + f] = b2 * cc + a2 * sn;
                }
            }
            const float s = isq ? 0.17677669529663687f * LOG2E : 1.0f;
            UNR for (int d = 0; d < 32; ++d) v[d] = f2bf(x[d] * s);
            continue;
        }
        it -= 4 * DAH;
        if (it < GLH) {
            bf16* v = pr + C_QC + it * 64;
            UNR for (int d = 0; d < 64; ++d) v[d] = f2bf(bf2f(v[d]) * 0.125f);
            continue;
        }
        it -= GLH;
        {
            const int dir = it / GLH, h = it % GLH;
            const bf16* a = p.AFB + (size_t)m * 32 + dir * 16;
            const float* w2 = (dir ? p.w_a2_b : p.w_a2_f) + (size_t)l * 16 * GK_W + h * 64;
            const float* bb = (dir ? p.b_a_b : p.b_a_f) + (size_t)l * GK_W + h * 64;
            float* o = (dir ? p.ALB : p.ALF) + (size_t)m * GK_W + h * 64;
            float av[16]; UNR for (int r = 0; r < 16; ++r) av[r] = bf2f(a[r]);
            UNR for (int d = 0; d < 64; ++d) {
                float xx = bb[d]; UNR for (int r = 0; r < 16; ++r) xx += av[r] * w2[(size_t)r * GK_W + d];
                o[d] = expf(logsigmoid_f(xx) * (1.0f / 16.0f));
            }
        }
    }
}

HD inline void ph_na_naive(const Params& p, int l, bool with_ctx, long gtid, long gsize) {
    const int mq = with_ctx ? M : ML; const long N = (long)NAH * mq;
    for (long i = gtid; i < N; i += gsize) {
        const int m = (int)(i % mq), h = (int)(i / mq);
        float q[64], o[64]; const bf16* qp = p.P + (size_t)m * PW + C_QA + h * 64;
        UNR for (int d = 0; d < 64; ++d) { q[d] = bf2f(qp[d]); o[d] = 0.f; }
        float mx = -1e30f, ls = 0.f;
        const int b = m < ML ? m / SEQ : (m - ML) / CTX;
        if (m < ML) {
            const int t = m % SEQ, r = t / GRID_W, w = t % GRID_W;
            const int r0 = clampi(r - 4, 0, ROWS - 8), c0 = clampi(w - 8, 0, GRID_W - 16);
            const float* rpb = p.rpb_a + ((size_t)l * NAH + h) * 15 * 31;
            for (int kk = 0; kk < 128; ++kk) {
                const int kr = r0 + (kk >> 4), kc = c0 + (kk & 15); const int km = b * SEQ + kr * GRID_W + kc;
                const bf16* kp = p.P + (size_t)km * PW + C_KA + h * 64; const bf16* vp = p.P + (size_t)km * PW + C_VA + h * 64;
                float s = 0.f; UNR for (int d8 = 0; d8 < 8; ++d8) { float t[8]; ld8(kp + 8 * d8, t); UNR for (int e = 0; e < 8; ++e) s += q[8 * d8 + e] * t[e]; }
                s += rpb[(kr - r + 7) * 31 + (kc - w + 15)] * LOG2E;
                const float mn = fmaxf(mx, s), al = exp2f(mx - mn), pe = exp2f(s - mn);
                ls = ls * al + pe; UNR for (int d8 = 0; d8 < 8; ++d8) { float t[8]; ld8(vp + 8 * d8, t); UNR for (int e = 0; e < 8; ++e) o[8 * d8 + e] = o[8 * d8 + e] * al + pe * t[e]; } mx = mn;
            }
        }
        for (int j = 0; j < CTX; ++j) {
            const int km = ML + b * CTX + j;
            const bf16* kp = p.P + (size_t)km * PW + C_KA + h * 64; const bf16* vp = p.P + (size_t)km * PW + C_VA + h * 64;
            float s = 0.f; UNR for (int d8 = 0; d8 < 8; ++d8) { float t[8]; ld8(kp + 8 * d8, t); UNR for (int e = 0; e < 8; ++e) s += q[8 * d8 + e] * t[e]; }
            const float mn = fmaxf(mx, s), al = exp2f(mx - mn), pe = exp2f(s - mn);
            ls = ls * al + pe; UNR for (int d8 = 0; d8 < 8; ++d8) { float t[8]; ld8(vp + 8 * d8, t); UNR for (int e = 0; e < 8; ++e) o[8 * d8 + e] = o[8 * d8 + e] * al + pe * t[e]; } mx = mn;
        }
        bf16* op = p.XN + (size_t)m * D + MO_A + h * 64; const float il = 1.0f / ls;
        UNR for (int d = 0; d < 64; ++d) op[d] = f2bf(o[d] * il);
    }
}

HD inline float lam_of(const Params& p, int l, float lam_init) {
    float s1 = 0.f, s2 = 0.f;
    for (int i = 0; i < 32; ++i) { s1 += p.lam_q1[l * 32 + i] * p.lam_k1[l * 32 + i]; s2 += p.lam_q2[l * 32 + i] * p.lam_k2[l * 32 + i]; }
    return expf(s1) - expf(s2) + lam_init;
}
HD inline float lam_init_of(int l) { return 0.8f - 0.6f * expf(-0.3f * (float)l); }

HD inline void ph_diff_naive(const Params& p, int l, bool with_ctx, long gtid, long gsize) {
    const int mq = with_ctx ? M : ML; const long N = (long)DAH * mq;
    const float lam_init = lam_init_of(l), lam = lam_of(p, l, lam_init);
    for (long i = gtid; i < N; i += gsize) {
        const int m = (int)(i % mq), h = (int)(i / mq);
        const int b = m < ML ? m / SEQ : (m - ML) / CTX;
        float* dt = p.DT + (size_t)m * DV_W + h * 64;
        float o[64];
        for (int c = 0; c < 2; ++c) {
            float q[32]; const bf16* qp = p.P + (size_t)m * PW + C_QB + h * 64 + c * 32;
            UNR for (int d = 0; d < 32; ++d) q[d] = bf2f(qp[d]);
            UNR for (int d = 0; d < 64; ++d) o[d] = 0.f;
            float mx = -1e30f, ls = 0.f;
            const int nk = (m < ML ? SEQ : 0) + CTX;
            for (int kk = 0; kk < nk; ++kk) {
                const int km = (m < ML) ? (kk < SEQ ? b * SEQ + kk : ML + b * CTX + (kk - SEQ)) : ML + b * CTX + kk;
                const bf16* kp = p.P + (size_t)km * PW + C_KB + h * 64 + c * 32; const bf16* vp = p.P + (size_t)km * PW + C_VB + h * 64;
                float s = 0.f; UNR for (int d8 = 0; d8 < 4; ++d8) { float t[8]; ld8(kp + 8 * d8, t); UNR for (int e = 0; e < 8; ++e) s += q[8 * d8 + e] * t[e]; }
                const float mn = fmaxf(mx, s), al = exp2f(mx - mn), pe = exp2f(s - mn);
                ls = ls * al + pe; UNR for (int d8 = 0; d8 < 8; ++d8) { float t[8]; ld8(vp + 8 * d8, t); UNR for (int e = 0; e < 8; ++e) o[8 * d8 + e] = o[8 * d8 + e] * al + pe * t[e]; } mx = mn;
            }
            const float il = 1.0f / ls;
            if (c == 0) { UNR for (int d = 0; d < 64; ++d) dt[d] = o[d] * il; }
            else { UNR for (int d = 0; d < 64; ++d) o[d] = dt[d] - lam * (o[d] * il); }
        }
        float* res = o;
        float ss = 0.f; UNR for (int d = 0; d < 64; ++d) ss += res[d] * res[d];
        const float r = 1.0f / sqrtf(ss / 64 + EPS) * (1.0f - lam_init);
        bf16* op = p.XN + (size_t)m * D + MO_B + h * 64;
        UNR for (int d = 0; d < 64; ++d) op[d] = f2bf(res[d] * r * p.subln_b[l * 64 + d]);
    }
}

HD inline void ph_gla_naive(const Params& p, long gtid, long gsize) {
    const long N = (long)BATCH * GLH * 128;
    for (long i = gtid; i < N; i += gsize) {
        const int v = (int)(i % 128), h = (int)((i / 128) % GLH), b = (int)(i / (128 * GLH));
        for (int dir = 0; dir < 2; ++dir) {
            float S[64]; UNR for (int d = 0; d < 64; ++d) S[d] = 0.f;
            const float* AL = dir ? p.ALB : p.ALF;
            for (int s = 0; s < CTX + SEQ; ++s) {
                int m;
                if (s < CTX) m = ML + b * CTX + (dir ? CTX - 1 - s : s);
                else m = b * SEQ + (dir ? SEQ - 1 - (s - CTX) : (s - CTX));
                const bf16* pr = p.P + (size_t)m * PW; const float* al = AL + (size_t)m * GK_W + h * 64;
                const float vv = bf2f(pr[C_VC + h * 128 + v]);
                float o = 0.f;
                UNR for (int d8 = 0; d8 < 8; ++d8) { float tk[8], tq[8]; ld8(pr + C_KC + h * 64 + 8 * d8, tk); ld8(pr + C_QC + h * 64 + 8 * d8, tq);
                    UNR for (int e = 0; e < 8; ++e) { const int d = 8 * d8 + e; S[d] = al[d] * S[d] + tk[e] * vv; o += tq[e] * S[d]; } }
                float* go = p.GO + (size_t)m * GV_W + h * 128 + v;
                if (dir == 0) *go = o; else *go += o;
            }
        }
    }
}
HD inline void ph_gla_out_naive(const Params& p, int l, bool with_ctx, long gtid, long gsize) {
    const int mq = with_ctx ? M : ML; const long N = (long)GLH * mq;
    for (long i = gtid; i < N; i += gsize) {
        const int m = (int)(i % mq), h = (int)(i / mq);
        const float* go = p.GO + (size_t)m * GV_W + h * 128; const bf16* gc = p.P + (size_t)m * PW + C_GC + h * 128;
        float ss = 0.f; for (int v = 0; v < 128; ++v) ss += go[v] * go[v];
        const float r = 1.0f / sqrtf(ss / 128 + EPS);
        bf16* op = p.XN + (size_t)m * D + MO_C + h * 128;
        for (int v = 0; v < 128; ++v) op[v] = f2bf(go[v] * r * p.onorm_c[l * 128 + v] * silu_f(bf2f(gc[v])));
    }
}

HD inline void ph_act_naive(const Params& p, int l, int half, int mrows, long gtid, long gsize) {
    const int t0 = half ? NT_H0 : 0, nt = half ? NT_F - NT_H0 : NT_H0; const int nf = nt * 128;
    const long N = (long)mrows * nf;
    for (long i = gtid; i < N; i += gsize) {
        const int m = (int)(i / nf), fl = (int)(i % nf); const int j = fl / 128, ii = fl % 128; const int f = (t0 + j) * 128 + ii;
        int pos, len; if (m < ML) { pos = m % SEQ; len = SEQ; } else { pos = (m - ML) % CTX; len = CTX; }
        const bf16* g = p.GU + (size_t)m * GUP + j * 256 + ii;
        const float* cw = p.conv_w + (size_t)l * 3 * FFN;
        float a = p.conv_b[(size_t)l * FFN + f] + cw[FFN + f] * bf2f(g[0]);
        if (pos > 0) a += cw[f] * bf2f(g[-(long)GUP]);
        if (pos < len - 1) a += cw[2 * FFN + f] * bf2f(g[GUP]);
        p.ACT[(size_t)m * FFN + f] = f2bf(silu_f(a) * bf2f(g[128]));
    }
}
namespace pg8 {
#define PG8_LAS __attribute__((address_space(3)))
typedef unsigned short bf16_t;
typedef short bf16x8 __attribute__((ext_vector_type(8)));
typedef float f32x4 __attribute__((ext_vector_type(4)));
typedef unsigned u32x4 __attribute__((ext_vector_type(4)));
constexpr int BM = 256, BK = 64, HALF = 128, HTB = HALF * BK * 2  , STAGE_BYTES = 8 * HTB, NXCD = 8, WGM = 8;

__host__ __device__ __forceinline__ int lds_byte(int r, int c) { const int st = (r >> 4) * 2 + (c >> 5), rr = r & 15, cc = c & 31, ob = rr * 64 + cc * 2; return st * 1024 + (ob ^ (((ob >> 9) & 1) << 5)); }
__host__ __device__ __forceinline__ void stage_rc(int b, int& R, int& C) { const int st = b / 1024, sb = b % 1024, swz = sb ^ (((sb >> 9) & 1) << 5); R = (st >> 1) * 16 + swz / 64; C = (st & 1) * 32 + (swz % 64) / 2; }
__host__ __device__ __forceinline__ int perm32(int rho) { const int n = rho >> 4, i = rho & 15; return 8 * (i >> 2) + 4 * n + (i & 3); }

struct Unit { int pm, pn; int k0, nk, sp, ti; };
struct Gemm { const bf16_t* A; const bf16_t* Bt; int M, N, K; };

struct StaticOrder {
    int nM, nN, nwg, G, c;
    __host__ __device__ void init(int M, int N, int G_, int c_) { nM = M / BM; nN = N / BM; nwg = nM * nN; G = G_; c = c_; }
    __host__ __device__ bool next(int i, Unit& u) const {
        const long L = (long)i * G + c; if (L >= nwg) return false;
        int wgid = (int)L; { const int q = nwg / NXCD, r = nwg % NXCD, xcd = wgid % NXCD, off = wgid / NXCD; wgid = (xcd < r ? xcd * (q + 1) : r * (q + 1) + (xcd - r) * q) + off; }
        const int nig = WGM * nN, gid = wgid / nig, fm = gid * WGM, gsz = (nM - fm) < WGM ? (nM - fm) : WGM;
        u.pm = fm + ((wgid % nig) % gsz); u.pn = (wgid % nig) / gsz; return true;
    }
    __device__ __forceinline__ void a_ready(const Unit&) const {}
    __device__ __forceinline__ void done(const Unit&) const {}
    static constexpr bool SPLITK = false;
};
template <int NS_> struct SplitTailOrder {
    static constexpr bool SPLITK = true; static constexpr int NS = NS_;
    StaticOrder so; int nfull, ntail, nkt; bool on; float* part; unsigned* cnt; volatile PG8_LAS unsigned* flag;
    __device__ void init(int M, int N, int K, int G_, int c_, float* part_, unsigned* cnt_, volatile PG8_LAS unsigned* flag_) {
        so.init(M, N, G_, c_); nkt = K / BK; ntail = so.nwg % G_; nfull = so.nwg - ntail; part = part_; cnt = cnt_; flag = flag_;
        on = ntail > 0 && ntail * NS <= G_ && (nkt / 2) >= NS; }
    __device__ bool next(int i, Unit& u) const {
        const long L = (long)i * so.G + so.c; u.k0 = 0; u.nk = nkt; u.sp = -1; u.ti = 0;
        if (!on || L < nfull) return so.next(i, u);
        const int j = (int)(L - nfull); if (j >= ntail * NS) return false;
        const int tix = j % ntail, s = j / ntail; StaticOrder t = so; t.c = 0; t.G = 1; (void)t.next(nfull + tix, u);
        const int pairs = nkt / 2, base = pairs / NS, rem = pairs % NS;
        u.k0 = 2 * (s * base + (s < rem ? s : rem)); u.nk = 2 * (base + (s < rem ? 1 : 0)); u.sp = s; u.ti = tix; return true;
    }
    __device__ __forceinline__ void a_ready(const Unit&) const {}
    __device__ __forceinline__ void done(const Unit&) const {}
};

__device__ __forceinline__ unsigned cvt_pk_bf16(float lo, float hi) { unsigned r; asm volatile("v_cvt_pk_bf16_f32 %0, %1, %2" : "=v"(r) : "v"(lo), "v"(hi)); return r; }
struct NoPre {};
template <class T, class = void> struct PreOf { typedef NoPre type;
    template <class U> static __device__ __forceinline__ NoPre get(const T&, const U&, int, int, int, int) { return NoPre{}; }
    template <class A, class U> static __device__ __forceinline__ void call(const T& E, A& acc, const U& u, int wr, int wc, int fr, int fq, const NoPre&) { E(acc, u, wr, wc, fr, fq); } };
template <class T> struct PreOf<T, decltype((void)sizeof(typename T::Pre))> { typedef typename T::Pre type;
    template <class U> static __device__ __forceinline__ type get(const T& E, const U& u, int wr, int wc, int fr, int fq) { return E.pre(u, wr, wc, fr, fq); }
    template <class A, class U> static __device__ __forceinline__ void call(const T& E, A& acc, const U& u, int wr, int wc, int fr, int fq, const type& p) { E(acc, u, wr, wc, fr, fq, p); } };
template <class Epi, class Sched, bool ALIGN_EPI = false, bool SP2 = false>
__device__ __forceinline__ void gemm_phase(PG8_LAS unsigned char* lds, const Gemm g, const Sched& S, const Epi& E) {
    const int tid = threadIdx.x, wid = __builtin_amdgcn_readfirstlane(tid >> 6), lane = tid & 63, wr = wid >> 2, wc = wid & 3, fr = lane & 15, fq = lane >> 4;
    const int K = g.K, nt = K / BK;
    unsigned voffA[2], voffB[2];
#pragma unroll
    for (int i = 0; i < 2; ++i) { int R, C; stage_rc(tid * 16 + i * 8192, R, C); const int Rb = Epi::PERM ? ((R & ~31) + perm32(R & 31)) : R;
        voffA[i] = (unsigned)(R * K + C) * 2u; voffB[i] = (unsigned)(Rb * K + C) * 2u; }
    const size_t kstep = (size_t)(BK * 2);
    const size_t hstep = (size_t)HALF * K * 2;
    const size_t tstep = 2 * hstep;
    const unsigned ldsw = (unsigned)wid * 1024u;
    const int aoff = lds_byte(wr * 64 + fr, fq * 8), boff = lds_byte(wc * 32 + fr, fq * 8);
#define PG8_SA(b, h) (((b) * 2 + (h)) * HTB)
#define PG8_SB(b, h) ((4 + (b) * 2 + (h)) * HTB)
#define PG8_STAGE(bufoff, gbase, voff) do { _Pragma("unroll") for (int _i = 0; _i < 2; ++_i) \
        __builtin_amdgcn_global_load_lds((const unsigned*)((const char*)(gbase) + (voff)[_i]), (PG8_LAS unsigned*)(lds + (bufoff) + ldsw + _i * 8192), 16, 0, 0); } while (0)
#define PG8_LDA(dst, b, h) do { _Pragma("unroll") for (int m = 0; m < 4; ++m) _Pragma("unroll") for (int k = 0; k < 2; ++k) dst[m][k] = *(const PG8_LAS bf16x8*)(lds + PG8_SA(b, h) + aoff + m * 2048 + k * 1024); } while (0)
#define PG8_LDB(dst, b, h) do { _Pragma("unroll") for (int n = 0; n < 2; ++n) _Pragma("unroll") for (int k = 0; k < 2; ++k) dst[n][k] = *(const PG8_LAS bf16x8*)(lds + PG8_SB(b, h) + boff + n * 2048 + k * 1024); } while (0)
#define PG8_MMA(ai, bj, At, Bt) do { __builtin_amdgcn_s_setprio(1); _Pragma("unroll") for (int m = 0; m < 4; ++m) _Pragma("unroll") for (int n = 0; n < 2; ++n) _Pragma("unroll") for (int k = 0; k < 2; ++k) \
        acc[ai][bj][m][n] = __builtin_amdgcn_mfma_f32_16x16x32_bf16(Bt[n][k], At[m][k], acc[ai][bj][m][n], 0, 0, 0); __builtin_amdgcn_s_setprio(0); } while (0)
#define PG8_WAIT_V(n) asm volatile("s_waitcnt vmcnt(" #n ")" ::: "memory")
#define PG8_WAIT_L(n) asm volatile("s_waitcnt lgkmcnt(" #n ")" ::: "memory")
#define PG8_BAR __builtin_amdgcn_s_barrier()
#define PG8_SCHED __builtin_amdgcn_sched_barrier(0)
    Unit cur, nxt; int ui = 0;
    if (!S.next(0, cur)) return;
    f32x4 acc[2][2][4][2];
#pragma unroll
    for (int a = 0; a < 2; ++a)
#pragma unroll
        for (int b = 0; b < 2; ++b)
#pragma unroll
            for (int m = 0; m < 4; ++m)
#pragma unroll
                for (int n = 0; n < 2; ++n) acc[a][b][m][n] = (f32x4){0.f, 0.f, 0.f, 0.f};
    bf16x8 At[4][2], B0[2][2], B1[2][2];
    const char* cA = (const char*)g.A + (size_t)cur.pm * tstep; const char* cB = (const char*)g.Bt + (size_t)cur.pn * tstep;
    if constexpr (Sched::SPLITK) { cA += (size_t)cur.k0 * kstep; cB += (size_t)cur.k0 * kstep; }
    S.a_ready(cur);
    if constexpr (SP2) {
        PG8_STAGE(PG8_SB(0, 0), cB, voffB); PG8_STAGE(PG8_SB(0, 1), cB + hstep, voffB); PG8_STAGE(PG8_SA(0, 0), cA, voffA); PG8_STAGE(PG8_SA(0, 1), cA + hstep, voffA);
        if (wr == 1) PG8_BAR;
        PG8_WAIT_V(2); PG8_BAR;
        PG8_STAGE(PG8_SB(1, 0), cB + kstep, voffB); PG8_STAGE(PG8_SA(1, 0), cA + kstep, voffA); PG8_STAGE(PG8_SB(1, 1), cB + hstep + kstep, voffB);
        PG8_WAIT_V(6); PG8_BAR;
    } else {
        PG8_STAGE(PG8_SB(0, 0), cB, voffB); PG8_STAGE(PG8_SA(0, 0), cA, voffA); PG8_STAGE(PG8_SB(0, 1), cB + hstep, voffB); PG8_STAGE(PG8_SA(0, 1), cA + hstep, voffA);
        if (wr == 1) PG8_BAR;
        PG8_WAIT_V(4); PG8_BAR;
        PG8_STAGE(PG8_SB(1, 0), cB + kstep, voffB); PG8_STAGE(PG8_SA(1, 0), cA + kstep, voffA); PG8_STAGE(PG8_SB(1, 1), cB + hstep + kstep, voffB);
        PG8_WAIT_V(6); PG8_BAR;
    }
    for (;;) {
        const bool has_next = S.next(ui + 1, nxt);
        const char* nA = has_next ? (const char*)g.A + (size_t)nxt.pm * tstep : cA; const char* nB = has_next ? (const char*)g.Bt + (size_t)nxt.pn * tstep : cB;
        if constexpr (Sched::SPLITK) { if (has_next) { nA += (size_t)nxt.k0 * kstep; nB += (size_t)nxt.k0 * kstep; } }
        const int unt = Sched::SPLITK ? cur.nk : nt;
        for (int t = 0; t < unt; t += 2) {
            const bool last = (t == unt - 2);
            const char* a1 = cA + (size_t)(t + 1) * kstep;
            const char* a2 = last ? nA : cA + (size_t)(t + 2) * kstep; const char* b2 = last ? nB : cB + (size_t)(t + 2) * kstep;
            const char* a3 = a2 + kstep; const char* b3 = b2 + kstep;
            if (last && has_next) S.a_ready(nxt);
            if constexpr (SP2) {
            PG8_LDB(B0, 0, 0); PG8_LDB(B1, 0, 1); PG8_SCHED; PG8_LDA(At, 0, 0); PG8_STAGE(PG8_SA(1, 1), a1 + hstep, voffA);
            PG8_WAIT_V(8); PG8_WAIT_L(0); PG8_BAR; PG8_MMA(0, 0, At, B0); PG8_MMA(0, 1, At, B1); PG8_BAR; PG8_SCHED;
            PG8_LDA(At, 0, 1); PG8_STAGE(PG8_SB(0, 0), b2, voffB); PG8_STAGE(PG8_SB(0, 1), b2 + hstep, voffB); PG8_STAGE(PG8_SA(0, 0), a2, voffA);
            PG8_WAIT_V(8); PG8_WAIT_L(0); PG8_BAR; PG8_MMA(1, 0, At, B0); PG8_MMA(1, 1, At, B1); PG8_BAR; PG8_SCHED;
            PG8_LDB(B0, 1, 0); PG8_LDB(B1, 1, 1); PG8_SCHED; PG8_LDA(At, 1, 0); PG8_STAGE(PG8_SA(0, 1), a2 + hstep, voffA);
            PG8_WAIT_V(8); PG8_WAIT_L(0); PG8_BAR; PG8_MMA(0, 0, At, B0); PG8_MMA(0, 1, At, B1); PG8_BAR; PG8_SCHED;
            PG8_LDA(At, 1, 1); PG8_STAGE(PG8_SB(1, 0), b3, voffB); PG8_STAGE(PG8_SB(1, 1), b3 + hstep, voffB); PG8_STAGE(PG8_SA(1, 0), a3, voffA);
            PG8_WAIT_V(8); PG8_WAIT_L(0); PG8_BAR; PG8_MMA(1, 0, At, B0); PG8_MMA(1, 1, At, B1); PG8_BAR; PG8_SCHED;
            } else {
            PG8_LDB(B0, 0, 0); PG8_SCHED; PG8_LDA(At, 0, 0); PG8_STAGE(PG8_SA(1, 1), a1 + hstep, voffA);
            PG8_WAIT_L(8); PG8_BAR; PG8_WAIT_L(0); PG8_MMA(0, 0, At, B0); PG8_BAR; PG8_SCHED;
            PG8_LDB(B1, 0, 1); PG8_STAGE(PG8_SB(0, 0), b2, voffB);
            PG8_BAR; PG8_WAIT_L(0); PG8_MMA(0, 1, At, B1); PG8_BAR;
            PG8_LDA(At, 0, 1); PG8_STAGE(PG8_SA(0, 0), a2, voffA);
            PG8_BAR; PG8_WAIT_L(0); PG8_MMA(1, 0, At, B0); PG8_BAR; PG8_SCHED;
            PG8_STAGE(PG8_SB(0, 1), b2 + hstep, voffB);
            PG8_WAIT_V(6); PG8_BAR; PG8_MMA(1, 1, At, B1); PG8_BAR;
            PG8_LDB(B0, 1, 0); PG8_SCHED; PG8_LDA(At, 1, 0); PG8_STAGE(PG8_SA(0, 1), a2 + hstep, voffA);
            PG8_WAIT_L(8); PG8_BAR; PG8_WAIT_L(0); PG8_MMA(0, 0, At, B0); PG8_BAR; PG8_SCHED;
            PG8_LDB(B1, 1, 1); PG8_STAGE(PG8_SB(1, 0), b3, voffB);
            PG8_BAR; PG8_WAIT_L(0); PG8_MMA(0, 1, At, B1); PG8_BAR;
            PG8_LDA(At, 1, 1); PG8_STAGE(PG8_SA(1, 0), a3, voffA);
            PG8_BAR; PG8_WAIT_L(0); PG8_MMA(1, 0, At, B0); PG8_BAR; PG8_SCHED;
            PG8_STAGE(PG8_SB(1, 1), b3 + hstep, voffB);
            PG8_WAIT_V(6); PG8_BAR; PG8_MMA(1, 1, At, B1); PG8_BAR;
            }
        }
        const typename PreOf<Epi>::type epre = PreOf<Epi>::get(E, cur, wr, wc, fr, fq);
        if constexpr (ALIGN_EPI) { if (wr == 0) PG8_BAR; }
        bool do_epi = true;
        if constexpr (Sched::SPLITK) { if (cur.sp >= 0) {
            static_assert(ALIGN_EPI && !Epi::AFTER_DRAIN, "split-K needs aligned register epilogues");
            const __amdgpu_buffer_rsrc_t prs = __builtin_amdgcn_make_buffer_rsrc(S.part, 0, (int)(64u * Sched::NS * 262144u), 0x00020000);
            const unsigned poff = ((unsigned)(cur.ti * Sched::NS + cur.sp) * 65536u + (unsigned)tid * 4u) * 4u;
#pragma unroll
            for (int a = 0; a < 2; ++a)
#pragma unroll
                for (int b = 0; b < 2; ++b)
#pragma unroll
                    for (int m = 0; m < 4; ++m)
#pragma unroll
                        for (int n = 0; n < 2; ++n) __builtin_amdgcn_raw_buffer_store_b128(__builtin_bit_cast(u32x4, acc[a][b][m][n]), prs, poff + (unsigned)((((a * 2 + b) * 4 + m) * 2 + n) * 8192), 0,   16);
            PG8_WAIT_V(0); PG8_BAR;
            if (tid == 0) {
                const unsigned old = __hip_atomic_fetch_add(S.cnt + cur.ti, 1u, __ATOMIC_RELAXED, __HIP_MEMORY_SCOPE_AGENT);
                if (old == (unsigned)(Sched::NS - 1)) { __builtin_amdgcn_fence(__ATOMIC_ACQUIRE, "agent"); PG8_WAIT_V(0); }
                *S.flag = old; PG8_WAIT_L(0); }
            PG8_BAR;
            do_epi = (*S.flag == (unsigned)(Sched::NS - 1));
            if (do_epi) {
                const float* qq = S.part + (size_t)(cur.ti * Sched::NS) * 65536 + tid * 4;
#pragma unroll
                for (int a = 0; a < 2; ++a)
#pragma unroll
                    for (int b = 0; b < 2; ++b)
#pragma unroll
                        for (int m = 0; m < 4; ++m)
#pragma unroll
                            for (int n = 0; n < 2; ++n) { const float* q1 = qq + (((a * 2 + b) * 4 + m) * 2 + n) * 2048; f32x4 sum = *(const f32x4*)q1;
#pragma unroll
                                for (int s = 1; s < Sched::NS; ++s) sum += *(const f32x4*)(q1 + (size_t)s * 65536);
                                acc[a][b][m][n] = sum; }
            }
        } }
        if constexpr (!Epi::AFTER_DRAIN) { if (do_epi) PreOf<Epi>::call(E, acc, cur, wr, wc, fr, fq, epre); S.done(cur); }
        if (!has_next) break;
#pragma unroll
        for (int a = 0; a < 2; ++a)
#pragma unroll
            for (int b = 0; b < 2; ++b)
#pragma unroll
                for (int m = 0; m < 4; ++m)
#pragma unroll
                    for (int n = 0; n < 2; ++n) acc[a][b][m][n] = (f32x4){0.f, 0.f, 0.f, 0.f};
        cur = nxt; cA = nA; cB = nB; ++ui;
        if constexpr (ALIGN_EPI) { if (wr == 1) PG8_BAR; }
    }
    PG8_WAIT_V(0);
    if constexpr (!ALIGN_EPI) { if (wr == 0) PG8_BAR; }
    PG8_BAR;
    if constexpr (Epi::AFTER_DRAIN) { E.fused(acc, cur, wr, wc, fr, fq, lds, wid, lane); S.done(cur); }
#undef PG8_SA
#undef PG8_SB
#undef PG8_STAGE
#undef PG8_LDA
#undef PG8_LDB
#undef PG8_MMA
#undef PG8_WAIT_V
#undef PG8_WAIT_L
#undef PG8_BAR
#undef PG8_SCHED
}
}

#ifndef PG8_SP2
#define PG8_SP2 true
#endif
#define GAS __attribute__((address_space(1)))
#define LAS __attribute__((address_space(3)))
typedef unsigned v4u __attribute__((ext_vector_type(4)));
typedef float f32x4 __attribute__((ext_vector_type(4)));
typedef short bf16x8 __attribute__((ext_vector_type(8)));
typedef GAS unsigned gu32;
typedef GAS unsigned long long gu64;
#define RLX_AGENT __ATOMIC_RELAXED, __HIP_MEMORY_SCOPE_AGENT
#define LDS_WAIT() asm volatile("s_waitcnt lgkmcnt(0)" ::: "memory")
#define VM_WAIT() asm volatile("s_waitcnt vmcnt(0)" ::: "memory")
__device__ __forceinline__ unsigned long long rt() { return __builtin_amdgcn_s_memrealtime(); }
__device__ __forceinline__ unsigned pk2(float lo, float hi) { return (unsigned)f2bf(lo) | ((unsigned)f2bf(hi) << 16); }
#define XB_TMO      128
#define XB_XCNT(j)  (256  + 64 * (j))
#define XB_XSUB(j)  (1280 + 64 * (j))
#define XB_XGEN(j)  (2304 + 64 * (j))
#define XB_TOP      3328
#define XB_TOPGEN   3392
#define XCD_BAR_WORDS 3456
#define XB_SPIN_CAP (1u << 18)

__device__ __forceinline__ unsigned xb_ld(unsigned* p)              { return __hip_atomic_load(p, __ATOMIC_RELAXED, __HIP_MEMORY_SCOPE_AGENT); }
__device__ __forceinline__ unsigned xb_add(unsigned* p, unsigned v) { return __hip_atomic_fetch_add(p, v, __ATOMIC_RELAXED, __HIP_MEMORY_SCOPE_AGENT); }
__device__ __forceinline__ unsigned xb_xcc_id() { return (unsigned)__builtin_amdgcn_s_getreg((3 << 11) | 20) & 0xFu; }
#define XB_SPIN(cond, bar) do { unsigned _sp = 0; while (cond) { __builtin_amdgcn_s_sleep(1); \
    if ((++_sp & 255u) == 0u) { if (xb_ld(&(bar)[XB_TMO])) break; if (_sp > XB_SPIN_CAP) { atomicAdd(&(bar)[XB_TMO], 1u); break; } } } } while (0)

struct XcdBarrier {
    unsigned* bar; unsigned x;
    volatile LAS unsigned* st;
};

__device__ __forceinline__ XcdBarrier xcd_barrier_post(unsigned* bar, volatile LAS unsigned* st) {
    XcdBarrier b; b.bar = bar; b.x = xb_xcc_id(); b.st = st;
    if (threadIdx.x == 0) (void)xb_add(&bar[XB_XCNT(b.x)], 1u);
    return b;
}
__device__ __forceinline__ void xcd_barrier_complete(unsigned* bar, unsigned x, unsigned& nloc, unsigned& nx) {
    const unsigned G = gridDim.x * gridDim.y * gridDim.z;
    unsigned sum, cnt, mine, sp = 0u;
    for (;;) {
        sum = 0u; cnt = 0u; mine = 0u;
#pragma unroll
        for (unsigned j = 0; j < 16; ++j) { const unsigned c = xb_ld(&bar[XB_XCNT(j)]); sum += c; cnt += (c > 0u) ? 1u : 0u; mine = (j == x) ? c : mine; }
        if (sum == G) break;
        __builtin_amdgcn_s_sleep(1);
        if ((++sp & 255u) == 0u) { if (xb_ld(&bar[XB_TMO])) break; if (sp > XB_SPIN_CAP) { atomicAdd(&bar[XB_TMO], 1u); break; } }
    }
    nloc = mine > 0u ? mine : 1u; nx = cnt > 0u ? cnt : 1u;
}

__device__ __forceinline__ void xcd_barrier(const XcdBarrier& b) {
    asm volatile("s_waitcnt vmcnt(0)" ::: "memory");
    __syncthreads();
    if (threadIdx.x == 0) {
        unsigned* bar = b.bar;
        __builtin_amdgcn_s_waitcnt(0);
        unsigned nloc = b.st[0], nx = b.st[1];
        if (nloc == 0u) { xcd_barrier_complete(bar, b.x, nloc, nx); b.st[0] = nloc; b.st[1] = nx; }
        const unsigned old = xb_add(&bar[XB_XSUB(b.x)], 1u);
        const unsigned gen = old / nloc;
        if (old + 1u == (gen + 1u) * nloc) {
            __builtin_amdgcn_fence(__ATOMIC_RELEASE, "agent");
            asm volatile("s_waitcnt vmcnt(0)" ::: "memory");
            const unsigned og = xb_add(&bar[XB_TOP], 1u);
            const unsigned tg = og / nx;
            if (og + 1u == (tg + 1u) * nx) xb_add(&bar[XB_TOPGEN], 1u);
            else XB_SPIN(xb_ld(&bar[XB_TOPGEN]) == tg, bar);
            __builtin_amdgcn_fence(__ATOMIC_ACQUIRE, "agent");
            xb_add(&bar[XB_XGEN(b.x)], 1u);
            asm volatile("s_waitcnt vmcnt(0)" ::: "memory");
        } else {
            XB_SPIN(xb_ld(&bar[XB_XGEN(b.x)]) == gen, bar);
            __builtin_amdgcn_fence(__ATOMIC_ACQUIRE, "agent");
            asm volatile("s_waitcnt vmcnt(0)" ::: "memory");
        }
    }
    __syncthreads();
}
#ifdef HOST_TEST
#define LASQ
#define MFMA32(a, b, c) emu_mfma_32x32x16((a), (b), (c))
#define TR16(p) emu_ds_read_tr16_b64((const void*)(p))
#define RFL(x) (x)
#define EXP2(x) exp2f(x)
#define LOG2(x) log2f(x)
#define DEVFN inline
#define LAUNDER(x)
#define SETPRIO(x)
#define ROR16(x, n) emu_ror16((x), (n))
#define SCHEDBAR()
#define __any(x) emu_any(x)
namespace pg8 { struct Unit { int pm, pn; }; constexpr int BM = 256, HALF = 128; }
static inline unsigned cvtpk(float lo, float hi) { return (unsigned)f2bf(lo) | ((unsigned)f2bf(hi) << 16); }
#else
#define LASQ __attribute__((address_space(3)))
#define MFMA32(a, b, c) __builtin_amdgcn_mfma_f32_32x32x16_bf16((a), (b), (c), 0, 0, 0)
typedef short v4i16_t __attribute__((ext_vector_type(4)));
typedef short s16x4 __attribute__((ext_vector_type(4)));
typedef float f32x16 __attribute__((ext_vector_type(16)));
typedef unsigned u32x2 __attribute__((ext_vector_type(2)));
typedef unsigned u32x4 __attribute__((ext_vector_type(4)));
#define TR16(p) __builtin_bit_cast(s16x4, __builtin_amdgcn_ds_read_tr16_b64_v4i16((LASQ v4i16_t*)(p)))
#define RFL(x) __builtin_amdgcn_readfirstlane(x)
#define EXP2(x) __builtin_amdgcn_exp2f(x)
#define LOG2(x) __builtin_amdgcn_logf(x)
#define DEVFN __device__ __forceinline__
#define LAUNDER(x) asm volatile("" : "+v"(x))
#define SETPRIO(x) __builtin_amdgcn_s_setprio(x)
#define ROR16(x, n) __builtin_bit_cast(float, __builtin_amdgcn_update_dpp(0, __builtin_bit_cast(int, (float)(x)), 0x120 + (n), 0xf, 0xf, false))
#define SCHEDBAR() __builtin_amdgcn_sched_barrier(0)
typedef float f32x2_t __attribute__((ext_vector_type(2))); typedef __bf16 bf16x2_t __attribute__((ext_vector_type(2)));
__device__ __forceinline__ unsigned cvtpk(float lo, float hi) { f32x2_t v = {lo, hi}; bf16x2_t b = __builtin_convertvector(v, bf16x2_t); return __builtin_bit_cast(unsigned, b); }
#endif
typedef LASQ unsigned char* ldsp_t;
#ifdef HOST_TEST
#define RCP(x) (1.0f / (x))
#define RSQ(x) (1.0f / sqrtf(x))
#else
#define RCP(x) __builtin_amdgcn_rcpf(x)
#define RSQ(x) __builtin_amdgcn_rsqf(x)
#endif
DEVFN float silu_fast(float x) { return x * RCP(1.0f + EXP2(-x * LOG2E)); }

DEVFN bf16x8 pack8(const f32x16& p, int b) {
    u32x4 w; w.x = cvtpk(p[b], p[b + 1]); w.y = cvtpk(p[b + 2], p[b + 3]); w.z = cvtpk(p[b + 4], p[b + 5]); w.w = cvtpk(p[b + 6], p[b + 7]);
    return __builtin_bit_cast(bf16x8, w);
}
DEVFN bf16x8 cat44(s16x4 a, s16x4 b) { return (bf16x8){a[0], a[1], a[2], a[3], b[0], b[1], b[2], b[3]}; }
DEVFN void unpack4(u32x2 w, float* o) { unsigned u; u = w.x << 16; __builtin_memcpy(&o[0], &u, 4); u = w.x & 0xffff0000u; __builtin_memcpy(&o[1], &u, 4); u = w.y << 16; __builtin_memcpy(&o[2], &u, 4); u = w.y & 0xffff0000u; __builtin_memcpy(&o[3], &u, 4); }
DEVFN float wave_sum64(float v) { UNR for (int o = 1; o < 64; o <<= 1) v += __shfl_xor(v, o); return v; }
DEVFN float max16(const f32x16& p) { float a = fmaxf(fmaxf(p[0], p[1]), fmaxf(p[2], p[3])), b = fmaxf(fmaxf(p[4], p[5]), fmaxf(p[6], p[7])), c = fmaxf(fmaxf(p[8], p[9]), fmaxf(p[10], p[11])), d = fmaxf(fmaxf(p[12], p[13]), fmaxf(p[14], p[15])); return fmaxf(fmaxf(a, b), fmaxf(c, d)); }
DEVFN float sum16(const f32x16& p) { return ((p[0] + p[1]) + (p[2] + p[3])) + ((p[4] + p[5]) + (p[6] + p[7])) + (((p[8] + p[9]) + (p[10] + p[11])) + ((p[12] + p[13]) + (p[14] + p[15]))); }

constexpr int AT_KP = 144, AT_VP = 192, AT_SUB = 64 * AT_KP + 64 * AT_VP;
#ifndef AT_THR_V
#define AT_THR_V 3.0f
#endif
#ifndef AT_BIG_V
#define AT_BIG_V 4096.0f
#endif
#ifndef AT_FORCE_SLOW
#define AT_FORCE_SLOW false
#endif
constexpr float AT_BIG = AT_BIG_V, AT_TINY = 1e-20f;
constexpr float AT_THR = AT_THR_V;

template <int MODE> DEVFN int attn_tile_row(int ub, bool uctxq, int ug4, int j) {
    if (uctxq) return ML + ub * CTX + 64 * j;
    if (MODE == 0) return j < SEQ / 64 ? ub * SEQ + 64 * j : ML + ub * CTX + 64 * (j - SEQ / 64);
    const int kr0 = clampi(ug4 - 4, 0, ROWS - 8), kr1 = clampi(ug4 + 3 - 4, 0, ROWS - 8) + 8, nwin = kr1 - kr0;
    return j < nwin ? ub * SEQ + (kr0 + j) * GRID_W : ML + ub * CTX + 64 * (j - nwin);
}
struct AU { int b, h, q0, ntiles, g4; bool ctxq; };
template <int MODE, int TPI> DEVFN void attn_unit(const Params& p, int l, int ub, int uh, int uq0, int untiles, bool uctxq, int ug4, ldsp_t lds, float lam, float lam_init) {
    constexpr int NC = MODE == 0 ? 2 : 1, KS = MODE == 0 ? 2 : 4;
    constexpr int CQ = MODE == 0 ? C_QB : C_QA, CK = MODE == 0 ? C_KB : C_KA, CV = MODE == 0 ? C_VB : C_VA, MO = MODE == 0 ? MO_B : MO_A;
    constexpr int SLOT = TPI * AT_SUB;
    int tid = threadIdx.x; LAUNDER(tid); const int lane = tid & 63, wid = RFL(tid >> 6), r32 = lane & 31, hh = lane >> 5;
    const int qrow = uq0 + wid * 32 + r32;
    bf16x8 qf[NC][KS];
    { const bf16* qp = p.P + (size_t)qrow * PW + CQ + uh * 64 + 8 * hh;
      UNR for (int c = 0; c < NC; ++c) UNR for (int ks = 0; ks < KS; ++ks) qf[c][ks] = *(const bf16x8*)(qp + c * 32 + 16 * ks); }
    int na_r = 0, na_w = 0, na_r0 = 0, na_c0 = 0, na_kr0 = 0, na_nwin = 0;
    if (MODE == 1 && !uctxq) { na_r = ug4 + (wid >> 1); na_w = 32 * (wid & 1) + r32; na_r0 = clampi(na_r - 4, 0, ROWS - 8); na_c0 = clampi(na_w - 8, 0, GRID_W - 16);
        na_kr0 = clampi(ug4 - 4, 0, ROWS - 8); na_nwin = clampi(ug4 + 3 - 4, 0, ROWS - 8) + 8 - na_kr0; }
    LASQ float* rpbl = (LASQ float*)(lds + 2 * SLOT);
    if (MODE == 1) { for (int i = tid; i < 15 * 31; i += 512) rpbl[i] = p.rpb_a[((size_t)l * NAH + uh) * 465 + i] * LOG2E; }
    float m_run[NC], l_run[NC]; f32x16 o[NC][2];
    UNR for (int c = 0; c < NC; ++c) { m_run[c] = 0.f; l_run[c] = 0.f; UNR for (int t = 0; t < 2; ++t) UNR for (int i = 0; i < 16; ++i) o[c][t][i] = 0.f; }
    bool first = true;
    const int srow = tid >> 3, spc = tid & 7;
    u32x4 kreg[TPI], vreg[TPI];
    const int nit = (untiles + TPI - 1) / TPI;
    UNR for (int s = 0; s < TPI; ++s) { const int jt = s < untiles ? s : untiles - 1; const bf16* g = p.P + (size_t)(attn_tile_row<MODE>(ub, uctxq, ug4, jt) + srow) * PW + uh * 64 + 8 * spc; kreg[s] = *(const u32x4*)(g + CK); vreg[s] = *(const u32x4*)(g + CV); }
    UNR for (int s = 0; s < TPI; ++s) { *(LASQ u32x4*)(lds + s * AT_SUB + srow * AT_KP + 16 * spc) = kreg[s]; *(LASQ u32x4*)(lds + s * AT_SUB + 64 * AT_KP + srow * AT_VP + 16 * spc) = vreg[s]; }
    __syncthreads();
    int cur = 0;
    for (int it = 0; it < nit; ++it) {
        const bool more = it + 1 < nit;
        UNR for (int s = 0; s < TPI; ++s) {
            if (more && s == TPI - 1) { UNR for (int s2 = 0; s2 < TPI; ++s2) { int jt = (it + 1) * TPI + s2; jt = jt < untiles ? jt : untiles - 1;
                const bf16* g = p.P + (size_t)(attn_tile_row<MODE>(ub, uctxq, ug4, jt) + srow) * PW + uh * 64 + 8 * spc; kreg[s2] = *(const u32x4*)(g + CK); vreg[s2] = *(const u32x4*)(g + CV); } }
            const int j = it * TPI + s;
            const ldsp_t kb = lds + cur * SLOT + s * AT_SUB, vb = kb + 64 * AT_KP;
            bool active = j < untiles; int kr = 0;
            if (MODE == 1 && !uctxq && j < na_nwin) { kr = na_kr0 + j; active = kr >= na_r0 && kr < na_r0 + 8; }
            if (active) {
                bf16x8 pb[NC][4];
                UNR for (int c = 0; c < NC; ++c) {
                    f32x16 s0, s1; { const float nm = -m_run[c]; UNR for (int i = 0; i < 16; ++i) { s0[i] = nm; s1[i] = nm; } }
                    UNR for (int ks = 0; ks < KS; ++ks) {
                        const bf16x8 k0 = *(const LASQ bf16x8*)(kb + r32 * AT_KP + (c * 32 + 16 * ks + 8 * hh) * 2);
                        const bf16x8 k1 = *(const LASQ bf16x8*)(kb + (32 + r32) * AT_KP + (c * 32 + 16 * ks + 8 * hh) * 2);
                        s0 = MFMA32(k0, qf[c][ks], s0); s1 = MFMA32(k1, qf[c][ks], s1);
                    }
                    if (MODE == 1 && !uctxq && j < na_nwin) {
                        const LASQ float* rb = rpbl + (kr - na_r + 7) * 31 + 15 - na_w;
                        UNR for (int i = 0; i < 16; ++i) { const int kc = (i & 3) + 8 * (i >> 2) + 4 * hh;
                            s0[i] = (kc >= na_c0 && kc < na_c0 + 16) ? s0[i] + rb[kc] : -1e30f;
                            s1[i] = (kc + 32 >= na_c0 && kc + 32 < na_c0 + 16) ? s1[i] + rb[kc + 32] : -1e30f; }
                    }
                    float rm = fmaxf(max16(s0), max16(s1)); rm = fmaxf(rm, __shfl_xor(rm, 32));
                    if (first || __any(rm > AT_THR)) {
                        const float dl = first ? rm : fmaxf(rm, 0.f); const float al = EXP2(-dl);
                        m_run[c] += dl; l_run[c] *= al;
                        UNR for (int t = 0; t < 2; ++t) UNR for (int i = 0; i < 16; ++i) o[c][t][i] *= al;
                        UNR for (int i = 0; i < 16; ++i) { s0[i] -= dl; s1[i] -= dl; }
                    }
                    UNR for (int i = 0; i < 16; ++i) { s0[i] = EXP2(s0[i]); s1[i] = EXP2(s1[i]); }
                    l_run[c] += sum16(s0) + sum16(s1);
                    pb[c][0] = pack8(s0, 0); pb[c][1] = pack8(s0, 8); pb[c][2] = pack8(s1, 0); pb[c][3] = pack8(s1, 8);
                }
                { const int gi = lane & 15; const ldsp_t vp = vb + (4 * hh + (gi >> 2)) * AT_VP + (16 * ((lane >> 4) & 1) + 4 * (gi & 3)) * 2;
                  UNR for (int t = 0; t < 2; ++t) { bf16x8 vf[4];
                      UNR for (int g = 0; g < 4; ++g) vf[g] = cat44(TR16(vp + 16 * g * AT_VP + t * 64), TR16(vp + (16 * g + 8) * AT_VP + t * 64));
                      UNR for (int g = 0; g < 4; ++g) UNR for (int c = 0; c < NC; ++c) o[c][t] = MFMA32(vf[g], pb[c][g], o[c][t]); } }
                first = false;
            }
        }
        if (more) { const ldsp_t nk = lds + (cur ^ 1) * SLOT;
            UNR for (int s = 0; s < TPI; ++s) { *(LASQ u32x4*)(nk + s * AT_SUB + srow * AT_KP + 16 * spc) = kreg[s]; *(LASQ u32x4*)(nk + s * AT_SUB + 64 * AT_KP + srow * AT_VP + 16 * spc) = vreg[s]; } }
        __syncthreads();
        cur ^= 1;
    }
    float res[2][16];
    if (MODE == 0) {
        const float L0 = l_run[0] + __shfl_xor(l_run[0], 32), L1 = l_run[NC - 1] + __shfl_xor(l_run[NC - 1], 32);
        const float i0 = 1.0f / L0, i1 = lam / L1; float ss = 0.f;
        UNR for (int t = 0; t < 2; ++t) UNR for (int i = 0; i < 16; ++i) { res[t][i] = o[0][t][i] * i0 - o[NC - 1][t][i] * i1; ss += res[t][i] * res[t][i]; }
        ss += __shfl_xor(ss, 32);
        const float r = 1.0f / sqrtf(ss / 64 + EPS) * (1.0f - lam_init);
        UNR for (int t = 0; t < 2; ++t) UNR for (int i = 0; i < 16; ++i) res[t][i] *= r * p.subln_b[l * 64 + 32 * t + (i & 3) + 8 * (i >> 2) + 4 * hh];
    } else {
        const float L0 = l_run[0] + __shfl_xor(l_run[0], 32), i0 = 1.0f / L0;
        UNR for (int t = 0; t < 2; ++t) UNR for (int i = 0; i < 16; ++i) res[t][i] = o[0][t][i] * i0;
    }
    bf16* op = p.XN + (size_t)qrow * D + MO + uh * 64 + 4 * hh;
    UNR for (int t = 0; t < 2; ++t) UNR for (int g = 0; g < 4; ++g) { u32x2 w; w.x = cvtpk(res[t][4 * g], res[t][4 * g + 1]); w.y = cvtpk(res[t][4 * g + 2], res[t][4 * g + 3]); *(u32x2*)(op + 32 * t + 8 * g) = w; }
}

template <int MODE> struct AttnState {
    static constexpr int NC = MODE == 0 ? 2 : 1, KS = MODE == 0 ? 2 : 4;
    bf16x8 qf[NC][KS]; float m_run[NC], l_run[NC]; f32x16 o[NC][2]; bool slow;
    int na_r, na_w, na_r0, na_c0, na_kr0, na_nwin;
};
template <int MODE> DEVFN bool attn_active(const AttnState<MODE>& A, bool uctxq, int untiles, int t) {
    if (t >= untiles) return false;
    if (MODE == 1 && !uctxq && t < A.na_nwin) { const int kr = A.na_kr0 + t; return kr >= A.na_r0 && kr < A.na_r0 + 8; }
    return true;
}
template <int MODE, int ABL = 0> DEVFN void attn_kload(int c, ldsp_t kb, int r32, int hh, bf16x8 (&kf)[2 * AttnState<MODE>::KS]) {
    if (ABL & 64) { UNR for (int i = 0; i < 2 * AttnState<MODE>::KS; ++i) kf[i] = (bf16x8){(short)r32, 1, 2, 3, 4, 5, (short)c, (short)i}; return; }
    UNR for (int ks = 0; ks < AttnState<MODE>::KS; ++ks) {
        kf[2 * ks] = *(const LASQ bf16x8*)(kb + r32 * AT_KP + (c * 32 + 16 * ks + 8 * hh) * 2);
        kf[2 * ks + 1] = *(const LASQ bf16x8*)(kb + (32 + r32) * AT_KP + (c * 32 + 16 * ks + 8 * hh) * 2); }
}
template <int MODE, int ABL = 0> DEVFN void attn_qk(const AttnState<MODE>& A, int c, const bf16x8 (&kf)[2 * AttnState<MODE>::KS], f32x16& s0, f32x16& s1, bool slow) {
    const float nm = slow ? -A.m_run[c] : 0.f; UNR for (int i = 0; i < 16; ++i) { s0[i] = nm; s1[i] = nm; }
    UNR for (int ks = 0; ks < AttnState<MODE>::KS; ++ks) {
        if ((ABL & 4) || ((ABL & 128) && (threadIdx.x >= 256))) { s0[0] += __builtin_bit_cast(float, (int)kf[2 * ks][0]); s1[0] += __builtin_bit_cast(float, (int)kf[2 * ks + 1][0]); } else { s0 = MFMA32(kf[2 * ks], A.qf[c][ks], s0); s1 = MFMA32(kf[2 * ks + 1], A.qf[c][ks], s1); }
    }
}
template <int MODE, int ABL = 0> DEVFN void attn_softmax(AttnState<MODE>& A, int c, bool uctxq, int t, const LASQ float* rpbl, int hh, f32x16& s0, f32x16& s1, bf16x8 (&pb)[4], f32x16& n0, f32x16& n1, bool next_issued) {
    if (MODE == 1 && !uctxq && t < A.na_nwin) {
        const int kr = A.na_kr0 + t; const LASQ float* rb = rpbl + (kr - A.na_r + 7) * 31 + 15 - A.na_w;
        UNR for (int i = 0; i < 16; ++i) { const int kc = (i & 3) + 8 * (i >> 2) + 4 * hh;
            s0[i] = (kc >= A.na_c0 && kc < A.na_c0 + 16) ? s0[i] + rb[kc] : -1e30f;
            s1[i] = (kc + 32 >= A.na_c0 && kc + 32 < A.na_c0 + 16) ? s1[i] + rb[kc + 32] : -1e30f; }
    }
    if (A.slow) {
    float rm = fmaxf(max16(s0), max16(s1)); rm = fmaxf(rm, __shfl_xor(rm, 32));
    if (__any(rm > AT_THR)) {
        const float dl = fmaxf(rm, 0.f); const float al = EXP2(-dl);
        A.m_run[c] += dl; A.l_run[c] *= al;
        UNR for (int tt = 0; tt < 2; ++tt) UNR for (int i = 0; i < 16; ++i) A.o[c][tt][i] *= al;
        UNR for (int i = 0; i < 16; ++i) { s0[i] -= dl; s1[i] -= dl; }
        if (AttnState<MODE>::NC == 1 && next_issued) { UNR for (int i = 0; i < 16; ++i) { n0[i] -= dl; n1[i] -= dl; } }
    }
    }
    if (!(ABL & 1) && !((ABL & 128) && (threadIdx.x < 256))) { UNR for (int i = 0; i < 16; ++i) { s0[i] = EXP2(s0[i]); s1[i] = EXP2(s1[i]); } }
    const float ts = sum16(s0) + sum16(s1);
    A.l_run[c] += ts;
    if (!A.slow) { if (__any(ts > AT_BIG || !(A.l_run[c] > AT_TINY))) A.slow = true; }
    pb[0] = pack8(s0, 0); pb[1] = pack8(s0, 8); pb[2] = pack8(s1, 0); pb[3] = pack8(s1, 8);
}
template <int ABL = 0> DEVFN void attn_vload(ldsp_t vb, int lane, int hh, int tt, bf16x8 (&vf)[4]) {
    if (ABL & 32) { UNR for (int g = 0; g < 4; ++g) vf[g] = (bf16x8){(short)lane, 1, 2, 3, 4, 5, 6, (short)g}; return; }
    const int gi = lane & 15; const ldsp_t vp = vb + (4 * hh + (gi >> 2)) * AT_VP + (16 * ((lane >> 4) & 1) + 4 * (gi & 3)) * 2 + tt * 64;
    UNR for (int g = 0; g < 4; ++g) vf[g] = cat44(TR16(vp + 16 * g * AT_VP), TR16(vp + (16 * g + 8) * AT_VP));
}
template <int MODE, int ABL = 0> DEVFN void attn_pv(AttnState<MODE>& A, int c, int tt, const bf16x8 (&vf)[4], const bf16x8 (&pb)[4]) {
    UNR for (int g = 0; g < 4; ++g) { if ((ABL & 2) || ((ABL & 128) && (threadIdx.x >= 256))) A.o[c][tt][0] += (float)(vf[g][0] + pb[g][0]); else A.o[c][tt] = MFMA32(vf[g], pb[g], A.o[c][tt]); }
}

template <int MODE, int DEAD = 0> DEVFN float attn_fast_p(const AttnState<MODE>& A, bool uctxq, int t, const LASQ float* rpbl, int hh, const f32x16& s0, const f32x16& s1, bf16x8 (&pb)[4]) {
    const bool na_win = DEAD != 0 || (MODE == 1 && !uctxq && t < A.na_nwin);
    const LASQ float* rb = rpbl; if (na_win) rb = rpbl + (A.na_kr0 + t - A.na_r + 7) * 31 + 15 - A.na_w;
    float ts = 0.f;
    UNR for (int g = 0; g < 4; ++g) { float e[8];
        if ((DEAD == 1 && g == 3) || (DEAD == 2 && g == 0)) { pb[g] = (bf16x8){0, 0, 0, 0, 0, 0, 0, 0}; continue; }
        UNR for (int j = 0; j < 8; ++j) { const int i = 8 * (g & 1) + j; float x = g < 2 ? s0[i] : s1[i];
            if ((DEAD == 1 && g == 2 && j >= 4) || (DEAD == 2 && g == 1 && j < 4)) { e[j] = 0.f; continue; }
            if (na_win) { const int kc = (i & 3) + 8 * (i >> 2) + 4 * hh + (g < 2 ? 0 : 32); x = (kc >= A.na_c0 && kc < A.na_c0 + 16) ? x + rb[kc] : -1e30f; }
            e[j] = EXP2(x); }
        ts += ((e[0] + e[1]) + (e[2] + e[3])) + ((e[4] + e[5]) + (e[6] + e[7]));
        u32x4 w; w.x = cvtpk(e[0], e[1]); w.y = cvtpk(e[2], e[3]); w.z = cvtpk(e[4], e[5]); w.w = cvtpk(e[6], e[7]); pb[g] = __builtin_bit_cast(bf16x8, w); }
    return ts;
}
template <int DEAD = 0> DEVFN void attn_vload8(ldsp_t vb, int lane, int hh, bf16x8 (&vf)[2][4]) {
    const int gi = lane & 15; const ldsp_t vp = vb + (4 * hh + (gi >> 2)) * AT_VP + (16 * ((lane >> 4) & 1) + 4 * (gi & 3)) * 2;
    UNR for (int g = 0; g < 4; ++g) { if ((DEAD == 1 && g == 3) || (DEAD == 2 && g == 0)) continue; vf[0][g] = cat44(TR16(vp + 16 * g * AT_VP), TR16(vp + (16 * g + 8) * AT_VP)); vf[1][g] = cat44(TR16(vp + 16 * g * AT_VP + 64), TR16(vp + (16 * g + 8) * AT_VP + 64)); }
}
template <int MODE, bool DO_QK, int ABL = 0, int DEAD = 0> DEVFN void attn_fast_stepA(AttnState<MODE>& A, int c, int cn, bool uctxq, int t, const LASQ float* rpbl, int lane, int r32, int hh,
                                                           ldsp_t vb, ldsp_t kbn, const f32x16& s0, const f32x16& s1, f32x16& n0, f32x16& n1, bf16x8 (&vf)[2][4]) {
    constexpr int KS = AttnState<MODE>::KS;
    bf16x8 kf[2 * KS]; bf16x8 pb[4];
    attn_vload8<DEAD>(vb, lane, hh, vf);
    if (DO_QK) attn_kload<MODE, ABL>(cn, kbn, r32, hh, kf);
    const float ts = attn_fast_p<MODE, DEAD>(A, uctxq, t, rpbl, hh, s0, s1, pb);
    UNR for (int g = 0; g < 4; ++g) { if ((DEAD == 1 && g == 3) || (DEAD == 2 && g == 0)) continue; A.o[c][0] = MFMA32(vf[0][g], pb[g], A.o[c][0]); A.o[c][1] = MFMA32(vf[1][g], pb[g], A.o[c][1]); }
    if (DO_QK) { UNR for (int i = 0; i < 16; ++i) { n0[i] = 0.f; n1[i] = 0.f; }
        UNR for (int ks = 0; ks < KS; ++ks) { n0 = MFMA32(kf[2 * ks], A.qf[cn][ks], n0); n1 = MFMA32(kf[2 * ks + 1], A.qf[cn][ks], n1); } }
    A.l_run[c] += ts;
    if (__any(ts > AT_BIG || !(A.l_run[c] > AT_TINY))) A.slow = true;
}
template <int MODE, bool DO_QK, int ABL = 0> DEVFN void attn_fast_stepB(AttnState<MODE>& A, int c, int cn, int r32, int hh, ldsp_t kbn, const f32x16& s0, const f32x16& s1, f32x16& n0, f32x16& n1, const bf16x8 (&vf)[2][4]) {
    constexpr int KS = AttnState<MODE>::KS;
    bf16x8 kf[2 * KS];
    if (DO_QK) attn_kload<MODE, ABL>(cn, kbn, r32, hh, kf);
    float ts = 0.f;
    UNR for (int g = 0; g < 4; ++g) { float e[8];
        UNR for (int j = 0; j < 8; ++j) { const int i = 8 * (g & 1) + j; e[j] = EXP2(g < 2 ? s0[i] : s1[i]); }
        ts += ((e[0] + e[1]) + (e[2] + e[3])) + ((e[4] + e[5]) + (e[6] + e[7]));
        u32x4 w; w.x = cvtpk(e[0], e[1]); w.y = cvtpk(e[2], e[3]); w.z = cvtpk(e[4], e[5]); w.w = cvtpk(e[6], e[7]); const bf16x8 pbg = __builtin_bit_cast(bf16x8, w);
        A.o[c][0] = MFMA32(vf[0][g], pbg, A.o[c][0]); A.o[c][1] = MFMA32(vf[1][g], pbg, A.o[c][1]); }
    if (DO_QK) { UNR for (int i = 0; i < 16; ++i) { n0[i] = 0.f; n1[i] = 0.f; }
        UNR for (int ks = 0; ks < KS; ++ks) { n0 = MFMA32(kf[2 * ks], A.qf[cn][ks], n0); n1 = MFMA32(kf[2 * ks + 1], A.qf[cn][ks], n1); } }
    A.l_run[c] += ts;
    if (__any(ts > AT_BIG || !(A.l_run[c] > AT_TINY))) A.slow = true;
}

template <int MODE, int ABL = 0> DEVFN void attn_unit2(const Params& p, int l, int ub, int uh, int uq0, int untiles, bool uctxq, int ug4, ldsp_t lds, float lam, float lam_init) {
    constexpr int NC = AttnState<MODE>::NC, KS = AttnState<MODE>::KS;
    constexpr int CQ = MODE == 0 ? C_QB : C_QA, CK = MODE == 0 ? C_KB : C_KA, CV = MODE == 0 ? C_VB : C_VA, MO = MODE == 0 ? MO_B : MO_A;
    int tid = threadIdx.x; LAUNDER(tid); const int lane = tid & 63, wid = RFL(tid >> 6), r32 = lane & 31, hh = lane >> 5;
    const bool late = (wid & 1) != 0;
    const int qrow = uq0 + wid * 32 + r32;
    AttnState<MODE> A;
    { const bf16* qp = p.P + (size_t)qrow * PW + CQ + uh * 64 + 8 * hh;
      UNR for (int c = 0; c < NC; ++c) UNR for (int ks = 0; ks < KS; ++ks) A.qf[c][ks] = *(const bf16x8*)(qp + c * 32 + 16 * ks); }
    A.na_r = A.na_w = A.na_r0 = A.na_c0 = A.na_kr0 = A.na_nwin = 0;
    if (MODE == 1 && !uctxq) { A.na_r = ug4 + (wid >> 1); A.na_w = 32 * (wid & 1) + r32; A.na_r0 = clampi(A.na_r - 4, 0, ROWS - 8); A.na_c0 = clampi(A.na_w - 8, 0, GRID_W - 16);
        A.na_kr0 = clampi(ug4 - 4, 0, ROWS - 8); A.na_nwin = clampi(ug4 + 3 - 4, 0, ROWS - 8) + 8 - A.na_kr0; }
    LASQ float* rpbl = (LASQ float*)(lds + 4 * AT_SUB);
    if (MODE == 1) { for (int i = tid; i < 15 * 31; i += 512) rpbl[i] = p.rpb_a[((size_t)l * NAH + uh) * 465 + i] * LOG2E; }
    UNR for (int c = 0; c < NC; ++c) { A.m_run[c] = 0.f; A.l_run[c] = 0.f; UNR for (int t = 0; t < 2; ++t) UNR for (int i = 0; i < 16; ++i) A.o[c][t][i] = 0.f; }
    A.slow = AT_FORCE_SLOW;
    const int srow = tid >> 3, spc = tid & 7;
    u32x4 kregA, vregA;
#define kregB kregA
#define vregB vregA
#define AT_GLOAD(t, KR, VR) do { const int jt_ = (t) < untiles ? (t) : untiles - 1; const bf16* g_ = p.P + (size_t)(attn_tile_row<MODE>(ub, uctxq, ug4, jt_) + srow) * PW + uh * 64 + 8 * spc; KR = *(const u32x4*)(g_ + CK); VR = *(const u32x4*)(g_ + CV); } while (0)
#define AT_LWRITE(t, KR, VR) do { const ldsp_t d_ = lds + ((t) & 3) * AT_SUB; *(LASQ u32x4*)(d_ + srow * AT_KP + 16 * spc) = KR; *(LASQ u32x4*)(d_ + 64 * AT_KP + srow * AT_VP + 16 * spc) = VR; } while (0)
    { u32x4 k0_, v0_, k1_, v1_; AT_GLOAD(0, k0_, v0_); AT_GLOAD(1, k1_, v1_); AT_GLOAD(2, kregA, vregA); AT_LWRITE(0, k0_, v0_); AT_LWRITE(1, k1_, v1_); }
    __syncthreads();
    f32x16 x0, x1, y0, y1;
    bf16x8 kf[2 * KS];
    if (attn_active<MODE>(A, uctxq, untiles, 0)) { attn_kload<MODE>(0, lds, r32, hh, kf); attn_qk<MODE, ABL>(A, 0, kf, x0, x1, A.slow); }
#define AT_TILE_START(t) do { if (!(ABL & 8)) { AT_LWRITE((t) + 2, kregA, vregA); AT_GLOAD((t) + 3, kregA, vregA); } if (!late && !(ABL & 16)) __syncthreads(); } while (0)
#define AT_VB(t) (lds + ((t) & 3) * AT_SUB + 64 * AT_KP)
#define AT_KB(t) (lds + ((t) & 3) * AT_SUB)
    int t = 0; bf16x8 vfT[2][4];
    if (!ABL) {
        if (MODE == 0) {
            for (; t + 1 < untiles && !A.slow; ++t) {
                AT_TILE_START(t);
                attn_fast_stepA<MODE, true, ABL>(A, 0, NC - 1, uctxq, t, rpbl, lane, r32, hh, AT_VB(t), AT_KB(t), x0, x1, y0, y1, vfT);
                if (late) __syncthreads();
                attn_fast_stepB<MODE, true, ABL>(A, NC - 1, 0, r32, hh, AT_KB(t + 1), y0, y1, x0, x1, vfT);
            }
            if (!A.slow && t + 1 == untiles) {
                AT_TILE_START(t);
                attn_fast_stepA<MODE, true, ABL>(A, 0, NC - 1, uctxq, t, rpbl, lane, r32, hh, AT_VB(t), AT_KB(t), x0, x1, y0, y1, vfT);
                if (late) __syncthreads();
                attn_fast_stepB<MODE, false, ABL>(A, NC - 1, 0, r32, hh, AT_KB(t), y0, y1, x0, x1, vfT);
                ++t;
            }
        } else {
#define AT_NA_STEP(tt, sc0, sc1, sn0, sn1) do { AT_TILE_START(tt); const bool act_ = attn_active<MODE>(A, uctxq, untiles, (tt)), nact_ = attn_active<MODE>(A, uctxq, untiles, (tt) + 1); \
                if (act_) { const int dd_ = (!uctxq && (tt) < A.na_nwin) ? 1 + (wid & 1) : 0; \
                    if (nact_) { if (dd_ == 0) attn_fast_stepA<MODE, true, 0, 0>(A, 0, 0, uctxq, (tt), rpbl, lane, r32, hh, AT_VB(tt), AT_KB((tt) + 1), sc0, sc1, sn0, sn1, vfT); \
                                 else if (dd_ == 1) attn_fast_stepA<MODE, true, 0, 1>(A, 0, 0, uctxq, (tt), rpbl, lane, r32, hh, AT_VB(tt), AT_KB((tt) + 1), sc0, sc1, sn0, sn1, vfT); \
                                 else attn_fast_stepA<MODE, true, 0, 2>(A, 0, 0, uctxq, (tt), rpbl, lane, r32, hh, AT_VB(tt), AT_KB((tt) + 1), sc0, sc1, sn0, sn1, vfT); } \
                    else { if (dd_ == 0) attn_fast_stepA<MODE, false, 0, 0>(A, 0, 0, uctxq, (tt), rpbl, lane, r32, hh, AT_VB(tt), AT_KB(tt), sc0, sc1, sn0, sn1, vfT); \
                           else if (dd_ == 1) attn_fast_stepA<MODE, false, 0, 1>(A, 0, 0, uctxq, (tt), rpbl, lane, r32, hh, AT_VB(tt), AT_KB(tt), sc0, sc1, sn0, sn1, vfT); \
                           else attn_fast_stepA<MODE, false, 0, 2>(A, 0, 0, uctxq, (tt), rpbl, lane, r32, hh, AT_VB(tt), AT_KB(tt), sc0, sc1, sn0, sn1, vfT); } } \
                else if (nact_) { attn_kload<MODE>(0, AT_KB((tt) + 1), r32, hh, kf); attn_qk<MODE, 0>(A, 0, kf, sn0, sn1, false); } \
                if (late) __syncthreads(); } while (0)
            for (; t + 1 < untiles && !A.slow; t += 2) { AT_NA_STEP(t, x0, x1, y0, y1); AT_NA_STEP(t + 1, y0, y1, x0, x1); }
            if (!A.slow && t + 1 == untiles) { AT_NA_STEP(t, x0, x1, y0, y1); ++t; }
#undef AT_NA_STEP
        }
    }
#define AT_STEP(t, c, sc0, sc1, sn0, sn1) do { \
        const int t_ = (t); const int tn_ = (c) + 1 < NC ? t_ : t_ + 1; const int cn_ = (c) + 1 < NC ? (c) + 1 : 0; \
        if ((c) == 0) AT_TILE_START(t_); \
        const bool nact_ = attn_active<MODE>(A, uctxq, untiles, tn_); \
        const bool act_ = attn_active<MODE>(A, uctxq, untiles, t_); \
        if (nact_) { attn_kload<MODE, ABL>(cn_, AT_KB(tn_), r32, hh, kf); attn_qk<MODE, ABL>(A, cn_, kf, sn0, sn1, true); } \
        bf16x8 pb_[4]; bf16x8 vfa_[4], vfb_[4]; \
        if (act_) attn_vload<ABL>(AT_VB(t_), lane, hh, 0, vfa_); \
        if (act_) attn_softmax<MODE, ABL>(A, (c), uctxq, t_, rpbl, hh, sc0, sc1, pb_, sn0, sn1, nact_); \
        if ((c) == 0 && late && !(ABL & 16)) __syncthreads(); \
        if (act_) { attn_vload<ABL>(AT_VB(t_), lane, hh, 1, vfb_); attn_pv<MODE, ABL>(A, (c), 0, vfa_, pb_); attn_pv<MODE, ABL>(A, (c), 1, vfb_, pb_); } \
    } while (0)
    if (t < untiles) {
        A.slow = true;
        if (NC == 2) { for (; t < untiles; ++t) { AT_STEP(t, 0, x0, x1, y0, y1); AT_STEP(t, 1, y0, y1, x0, x1); } }
        else { if (t & 1) { AT_STEP(t, 0, y0, y1, x0, x1); ++t; }
               for (; t < untiles; t += 2) { AT_STEP(t, 0, x0, x1, y0, y1); if (t + 1 < untiles) AT_STEP(t + 1, 0, y0, y1, x0, x1); } }
    }
#undef AT_TILE_START
#undef AT_VB
#undef AT_KB
#undef AT_STEP
#undef AT_GLOAD
#undef AT_LWRITE
    __syncthreads();
    float res[2][16];
    if (MODE == 0) {
        const float L0 = A.l_run[0] + __shfl_xor(A.l_run[0], 32), L1 = A.l_run[NC - 1] + __shfl_xor(A.l_run[NC - 1], 32);
        const float i0 = 1.0f / L0, i1 = lam / L1; float ss = 0.f;
        UNR for (int t = 0; t < 2; ++t) UNR for (int i = 0; i < 16; ++i) { res[t][i] = A.o[0][t][i] * i0 - A.o[NC - 1][t][i] * i1; ss += res[t][i] * res[t][i]; }
        ss += __shfl_xor(ss, 32);
        const float r = 1.0f / sqrtf(ss / 64 + EPS) * (1.0f - lam_init);
        UNR for (int t = 0; t < 2; ++t) UNR for (int i = 0; i < 16; ++i) res[t][i] *= r * p.subln_b[l * 64 + 32 * t + (i & 3) + 8 * (i >> 2) + 4 * hh];
    } else {
        const float L0 = A.l_run[0] + __shfl_xor(A.l_run[0], 32), i0 = 1.0f / L0;
        UNR for (int t = 0; t < 2; ++t) UNR for (int i = 0; i < 16; ++i) res[t][i] = A.o[0][t][i] * i0;
    }
    bf16* op = p.XN + (size_t)qrow * D + MO + uh * 64 + 4 * hh;
    UNR for (int t = 0; t < 2; ++t) UNR for (int g = 0; g < 4; ++g) { u32x2 w; w.x = cvtpk(res[t][4 * g], res[t][4 * g + 1]); w.y = cvtpk(res[t][4 * g + 2], res[t][4 * g + 3]);
        if (ABL) { if (w.x == 0x12345678u && w.y == 0x9abcdef0u) *(u32x2*)(op + 32 * t + 8 * g) = w; } else *(u32x2*)(op + 32 * t + 8 * g) = w; }
}

template <int ABL = 0> DEVFN void ph_diff_fast(const Params& p, int l, bool with_ctx, ldsp_t lds, int bid, int nblk) {
    const float lam_init = lam_init_of(l), lam = lam_of(p, l, lam_init);
    const int nlat = BATCH * DAH * (SEQ / 256), nctx = with_ctx ? BATCH * DAH * (CTX / 256) : 0;
    for (int i0 = bid; i0 < nlat + nctx; i0 += nblk) {
        AU u; u.g4 = 0; int i = i0;
        if (i0 < nlat && nblk % 8 == 0 && nlat % nblk == 0) {
            const int rnd = i0 / nblk, b_ = i0 % nblk, per = nblk / 8; i = rnd * nblk + (b_ % 8) * per + b_ / 8; }
        if (i < nlat) { const int qb = i % (SEQ / 256), bh = i / (SEQ / 256); u.b = bh / DAH; u.h = bh % DAH; u.q0 = u.b * SEQ + 256 * qb; u.ntiles = SEQ / 64 + CTX / 64; u.ctxq = false; }
        else { const int k = i - nlat; const int qb = k % (CTX / 256), bh = k / (CTX / 256); u.b = bh / DAH; u.h = bh % DAH; u.q0 = ML + u.b * CTX + 256 * qb; u.ntiles = CTX / 64; u.ctxq = true; }
        attn_unit2<0, ABL>(p, l, u.b, u.h, u.q0, u.ntiles, u.ctxq, u.g4, lds, lam, lam_init);
    }
}
DEVFN void ph_na_fast(const Params& p, int l, bool with_ctx, ldsp_t lds, int bid, int nblk) {
    const int nlat = BATCH * NAH * (ROWS / 4), nctx = with_ctx ? BATCH * NAH * (CTX / 256) : 0;
    for (int i = bid; i < nlat + nctx; i += nblk) {
        AU u;
        if (i < nlat) { const int g = i % (ROWS / 4), bh = i / (ROWS / 4); u.b = bh / NAH; u.h = bh % NAH; u.g4 = 4 * g; u.q0 = u.b * SEQ + 256 * g; u.ctxq = false;
            const int kr0 = clampi(u.g4 - 4, 0, ROWS - 8), kr1 = clampi(u.g4 + 3 - 4, 0, ROWS - 8) + 8; u.ntiles = (kr1 - kr0) + CTX / 64; }
        else { const int k = i - nlat; const int qb = k % (CTX / 256), bh = k / (CTX / 256); u.b = bh / NAH; u.h = bh % NAH; u.g4 = 0; u.q0 = ML + u.b * CTX + 256 * qb; u.ntiles = CTX / 64; u.ctxq = true; }
        attn_unit2<1>(p, l, u.b, u.h, u.q0, u.ntiles, u.ctxq, u.g4, lds, 0.f, 0.f);
    }
}

constexpr int NCC = CTX / 64, NLC = SEQ / 64, NCH = NCC + NLC;
constexpr int GL_VP = 320, GL_KP = 144, GL_TP = 192;
constexpr int GL_G = 0, GL_W = 32768, GL_T = GL_W + 8704, GL_V = GL_T + 2048, GL_OP = GL_V + 64 * GL_VP, GL_RED = GL_OP + 6 * 64 * GL_KP, GL_LDS = GL_RED + 1024;
static_assert(GL_LDS <= 131072 && 2 * 64 * GL_TP <= 6 * 64 * GL_KP, "GLA LDS map");
DEVFN int gla_chunk_row(int b, int c) { return c < NCC ? ML + b * CTX + 64 * c : b * SEQ + 64 * (c - NCC); }
DEVFN int gla_scan_chunk(int dir, int step) { return dir == 0 ? step : (step < NCC ? NCC - 1 - step : NCC + (NLC - 1 - (step - NCC))); }

struct GlaRegs { u32x4 af, v0, v1, k, q; };
struct GlaW { bf16x8 hi, lo; float bias; };
DEVFN void gla_unit_decode(int unit, int ncu, int c_lo, int& b, int& h, int& c) { h = unit % GLH; const int r = unit / GLH; c = c_lo + r % ncu; b = r / ncu; }
DEVFN void gla_load(const Params& p, GlaRegs& R, int h, int m0, int tid, bool want_q) {
    { const int lane = tid & 63, wid = tid >> 6, dir = wid >> 2, st = (wid >> 1) & 1; R.af = *(const u32x4*)(p.AFB + (size_t)(m0 + 32 * st + (lane & 31)) * 32 + dir * 16 + 8 * (lane >> 5)); }
    { const int row = tid >> 4, pc = tid & 15; R.v0 = *(const u32x4*)(p.P + (size_t)(m0 + row) * PW + C_VC + h * 128 + 8 * pc); R.v1 = *(const u32x4*)(p.P + (size_t)(m0 + 32 + row) * PW + C_VC + h * 128 + 8 * pc); }
    { const int row = tid >> 3, d8 = (tid & 7) * 8; const bf16* pr = p.P + (size_t)(m0 + row) * PW + h * 64 + d8; R.k = *(const u32x4*)(pr + C_KC); if (want_q) R.q = *(const u32x4*)(pr + C_QC); }
}
DEVFN void unpack8(const u32x4& w, float* o) { unsigned u; u = w.x << 16; __builtin_memcpy(&o[0], &u, 4); u = w.x & 0xffff0000u; __builtin_memcpy(&o[1], &u, 4); u = w.y << 16; __builtin_memcpy(&o[2], &u, 4); u = w.y & 0xffff0000u; __builtin_memcpy(&o[3], &u, 4);
    u = w.z << 16; __builtin_memcpy(&o[4], &u, 4); u = w.z & 0xffff0000u; __builtin_memcpy(&o[5], &u, 4); u = w.w << 16; __builtin_memcpy(&o[6], &u, 4); u = w.w & 0xffff0000u; __builtin_memcpy(&o[7], &u, 4); }
DEVFN void gla_load_w(const Params& p, int l, int h, GlaW& W, int tid) {
    const int lane = tid & 63, wid = tid >> 6, dir = wid >> 2, dt = wid & 1, d = h * 64 + 32 * dt + (lane & 31), hh = lane >> 5;
    const float* w2 = (dir ? p.w_a2_b : p.w_a2_f) + (size_t)l * 16 * GK_W + d; float hi[8], lo[8];
    UNR for (int j = 0; j < 8; ++j) { const float w = w2[(size_t)(8 * hh + j) * GK_W]; hi[j] = bf2f(f2bf(w)); lo[j] = w - hi[j]; }
    u32x4 a, b2; a.x = cvtpk(hi[0], hi[1]); a.y = cvtpk(hi[2], hi[3]); a.z = cvtpk(hi[4], hi[5]); a.w = cvtpk(hi[6], hi[7]); b2.x = cvtpk(lo[0], lo[1]); b2.y = cvtpk(lo[2], lo[3]); b2.z = cvtpk(lo[4], lo[5]); b2.w = cvtpk(lo[6], lo[7]);
    W.hi = __builtin_bit_cast(bf16x8, a); W.lo = __builtin_bit_cast(bf16x8, b2); W.bias = (dir ? p.b_a_b : p.b_a_f)[(size_t)l * GK_W + d];
}
DEVFN void gla_prep(const GlaRegs& R, const GlaW& W, ldsp_t lds, int tid) {
    LASQ float* G = (LASQ float*)(lds + GL_G); LASQ float* T = (LASQ float*)(lds + GL_T);
    { const int row = tid >> 4, pc = tid & 15; *(LASQ u32x4*)(lds + GL_V + row * GL_VP + 16 * pc) = R.v0; *(LASQ u32x4*)(lds + GL_V + (32 + row) * GL_VP + 16 * pc) = R.v1; }
    { const int lane = tid & 63, wid = tid >> 6, dir = wid >> 2, st = (wid >> 1) & 1, dt = wid & 1, hh = lane >> 5;
      f32x16 x; UNR for (int i = 0; i < 16; ++i) x[i] = W.bias;
      const bf16x8 a = __builtin_bit_cast(bf16x8, R.af);
      x = MFMA32(a, W.hi, x); x = MFMA32(a, W.lo, x);
      float g[16], pf[16], gt[4], pt[4], off[4];
      UNR for (int i = 0; i < 16; ++i) g[i] = (fminf(x[i], 0.f) - 0.6931471805599453f * LOG2(1.0f + EXP2(-fabsf(x[i]) * LOG2E))) * (1.0f / 16.0f);
      UNR for (int j = 0; j < 4; ++j) {
          if (dir == 0) { pf[4 * j] = g[4 * j]; pf[4 * j + 1] = pf[4 * j] + g[4 * j + 1]; pf[4 * j + 2] = pf[4 * j + 1] + g[4 * j + 2]; pf[4 * j + 3] = pf[4 * j + 2] + g[4 * j + 3]; gt[j] = pf[4 * j + 3]; }
          else { pf[4 * j + 3] = g[4 * j + 3]; pf[4 * j + 2] = pf[4 * j + 3] + g[4 * j + 2]; pf[4 * j + 1] = pf[4 * j + 2] + g[4 * j + 1]; pf[4 * j] = pf[4 * j + 1] + g[4 * j]; gt[j] = pf[4 * j]; } }
      UNR for (int j = 0; j < 4; ++j) pt[j] = __shfl_xor(gt[j], 32);
      float run = 0.f;
      if (dir == 0) { UNR for (int j = 0; j < 4; ++j) { off[j] = run + (hh ? pt[j] : 0.f); run += gt[j] + pt[j]; } }
      else { UNR for (int j = 3; j >= 0; --j) { off[j] = run + (hh ? 0.f : pt[j]); run += gt[j] + pt[j]; } }
      UNR for (int i = 0; i < 16; ++i) { const int s = 32 * st + (i & 3) + 8 * (i >> 2) + 4 * hh; G[(dir * 64 + s) * 64 + 32 * dt + (lane & 31)] = pf[i] + off[i >> 2]; }
      if (hh == 0) T[(dir * 2 + st) * 64 + 32 * dt + (lane & 31)] = run; }
    __syncthreads();
}
DEVFN void gla_off8(ldsp_t lds, int dir, int row, int d8, float* o) {
    const LASQ float* T = (const LASQ float*)(lds + GL_T); const bool need = dir == 0 ? row >= 32 : row < 32;
    UNR for (int e = 0; e < 8; ++e) o[e] = need ? T[(dir * 2 + dir) * 64 + d8 + e] : 0.f;
}

DEVFN void ph_gla_A(const Params& p, int l, ldsp_t lds, int bid, int nblk) {
    int tid = threadIdx.x; LAUNDER(tid); const int lane = tid & 63, wid = RFL(tid >> 6), r32 = lane & 31, hh = lane >> 5, gi = lane & 15;
    const LASQ float* G = (const LASQ float*)(lds + GL_G);
    const int nunits = BATCH * GLH * NCH; int cur_h = -1;
    GlaRegs R; GlaW GW; int b, h, c;
    if (bid < nunits) { gla_unit_decode(bid, NCH, 0, b, h, c); gla_load(p, R, h, gla_chunk_row(b, c), tid, false); }
    for (int unit = bid; unit < nunits; unit += nblk) {
        gla_unit_decode(unit, NCH, 0, b, h, c); const int bh = b * GLH + h;
        if (h != cur_h) { gla_load_w(p, l, h, GW, tid); cur_h = h; }
        gla_prep(R, GW, lds, tid);
        { const int row = tid >> 3, d8 = (tid & 7) * 8; float k8[8]; unpack8(R.k, k8);
          UNR for (int dir = 0; dir < 2; ++dir) { const LASQ float* bl = G + (dir * 64 + (dir ? 0 : 63)) * 64 + d8; const LASQ float* bs = G + (dir * 64 + row) * 64 + d8; float o8[8], ol[8], os[8];
              gla_off8(lds, dir, dir ? 0 : 63, d8, ol); gla_off8(lds, dir, row, d8, os);
              UNR for (int e = 0; e < 8; ++e) o8[e] = k8[e] * EXP2(((bl[e] + ol[e]) - (bs[e] + os[e])) * LOG2E);
              u32x4 w; w.x = cvtpk(o8[0], o8[1]); w.y = cvtpk(o8[2], o8[3]); w.z = cvtpk(o8[4], o8[5]); w.w = cvtpk(o8[6], o8[7]);
              *(LASQ u32x4*)(lds + GL_OP + dir * 64 * GL_TP + row * GL_TP + d8 * 2) = w; } }
        if (tid < 128) { const int dir = tid >> 6, d = tid & 63; const LASQ float* T_ = (const LASQ float*)(lds + GL_T);
            p.AD[((size_t)(bh * 2 + dir) * NCH + c) * 64 + d] = EXP2((G[(dir * 64 + (dir ? 0 : 63)) * 64 + d] + T_[(dir * 2 + dir) * 64 + d]) * LOG2E); }
        if (unit + nblk < nunits) { int b2, h2, c2; gla_unit_decode(unit + nblk, NCH, 0, b2, h2, c2); gla_load(p, R, h2, gla_chunk_row(b2, c2), tid, false); }
        __syncthreads();
        const int vt = wid >> 1, dt = wid & 1;
        UNR for (int dir = 0; dir < 2; ++dir) {
            f32x16 u; UNR for (int i = 0; i < 16; ++i) u[i] = 0.f;
            const ldsp_t vp = lds + GL_V + (8 * hh + (gi >> 2)) * GL_VP + (32 * vt + 16 * ((lane >> 4) & 1) + 4 * (gi & 3)) * 2;
            const ldsp_t kp = lds + GL_OP + dir * 64 * GL_TP + (8 * hh + (gi >> 2)) * GL_TP + (32 * dt + 16 * ((lane >> 4) & 1) + 4 * (gi & 3)) * 2;
            UNR for (int ks = 0; ks < 4; ++ks) { const bf16x8 va = cat44(TR16(vp + 16 * ks * GL_VP), TR16(vp + (16 * ks + 4) * GL_VP)); const bf16x8 kb = cat44(TR16(kp + 16 * ks * GL_TP), TR16(kp + (16 * ks + 4) * GL_TP));
                u = MFMA32(va, kb, u); }
            bf16* ub = (bf16*)(p.US + ((size_t)(bh * 2 + dir) * NCH + c) * 8192) + 32 * dt + r32;
            UNR for (int i = 0; i < 16; ++i) ub[(size_t)(32 * vt + (i & 3) + 8 * (i >> 2) + 4 * hh) * 64] = f2bf(u[i]);
        }
        __syncthreads();
    }
}

DEVFN void ph_gla_B(const Params& p, int bid, int nblk) {
    int tid = threadIdx.x; LAUNDER(tid);
    constexpr int PD = (NCH % 17 == 0) ? 17 : 4;
    static_assert(NCH % PD == 0, "scan pipelining");
    for (int unit = bid; unit < BATCH * GLH * 2 * 4; unit += nblk) {
        const int vq = unit & 3, dir = (unit >> 2) & 1, bh = unit >> 3;
        f32x4 S = {0.f, 0.f, 0.f, 0.f};
        u32x2 Un[PD]; f32x4 an[PD];
#define UBASE(step) ((size_t)(bh * 2 + dir) * NCH + gla_scan_chunk(dir, (step)))
        UNR for (int k = 0; k < PD; ++k) { const size_t blk = UBASE(k); Un[k] = *(const u32x2*)((const bf16*)(p.US + blk * 8192) + vq * 2048 + 4 * tid); an[k] = *(const f32x4*)(p.AD + blk * 64 + 4 * (tid & 15)); }
        for (int step = 0; step < NCH; step += PD) {
            UNR for (int k = 0; k < PD; ++k) {
                const size_t blk = UBASE(step + k); float U[4]; unpack4(Un[k], U); const f32x4 a = an[k];
                if (step + k + PD < NCH) { const size_t nb = UBASE(step + k + PD); Un[k] = *(const u32x2*)((const bf16*)(p.US + nb * 8192) + vq * 2048 + 4 * tid); an[k] = *(const f32x4*)(p.AD + nb * 64 + 4 * (tid & 15)); }
                u32x2 w; w.x = cvtpk(S[0], S[1]); w.y = cvtpk(S[2], S[3]);
                __hip_atomic_store((unsigned long long*)((bf16*)(p.US + blk * 8192) + 8192 + vq * 2048 + 4 * tid), (unsigned long long)w.x | ((unsigned long long)w.y << 32), __ATOMIC_RELAXED, __HIP_MEMORY_SCOPE_AGENT);
                UNR for (int e = 0; e < 4; ++e) S[e] = a[e] * S[e] + U[e];
            }
        }
#undef UBASE
    }
}

DEVFN void ph_gla_C(const Params& p, int l, bool with_ctx, ldsp_t lds, int bid, int nblk) {
    int tid = threadIdx.x; LAUNDER(tid); const int lane = tid & 63, wid = RFL(tid >> 6), r32 = lane & 31, hh = lane >> 5, gi = lane & 15;
    const LASQ float* G = (const LASQ float*)(lds + GL_G); LASQ float* RED = (LASQ float*)(lds + GL_RED);
    const int c_lo = with_ctx ? 0 : NCC, ncu = NCH - c_lo; const int nunits = BATCH * GLH * ncu; int cur_h = -1;
    GlaRegs R; GlaW GW; int b, h, c;
    float onw[16]; { const int vt_ = wid >> 1; UNR for (int i = 0; i < 16; ++i) onw[i] = p.onorm_c[l * 128 + 32 * vt_ + 8 * (i >> 2) + 4 * hh + (i & 3)]; }
    if (bid < nunits) { gla_unit_decode(bid, ncu, c_lo, b, h, c); gla_load(p, R, h, gla_chunk_row(b, c), tid, true); }
    for (int unit = bid; unit < nunits; unit += nblk) {
        gla_unit_decode(unit, ncu, c_lo, b, h, c); const int bh = b * GLH + h; const int m0 = gla_chunk_row(b, c);
        if (h != cur_h) { gla_load_w(p, l, h, GW, tid); cur_h = h; }
        bf16x8 sfr[2][4]; u32x2 gcw[4];
        { const int vt_ = wid >> 1, tt_ = wid & 1;
          UNR for (int dir = 0; dir < 2; ++dir) { const bf16* sb = (const bf16*)(p.US + ((size_t)(bh * 2 + dir) * NCH + c) * 8192) + 8192 + vt_ * 2048 + r32 * 64 + 8 * hh;
              UNR for (int ks = 0; ks < 4; ++ks) sfr[dir][ks] = *(const bf16x8*)(sb + 16 * ks); }
          const bf16* gp_ = p.P + (size_t)(m0 + 32 * tt_ + r32) * PW + C_GC + h * 128 + 32 * vt_ + 4 * hh;
          UNR for (int g = 0; g < 4; ++g) gcw[g] = *(const u32x2*)(gp_ + 8 * g); }
        gla_prep(R, GW, lds, tid);
        { const int row = tid >> 3, d8 = (tid & 7) * 8; float q8[8], k8[8]; unpack8(R.q, q8); unpack8(R.k, k8);
          UNR for (int dir = 0; dir < 2; ++dir) { const LASQ float* rf = G + (dir * 64 + (dir ? 32 : 31)) * 64 + d8; const LASQ float* bsr = G + (dir * 64 + row) * 64 + d8; float t8[8], bs[8]; u32x4 w;
              gla_off8(lds, dir, row, d8, bs); UNR for (int e = 0; e < 8; ++e) bs[e] += bsr[e];
              const ldsp_t ob = lds + GL_OP + dir * 3 * 64 * GL_KP + row * GL_KP + d8 * 2;
              UNR for (int e = 0; e < 8; ++e) t8[e] = q8[e] * EXP2((bs[e] - rf[e]) * LOG2E);
              w.x = cvtpk(t8[0], t8[1]); w.y = cvtpk(t8[2], t8[3]); w.z = cvtpk(t8[4], t8[5]); w.w = cvtpk(t8[6], t8[7]); *(LASQ u32x4*)(ob) = w;
              UNR for (int e = 0; e < 8; ++e) t8[e] = q8[e] * EXP2(bs[e] * LOG2E);
              w.x = cvtpk(t8[0], t8[1]); w.y = cvtpk(t8[2], t8[3]); w.z = cvtpk(t8[4], t8[5]); w.w = cvtpk(t8[6], t8[7]); *(LASQ u32x4*)(ob + 64 * GL_KP) = w;
              UNR for (int e = 0; e < 8; ++e) t8[e] = k8[e] * EXP2((rf[e] - bs[e]) * LOG2E);
              w.x = cvtpk(t8[0], t8[1]); w.y = cvtpk(t8[2], t8[3]); w.z = cvtpk(t8[4], t8[5]); w.w = cvtpk(t8[6], t8[7]); *(LASQ u32x4*)(ob + 2 * 64 * GL_KP) = w; } }
        if (unit + nblk < nunits) { int b2, h2, c2; gla_unit_decode(unit + nblk, ncu, c_lo, b2, h2, c2); gla_load(p, R, h2, gla_chunk_row(b2, c2), tid, true); }
        __syncthreads();
        const int tt = wid & 1, vt = wid >> 1; const int t_in = 32 * tt + r32;
        f32x16 o; UNR for (int i = 0; i < 16; ++i) o[i] = 0.f;
        UNR for (int dir = 0; dir < 2; ++dir) {
            const ldsp_t QT = lds + GL_OP + dir * 3 * 64 * GL_KP, QS = QT + 64 * GL_KP, KT = QT + 2 * 64 * GL_KP;
            f32x16 a0, a1; UNR for (int i = 0; i < 16; ++i) { a0[i] = 0.f; a1[i] = 0.f; }
            UNR for (int ks = 0; ks < 4; ++ks) { const int co = (16 * ks + 8 * hh) * 2;
                const bf16x8 k0 = *(const LASQ bf16x8*)(KT + r32 * GL_KP + co), k1 = *(const LASQ bf16x8*)(KT + (32 + r32) * GL_KP + co), qf = *(const LASQ bf16x8*)(QT + t_in * GL_KP + co);
                a0 = MFMA32(k0, qf, a0); a1 = MFMA32(k1, qf, a1); }
            UNR for (int i = 0; i < 16; ++i) { const int s = (i & 3) + 8 * (i >> 2) + 4 * hh;
                a0[i] = (dir == 0 ? s <= t_in : s >= t_in) ? a0[i] : 0.f; a1[i] = (dir == 0 ? s + 32 <= t_in : s + 32 >= t_in) ? a1[i] : 0.f; }
            const ldsp_t vp = lds + GL_V + (4 * hh + (gi >> 2)) * GL_VP + (32 * vt + 16 * ((lane >> 4) & 1) + 4 * (gi & 3)) * 2;
            UNR for (int g = 0; g < 4; ++g) { const bf16x8 vf = cat44(TR16(vp + 16 * g * GL_VP), TR16(vp + (16 * g + 8) * GL_VP));
                const bf16x8 pb = g == 0 ? pack8(a0, 0) : g == 1 ? pack8(a0, 8) : g == 2 ? pack8(a1, 0) : pack8(a1, 8); o = MFMA32(vf, pb, o); }
            UNR for (int ks = 0; ks < 4; ++ks) { const bf16x8 sf = sfr[dir][ks], qsf = *(const LASQ bf16x8*)(QS + t_in * GL_KP + (16 * ks + 8 * hh) * 2); o = MFMA32(sf, qsf, o); }
        }
        float ss = 0.f; UNR for (int i = 0; i < 16; ++i) ss += o[i] * o[i];
        ss += __shfl_xor(ss, 32);
        if (hh == 0) RED[wid * 32 + r32] = ss;
        __syncthreads();
        ss = RED[tt * 32 + r32] + RED[(tt + 2) * 32 + r32] + RED[(tt + 4) * 32 + r32] + RED[(tt + 6) * 32 + r32];
        const float rs = 1.0f / sqrtf(ss / 128 + EPS);
        const int m = m0 + t_in; const bf16* gp = p.P + (size_t)m * PW + C_GC + h * 128 + 32 * vt + 4 * hh; bf16* op = p.XN + (size_t)m * D + MO_C + h * 128 + 32 * vt + 4 * hh;
        UNR for (int g = 0; g < 4; ++g) { const u32x2 gw = gcw[g]; float gv[4]; unsigned uu;
            uu = gw.x << 16; __builtin_memcpy(&gv[0], &uu, 4); uu = gw.x & 0xffff0000u; __builtin_memcpy(&gv[1], &uu, 4); uu = gw.y << 16; __builtin_memcpy(&gv[2], &uu, 4); uu = gw.y & 0xffff0000u; __builtin_memcpy(&gv[3], &uu, 4);
            float r4[4]; UNR for (int e = 0; e < 4; ++e) r4[e] = o[4 * g + e] * rs * onw[4 * g + e] * silu_fast(gv[e]);
            u32x2 w; w.x = cvtpk(r4[0], r4[1]); w.y = cvtpk(r4[2], r4[3]); *(u32x2*)(op + 8 * g) = w; }
        __syncthreads();
    }
}


DEVFN void ph_norm_fast(const Params& p, int l, int which, bool from_input, int mrows, int gw, int NGW, int lane) {
    static_assert(D % 256 == 0, "norm layout"); constexpr int NJ = D / 256;
    const float* g = (which ? p.norm2 : p.norm1) + (size_t)l * D;
    const int R = (mrows + NGW - 1) / NGW, m_lo = gw * R, m_hi = m_lo + R < mrows ? m_lo + R : mrows;
    f32x4 gg[NJ], s1[NJ], s0[NJ], v[NJ], vn[NJ]; int cur_slot = -1;
    UNR for (int j = 0; j < NJ; ++j) gg[j] = *(const f32x4*)(g + 256 * j + 4 * lane);
    if (m_lo < m_hi) { const float* h = from_input ? xrow(p, m_lo) : hrow(p, m_lo); UNR for (int j = 0; j < NJ; ++j) v[j] = *(const f32x4*)(h + 256 * j + 4 * lane); }
    for (int m = m_lo; m < m_hi; ++m) {
        if (m + 1 < m_hi) { const float* hn = from_input ? xrow(p, m + 1) : hrow(p, m + 1); UNR for (int j = 0; j < NJ; ++j) vn[j] = *(const f32x4*)(hn + 256 * j + 4 * lane); }
        const int slot = m < ML ? m / SEQ : BATCH;
        if (slot != cur_slot) { cur_slot = slot; const float* sh = mod_vec(p, l, m, which ? 3 : 0); const float* sc = mod_vec(p, l, m, which ? 4 : 1);
            UNR for (int j = 0; j < NJ; ++j) { s1[j] = *(const f32x4*)(sc + 256 * j + 4 * lane); s0[j] = *(const f32x4*)(sh + 256 * j + 4 * lane); } }
        float ss = 0.f;
        UNR for (int j = 0; j < NJ; ++j) ss += (v[j][0] * v[j][0] + v[j][1] * v[j][1]) + (v[j][2] * v[j][2] + v[j][3] * v[j][3]);
        const float rstd = 1.0f / sqrtf(wave_sum64(ss) / D + EPS);
        bf16* o = p.XN + (size_t)m * D;
        UNR for (int j = 0; j < NJ; ++j) { const int k = 256 * j + 4 * lane;
            float r[4]; UNR for (int e = 0; e < 4; ++e) r[e] = (v[j][e] * rstd * gg[j][e]) * (1.0f + s1[j][e]) + s0[j][e];
            u32x2 w; w.x = cvtpk(r[0], r[1]); w.y = cvtpk(r[2], r[3]); *(u32x2*)(o + k) = w; }
        UNR for (int j = 0; j < NJ; ++j) v[j] = vn[j];
    }
}

DEVFN void ph_post_fast(const Params& p, int l, int gw, int NGW, int lane) {
    if constexpr (NA_W == 256 && DQK_W == 256 && GK_W == 256) {
    const int c4 = 4 * lane;
    for (int m = gw; m < M; m += NGW) {
        bf16* pr = p.P + (size_t)m * PW;
        float x[4];
        UNR for (int seg = 0; seg < 2; ++seg) {
            bf16* v = pr + (seg ? C_KA : C_QA) + c4; unpack4(*(const u32x2*)v, x);
            float ss = (x[0] * x[0] + x[1] * x[1]) + (x[2] * x[2] + x[3] * x[3]);
            ss += __shfl_xor(ss, 1); ss += __shfl_xor(ss, 2); ss += __shfl_xor(ss, 4); ss += __shfl_xor(ss, 8);
            const float r = 1.0f / sqrtf(ss / 64 + EPS) * (seg ? 1.0f : 0.125f * LOG2E); const float* g = (seg ? p.kn_a : p.qn_a) + l * 64 + (c4 & 63);
            u32x2 w; w.x = cvtpk(x[0] * r * g[0], x[1] * r * g[1]); w.y = cvtpk(x[2] * r * g[2], x[3] * r * g[3]); *(u32x2*)v = w;
        }
        UNR for (int seg = 0; seg < 2; ++seg) {
            bf16* v = pr + (seg ? C_KB : C_QB) + c4; unpack4(*(const u32x2*)v, x);
            float ss = (x[0] * x[0] + x[1] * x[1]) + (x[2] * x[2] + x[3] * x[3]);
            ss += __shfl_xor(ss, 1); ss += __shfl_xor(ss, 2); ss += __shfl_xor(ss, 4);
            const float r = 1.0f / sqrtf(ss / 32 + EPS); const float* g = (seg ? p.kn_b : p.qn_b) + l * 32 + (c4 & 31);
            UNR for (int e = 0; e < 4; ++e) x[e] = x[e] * r * g[e];
            float px[4]; UNR for (int e = 0; e < 4; ++e) px[e] = __shfl_xor(x[e], 2);
            if (m < ML) { const int t = m % SEQ, pos = (lane & 4) ? t % GRID_W : t / GRID_W; const bool isx2 = (lane >> 1) & 1; const float* rt = p.ROPE + (pos * 8 + 4 * (lane & 1)) * 2;
                UNR for (int e = 0; e < 4; ++e) { const float cs = rt[2 * e], sn = rt[2 * e + 1]; x[e] = isx2 ? x[e] * cs + px[e] * sn : x[e] * cs - px[e] * sn; } }
            const float s = seg ? 1.0f : 0.17677669529663687f * LOG2E;
            u32x2 w; w.x = cvtpk(x[0] * s, x[1] * s); w.y = cvtpk(x[2] * s, x[3] * s); *(u32x2*)v = w;
        }
        { bf16* v = pr + C_QC + c4; unpack4(*(const u32x2*)v, x); u32x2 w; w.x = cvtpk(x[0] * 0.125f, x[1] * 0.125f); w.y = cvtpk(x[2] * 0.125f, x[3] * 0.125f); *(u32x2*)v = w; }
    }
    }
}

DEVFN void ph_mod_fast(const Params& p, ldsp_t lds, int bid, int nblk) {
    int tid = threadIdx.x; LAUNDER(tid); const int lane = tid & 63, wid = RFL(tid >> 6);
    constexpr int NR = BATCH + 1, KW = D / 8, NU = DEPTH * (6 * D / 64);
    LASQ float* SL = (LASQ float*)lds; LASQ float* RED = SL + NR * D;
    if (bid < NU) { for (int i = tid; i < NR * D; i += 512) { const int j = i / D, k = i % D; SL[i] = silu_f(j < BATCH ? p.c[(size_t)j * D + k] : p.c_ctx[k]); } }
    __syncthreads();
    for (int unit = bid; unit < NU; unit += nblk) {
        const int l = unit / (6 * D / 64), n0 = 64 * (unit % (6 * D / 64));
        const float* w = p.w_ada + ((size_t)l * D + KW * wid) * 6 * D + n0 + lane;
        float acc[NR]; UNR for (int j = 0; j < NR; ++j) acc[j] = 0.f;
        for (int k = 0; k < KW; k += 4) { float wv[4]; UNR for (int e = 0; e < 4; ++e) wv[e] = w[(size_t)(k + e) * 6 * D];
            UNR for (int e = 0; e < 4; ++e) UNR for (int j = 0; j < NR; ++j) acc[j] += SL[j * D + KW * wid + k + e] * wv[e]; }
        UNR for (int j = 0; j < NR; ++j) RED[(wid * NR + j) * 64 + lane] = acc[j];
        __syncthreads();
        for (int i = tid; i < NR * 64; i += 512) { const int j = i / 64, ln = i % 64; float s = p.b_ada[(size_t)l * 6 * D + n0 + ln]; UNR for (int ww = 0; ww < 8; ++ww) s += RED[(ww * NR + j) * 64 + ln];
            p.MOD[((size_t)l * NR + j) * 6 * D + n0 + ln] = s; }
        __syncthreads();
    }
}
DEVFN void ph_rope_table(const Params& p, long gtid, long gsize) {
    for (long i = gtid; i < 64 * 8; i += gsize) { const int pos = (int)(i / 8), f = (int)(i % 8); const float inv = expf(-((float)f / 8.0f) * logf(10000.0f)); const float ang = (float)pos * inv;
        p.ROPE[2 * i] = cosf(ang); p.ROPE[2 * i + 1] = sinf(ang); }
}

#ifdef HOST_TEST
#define ATOMIC_ADDF(p, v) (*(p) += (v))
#else
#define ATOMIC_ADDF(p, v) atomicAdd((p), (v))
#endif
namespace pg8 {
struct EpiGU {
    static constexpr bool PERM = true, AFTER_DRAIN = false;
    bf16* ACT; bf16* EA; bf16* EU; const float* cw; const float* cb;
    const float* SS; const float* b2;
    struct Pre { f32x4 w0[2], w1[2], w2[2], bb[2], ba[2], bu[2]; float ssv[2][4]; };
    DEVFN Pre pre(const Unit& u, int wr, int wc, int fr, int fq) const {
        Pre P; const int f0 = 128 * u.pn + 32 * wc + 8 * fq; const int slot = u.pm * BM < ML ? (u.pm * BM) / SEQ : BATCH;
        const float* bp = b2 + (size_t)slot * 2 * FFN + 256 * u.pn + 32 * wc + 8 * fq;
        UNR for (int q = 0; q < 2; ++q) { P.w0[q] = *(const f32x4*)(cw + f0 + 4 * q); P.w1[q] = *(const f32x4*)(cw + FFN + f0 + 4 * q); P.w2[q] = *(const f32x4*)(cw + 2 * FFN + f0 + 4 * q);
            P.bb[q] = *(const f32x4*)(cb + f0 + 4 * q); P.ba[q] = *(const f32x4*)(bp + 4 * q); P.bu[q] = *(const f32x4*)(bp + 128 + 4 * q); }
        UNR for (int ai = 0; ai < 2; ++ai) UNR for (int m = 0; m < 4; ++m) P.ssv[ai][m] = SS[u.pm * BM + ai * HALF + wr * 64 + 16 * m + fr];
        return P;
    }
    DEVFN void operator()(const f32x4 (&acc)[2][2][4][2], const Unit& u, int wr, int wc, int fr, int fq, const Pre& P) const {
        const int f0 = 128 * u.pn + 32 * wc + 8 * fq; const int lane = fq * 16 + fr;
        const int src_prev = (lane & ~15) | ((fr + 15) & 15), src_next = (lane & ~15) | ((fr + 1) & 15);
        float w0[8], w1[8], w2[8], bb[8], ba[8], bu[8];
        UNR for (int e = 0; e < 8; ++e) { w0[e] = P.w0[e >> 2][e & 3]; w1[e] = P.w1[e >> 2][e & 3]; w2[e] = P.w2[e >> 2][e & 3]; bb[e] = P.bb[e >> 2][e & 3]; ba[e] = P.ba[e >> 2][e & 3]; bu[e] = P.bu[e >> 2][e & 3]; }
        UNR for (int ai = 0; ai < 2; ++ai) {
            const int rowb = u.pm * BM + ai * HALF + wr * 64;
            float rs[4]; UNR for (int m = 0; m < 4; ++m) rs[m] = RSQ(P.ssv[ai][m] * (1.0f / D) + EPS);
#define GU_A(m_, n_, e_) (rs[m_] * acc[ai][0][m_][n_][e_] + ba[4 * (n_) + (e_)])
#define GU_U(m_, n_, e_) (rs[m_] * acc[ai][1][m_][n_][e_] + bu[4 * (n_) + (e_)])
            UNR for (int m = 0; m < 4; ++m) {
                const int row = rowb + 16 * m + fr; float act[8], av[8], uv[8];
                UNR for (int n = 0; n < 2; ++n) UNR for (int e = 0; e < 4; ++e) {
                    const float cur = GU_A(m, n, e);
                    const float sp = (fr == 15 && m > 0) ? GU_A(m > 0 ? m - 1 : 0, n, e) : cur;
                    const float sn = (fr == 0 && m < 3) ? GU_A(m < 3 ? m + 1 : 3, n, e) : cur;
                    const float prev = ROR16(sp, 1), next = ROR16(sn, 15);
                    const float a = bb[4 * n + e] + w0[4 * n + e] * prev + w1[4 * n + e] * cur + w2[4 * n + e] * next;
                    av[4 * n + e] = cur; uv[4 * n + e] = GU_U(m, n, e);
                    act[4 * n + e] = silu_fast(a) * uv[4 * n + e];
                }
                const bool e0 = (m == 0 && fr == 0), e63 = (m == 3 && fr == 15), e1 = (m == 0 && fr == 1), e62 = (m == 3 && fr == 14);
                { u32x4 w; w.x = cvtpk(act[0], act[1]); w.y = cvtpk(act[2], act[3]); w.z = cvtpk(act[4], act[5]); w.w = cvtpk(act[6], act[7]); *(u32x4*)(ACT + (size_t)row * FFN + f0) = w; }
                if (e0 || e1 || e62 || e63) { u32x4 w; w.x = cvtpk(av[0], av[1]); w.y = cvtpk(av[2], av[3]); w.z = cvtpk(av[4], av[5]); w.w = cvtpk(av[6], av[7]);
                    *(u32x4*)(EA + ((size_t)(rowb / 64) * 4 + (e0 ? 0 : e1 ? 1 : e62 ? 2 : 3)) * FFN + f0) = w; }
                if (e0 || e63) { u32x4 w; w.x = cvtpk(uv[0], uv[1]); w.y = cvtpk(uv[2], uv[3]); w.z = cvtpk(uv[4], uv[5]); w.w = cvtpk(uv[6], uv[7]);
                    *(u32x4*)(EU + ((size_t)(rowb / 64) * 2 + (e0 ? 0 : 1)) * FFN + f0) = w; }
            }
#undef GU_A
#undef GU_U
        }
    }
};
template <bool OUT_BF16, bool BASE_BF16, bool FUSE> struct EpiResidT {
    static constexpr bool PERM = true, AFTER_DRAIN = false;
    const float* base_lat; const float* base_ctx; float* out_lat; float* out_ctx; const float* gate;
    bf16* XNo; const float* nw; const float* scb; float* SS;
    const bf16* baseb; bf16* outb;
    struct Pre { f32x4 gv[2][2], gm[2][2]; };
    DEVFN Pre pre(const Unit& u, int wr, int wc, int fr, int fq) const {
        Pre P; const int slot = u.pm * BM < ML ? (u.pm * BM) / SEQ : BATCH; const float* g = gate + (size_t)slot * 6 * D; const int col0 = u.pn * BM + wc * 32 + 8 * fq;
        UNR for (int bj = 0; bj < 2; ++bj) UNR for (int n = 0; n < 2; ++n) { const int c = col0 + bj * HALF + 4 * n; P.gv[bj][n] = *(const f32x4*)(g + c);
            if (FUSE) { const float* sc = scb + (size_t)slot * 6 * D; const f32x4 w = *(const f32x4*)(nw + c), s1 = *(const f32x4*)(sc + c); P.gm[bj][n] = w * (1.0f + s1); } else P.gm[bj][n] = P.gv[bj][n]; }
        return P;
    }
    DEVFN void operator()(const f32x4 (&acc)[2][2][4][2], const Unit& u, int wr, int wc, int fr, int fq, const Pre& P) const {
        const bool lat = u.pm * BM < ML;
        const int lrow0 = (lat ? u.pm * BM : u.pm * BM - ML) + wr * 64 + fr, grow0 = u.pm * BM + wr * 64 + fr;
        const float* bs = lat ? base_lat : base_ctx; float* os = lat ? out_lat : out_ctx;
        const int col0 = u.pn * BM + wc * 32 + 8 * fq;
        f32x4 gv[2][2], gm[2][2];
        UNR for (int bj = 0; bj < 2; ++bj) UNR for (int n = 0; n < 2; ++n) { gv[bj][n] = P.gv[bj][n]; gm[bj][n] = P.gm[bj][n]; }
        UNR for (int ai = 0; ai < 2; ++ai) UNR for (int m = 0; m < 4; ++m) {
            const size_t off = (size_t)(lrow0 + ai * HALF + m * 16) * D + col0, goff = (size_t)(grow0 + ai * HALF + m * 16) * D + col0; float ss = 0.f;
            UNR for (int bj = 0; bj < 2; ++bj) { const int cc = bj * HALF;
                f32x4 b0, b1;
                if (BASE_BF16) { float t8[8]; const u32x4 bw = *(const u32x4*)(baseb + goff + cc); unpack8(bw, t8); b0 = (f32x4){t8[0], t8[1], t8[2], t8[3]}; b1 = (f32x4){t8[4], t8[5], t8[6], t8[7]}; }
                else { b0 = *(const f32x4*)(bs + off + cc); b1 = *(const f32x4*)(bs + off + cc + 4); }
                const f32x4 o0 = b0 + gv[bj][0] * acc[ai][bj][m][0], o1 = b1 + gv[bj][1] * acc[ai][bj][m][1];
                if (OUT_BF16) { u32x4 w1; w1.x = cvtpk(o0[0], o0[1]); w1.y = cvtpk(o0[2], o0[3]); w1.z = cvtpk(o1[0], o1[1]); w1.w = cvtpk(o1[2], o1[3]); *(u32x4*)(outb + goff + cc) = w1; }
                else { *(f32x4*)(os + off + cc) = o0; *(f32x4*)(os + off + cc + 4) = o1; }
                if (FUSE) { ss += ((o0[0] * o0[0] + o0[1] * o0[1]) + (o0[2] * o0[2] + o0[3] * o0[3])) + ((o1[0] * o1[0] + o1[1] * o1[1]) + (o1[2] * o1[2] + o1[3] * o1[3]));
                    const f32x4 x0 = o0 * gm[bj][0], x1 = o1 * gm[bj][1]; u32x4 w2; w2.x = cvtpk(x0[0], x0[1]); w2.y = cvtpk(x0[2], x0[3]); w2.z = cvtpk(x1[0], x1[1]); w2.w = cvtpk(x1[2], x1[3]); *(u32x4*)(XNo + goff + cc) = w2; } }
            if (FUSE) { ss += __shfl_xor(ss, 16); ss += __shfl_xor(ss, 32); if (fq == 0) ATOMIC_ADDF(SS + grow0 + ai * HALF + m * 16, ss); }
        }
    }
};
typedef EpiResidT<false, false, true> EpiResidN;
struct EpiInprojN {
    static constexpr bool PERM = true, AFTER_DRAIN = false;
    bf16* P; bf16* AFB; const float* SS; const float* b2; int ldb;
    DEVFN void operator()(const f32x4 (&acc)[2][2][4][2], const Unit& u, int wr, int wc, int fr, int fq) const {
        const int row0 = u.pm * BM + wr * 64 + fr; const int col0 = u.pn * BM + wc * 32 + 8 * fq;
        const int slot = u.pm * BM < ML ? (u.pm * BM) / SEQ : BATCH;
        f32x4 bv[2][2]; UNR for (int bj = 0; bj < 2; ++bj) UNR for (int n = 0; n < 2; ++n) bv[bj][n] = *(const f32x4*)(b2 + (size_t)slot * ldb + col0 + bj * HALF + 4 * n);
        UNR for (int ai = 0; ai < 2; ++ai) UNR for (int m = 0; m < 4; ++m) { const size_t row = (size_t)(row0 + ai * HALF + m * 16); const float rs = 1.0f / sqrtf(SS[row] * (1.0f / D) + EPS);
            UNR for (int bj = 0; bj < 2; ++bj) { const f32x4 v0 = acc[ai][bj][m][0] * rs + bv[bj][0], v1 = acc[ai][bj][m][1] * rs + bv[bj][1]; const int col = col0 + bj * HALF;
                u32x4 w; w.x = cvtpk(v0[0], v0[1]); w.y = cvtpk(v0[2], v0[3]); w.z = cvtpk(v1[0], v1[1]); w.w = cvtpk(v1[2], v1[3]);
                if (col < PW) *(u32x4*)(P + row * PW + col) = w;
                else if (col < PW + 32) *(u32x4*)(AFB + row * 32 + (col - PW)) = w; } }
    }
};
}
namespace pg8 {
template <bool NORMIN> struct EpiInprojPost {
    static constexpr bool PERM = true, AFTER_DRAIN = false;
    bf16* P; bf16* AFB; const float* SS; const float* b2; int ldb;
    const float* qn_a; const float* kn_a; const float* qn_b; const float* kn_b; const float* rope;
    struct Pre { f32x4 bias[2][2]; float ssv[2][4]; };
    DEVFN Pre pre(const Unit& u, int wr, int wc, int fr, int fq) const {
        Pre PR; const int slot = u.pm * BM < ML ? (u.pm * BM) / SEQ : BATCH; const int vcol0 = wc * 32 + 8 * fq;
        UNR for (int bj = 0; bj < 2; ++bj) UNR for (int q = 0; q < 2; ++q) PR.bias[bj][q] = NORMIN ? *(const f32x4*)(b2 + (size_t)slot * ldb + u.pn * BM + bj * HALF + vcol0 + 4 * q) : (f32x4){0.f, 0.f, 0.f, 0.f};
        UNR for (int ai = 0; ai < 2; ++ai) UNR for (int m = 0; m < 4; ++m) PR.ssv[ai][m] = NORMIN ? SS[u.pm * BM + wr * 64 + fr + ai * HALF + m * 16] : 0.f;
        return PR;
    }
    DEVFN void operator()(const f32x4 (&acc)[2][2][4][2], const Unit& u, int wr, int wc, int fr, int fq, const Pre& PR) const {
        const int row0 = u.pm * BM + wr * 64 + fr; const int pn = u.pn; const int vcol0 = wc * 32 + 8 * fq;
        const bool lat = u.pm * BM < ML;
        float bias[2][8];
        if (NORMIN) { UNR for (int bj = 0; bj < 2; ++bj) UNR for (int e = 0; e < 8; ++e) bias[bj][e] = PR.bias[bj][e >> 2][e & 3]; }
        UNR for (int ai = 0; ai < 2; ++ai) UNR for (int m = 0; m < 4; ++m) {
            const int row = row0 + ai * HALF + m * 16; float v[2][8];
            { float rs = 1.f; if (NORMIN) rs = RSQ(PR.ssv[ai][m] * (1.0f / D) + EPS);
              UNR for (int bj = 0; bj < 2; ++bj) UNR for (int e = 0; e < 8; ++e) { const float a = acc[ai][bj][m][e >> 2][e & 3]; v[bj][e] = NORMIN ? a * rs + bias[bj][e] : a; } }
            if (pn <= 1) {
                float ss = 0.f; UNR for (int bj = 0; bj < 2; ++bj) UNR for (int e = 0; e < 8; ++e) ss += v[bj][e] * v[bj][e];
                ss += __shfl_xor(ss, 16); ss += __shfl_xor(ss, 32);
                const float r = RSQ(ss * (1.0f / 64) + EPS) * (pn == 0 ? 0.125f * LOG2E : 1.0f); const float* g = (pn == 0 ? qn_a : kn_a);
                UNR for (int bj = 0; bj < 2; ++bj) { u32x4 w; float o[8]; UNR for (int e = 0; e < 8; ++e) o[e] = v[bj][e] * r * g[32 * bj + 8 * fq + e];
                    w.x = cvtpk(o[0], o[1]); w.y = cvtpk(o[2], o[3]); w.z = cvtpk(o[4], o[5]); w.w = cvtpk(o[6], o[7]);
                    *(u32x4*)(P + (size_t)row * PW + pn * BM + 64 * wc + 32 * bj + 8 * fq) = w; }
            } else if (pn == 3 || pn == 4) {
                const float* g = (pn == 3 ? qn_b : kn_b); int t = 0, prow = 0, pcol = 0; if (lat) { t = row % SEQ; prow = t / GRID_W; pcol = t % GRID_W; }
                UNR for (int bj = 0; bj < 2; ++bj) {
                    float ss = 0.f; UNR for (int e = 0; e < 8; ++e) ss += v[bj][e] * v[bj][e];
                    ss += __shfl_xor(ss, 16); ss += __shfl_xor(ss, 32);
                    const float r = RSQ(ss * (1.0f / 32) + EPS); float o[8], po[8];
                    UNR for (int e = 0; e < 8; ++e) o[e] = v[bj][e] * r * g[8 * fq + e];
                    UNR for (int e = 0; e < 8; ++e) po[e] = __shfl_xor(o[e], 16);
                    if (lat) { const float* rt = rope + ((fq & 2) ? pcol : prow) * 16; const bool isx2 = fq & 1;
                        UNR for (int e = 0; e < 8; ++e) { const float cs = rt[2 * e], sn = rt[2 * e + 1]; o[e] = isx2 ? o[e] * cs + po[e] * sn : o[e] * cs - po[e] * sn; } }
                    const float sc = pn == 3 ? 0.17677669529663687f * LOG2E : 1.0f; u32x4 w;
                    w.x = cvtpk(o[0] * sc, o[1] * sc); w.y = cvtpk(o[2] * sc, o[3] * sc); w.z = cvtpk(o[4] * sc, o[5] * sc); w.w = cvtpk(o[6] * sc, o[7] * sc);
                    *(u32x4*)(P + (size_t)row * PW + pn * BM + bj * HALF + vcol0) = w; }
            } else {
                const float sc = pn == 6 ? 0.125f : 1.0f;
                UNR for (int bj = 0; bj < 2; ++bj) { const int col = pn * BM + bj * HALF + vcol0; u32x4 w;
                    w.x = cvtpk(v[bj][0] * sc, v[bj][1] * sc); w.y = cvtpk(v[bj][2] * sc, v[bj][3] * sc); w.z = cvtpk(v[bj][4] * sc, v[bj][5] * sc); w.w = cvtpk(v[bj][6] * sc, v[bj][7] * sc);
                    if (col < PW) *(u32x4*)(P + (size_t)row * PW + col) = w;
                    else if (col < PW + 32) *(u32x4*)(AFB + (size_t)row * 32 + (col - PW)) = w; }
            }
        }
    }
};
}
DEVFN void ph_bias2(const bf16* Bt, int N, const float* shb, float* out, int gw, int NGW, int lane) {
    static_assert(D % 512 == 0, "bias2 layout"); constexpr int NJ = D / 512, SP = 3;
    for (int s0 = 0; s0 <= BATCH; s0 += SP) {
        f32x4 sv[SP][NJ][2];
        UNR for (int s = 0; s < SP; ++s) { const int sl = s0 + s <= BATCH ? s0 + s : BATCH; const float* sh = shb + (size_t)sl * 6 * D;
            UNR for (int j = 0; j < NJ; ++j) UNR for (int q = 0; q < 2; ++q) sv[s][j][q] = *(const f32x4*)(sh + 512 * j + 8 * lane + 4 * q); }
        for (int n = gw; n < N; n += NGW) {
            float w[NJ][8]; UNR for (int j = 0; j < NJ; ++j) ld8(Bt + (size_t)n * D + 512 * j + 8 * lane, w[j]);
            float a[SP]; UNR for (int s = 0; s < SP; ++s) { a[s] = 0.f; UNR for (int j = 0; j < NJ; ++j) UNR for (int e = 0; e < 8; ++e) a[s] += w[j][e] * sv[s][j][e >> 2][e & 3]; }
            UNR for (int s = 0; s < SP; ++s) a[s] = wave_sum64(a[s]);
            if (lane == 0) { UNR for (int s = 0; s < SP; ++s) if (s0 + s <= BATCH) out[(size_t)(s0 + s) * N + n] = a[s]; }
        }
    }
}
DEVFN void ffn_fix_rowtile(const Params& p, int l, int pm, int tid) {
    if (tid >= FFN / 8) return;
    const float* cw = p.conv_w + (size_t)l * 3 * FFN; const float* cb = p.conv_b + (size_t)l * FFN; const int f0 = 8 * tid;
    float wb[8], w0[8], w1[8], w2[8];
    UNR for (int q = 0; q < 2; ++q) { const f32x4 vb = *(const f32x4*)(cb + f0 + 4 * q), v0 = *(const f32x4*)(cw + f0 + 4 * q), v1 = *(const f32x4*)(cw + FFN + f0 + 4 * q), v2 = *(const f32x4*)(cw + 2 * FFN + f0 + 4 * q);
        UNR for (int e = 0; e < 4; ++e) { wb[4 * q + e] = vb[e]; w0[4 * q + e] = v0[e]; w1[4 * q + e] = v1[e]; w2[4 * q + e] = v2[e]; } }
    UNR for (int half = 0; half < 2; ++half) {
        U4 curw[4], uuw[4], prvw[4], nxtw[4];
        UNR for (int k = 0; k < 4; ++k) { const int kb = 4 * pm + 2 * half + (k >> 1), edge = k & 1; const int row = 64 * kb + (edge ? 63 : 0);
            int pos, len; if (row < ML) { pos = row & (SEQ - 1); len = SEQ; } else { pos = (row - ML) & (CTX - 1); len = CTX; }
            const unsigned ea0 = (unsigned)kb * 4u * (unsigned)FFN + (unsigned)f0;
            curw[k] = *(const U4*)(p.EA + ea0 + (edge ? 3u : 0u) * (unsigned)FFN); uuw[k] = *(const U4*)(p.EU + ((unsigned)kb * 2u + (unsigned)edge) * (unsigned)FFN + (unsigned)f0);
            prvw[k] = curw[k]; nxtw[k] = curw[k];
            if (edge == 0) { if (pos > 0) prvw[k] = *(const U4*)(p.EA + ea0 - (unsigned)FFN); nxtw[k] = *(const U4*)(p.EA + ea0 + (unsigned)FFN); }
            else { prvw[k] = *(const U4*)(p.EA + ea0 + 2u * (unsigned)FFN); if (pos < len - 1) nxtw[k] = *(const U4*)(p.EA + ea0 + 4u * (unsigned)FFN); } }
        UNR for (int k = 0; k < 4; ++k) { const int kb = 4 * pm + 2 * half + (k >> 1), edge = k & 1; const int row = 64 * kb + (edge ? 63 : 0);
            int pos, len; if (row < ML) { pos = row & (SEQ - 1); len = SEQ; } else { pos = (row - ML) & (CTX - 1); len = CTX; }
            const bool hp = edge == 1 || pos > 0, hn = edge == 0 || pos < len - 1;
            float cur[8], prv[8], nxt[8], uu[8], act[8]; ld8((const bf16*)&curw[k], cur); ld8((const bf16*)&uuw[k], uu); ld8((const bf16*)&prvw[k], prv); ld8((const bf16*)&nxtw[k], nxt);
            UNR for (int e = 0; e < 8; ++e) { float a = wb[e] + w1[e] * cur[e]; if (hp) a += w0[e] * prv[e]; if (hn) a += w2[e] * nxt[e]; act[e] = silu_fast(a) * uu[e]; }
            u32x4 w; w.x = cvtpk(act[0], act[1]); w.y = cvtpk(act[2], act[3]); w.z = cvtpk(act[4], act[5]); w.w = cvtpk(act[6], act[7]); *(u32x4*)(p.ACT + (unsigned)row * (unsigned)FFN + (unsigned)f0) = w; }
    }
}
DEVFN void ph_ffn_fix(const Params& p, int l, int mrows, long gtid, long gsize) {
    const float* cw = p.conv_w + (size_t)l * 3 * FFN; const float* cb = p.conv_b + (size_t)l * FFN;
    const long N = (long)(mrows / 64) * 2 * (FFN / 8);
    for (long i = gtid; i < N; i += gsize) {
        const int f0 = (int)(i % (FFN / 8)) * 8, edge = (int)((i / (FFN / 8)) & 1), kb = (int)(i / (2 * (FFN / 8)));
        const int row = 64 * kb + (edge ? 63 : 0); int pos, len; if (row < ML) { pos = row % SEQ; len = SEQ; } else { pos = (row - ML) % CTX; len = CTX; }
        float cur[8], prv[8], nxt[8], uu[8];
        ld8(p.EA + ((size_t)kb * 4 + (edge ? 3 : 0)) * FFN + f0, cur); ld8(p.EU + ((size_t)kb * 2 + edge) * FFN + f0, uu);
        if (edge == 0) { if (pos > 0) ld8(p.EA + ((size_t)(kb - 1) * 4 + 3) * FFN + f0, prv); ld8(p.EA + ((size_t)kb * 4 + 1) * FFN + f0, nxt); }
        else { ld8(p.EA + ((size_t)kb * 4 + 2) * FFN + f0, prv); if (pos < len - 1) ld8(p.EA + ((size_t)(kb + 1) * 4 + 0) * FFN + f0, nxt); }
        const bool hp = edge == 1 || pos > 0, hn = edge == 0 || pos < len - 1; float act[8];
        float wb[8], w0[8], w1[8], w2[8];
        UNR for (int q = 0; q < 2; ++q) { const f32x4 vb = *(const f32x4*)(cb + f0 + 4 * q), v0 = *(const f32x4*)(cw + f0 + 4 * q), v1 = *(const f32x4*)(cw + FFN + f0 + 4 * q), v2 = *(const f32x4*)(cw + 2 * FFN + f0 + 4 * q);
            UNR for (int e = 0; e < 4; ++e) { wb[4 * q + e] = vb[e]; w0[4 * q + e] = v0[e]; w1[4 * q + e] = v1[e]; w2[4 * q + e] = v2[e]; } }
        UNR for (int e = 0; e < 8; ++e) { float a = wb[e] + w1[e] * cur[e]; if (hp) a += w0[e] * prv[e]; if (hn) a += w2[e] * nxt[e]; act[e] = silu_fast(a) * uu[e]; }
        u32x4 w; w.x = cvtpk(act[0], act[1]); w.y = cvtpk(act[2], act[3]); w.z = cvtpk(act[4], act[5]); w.w = cvtpk(act[6], act[7]); *(u32x4*)(p.ACT + (size_t)row * FFN + f0) = w;
    }
}
namespace pg8 {
template <bool NOSTORE = false> struct EpiInprojT {
    static constexpr bool PERM = true, AFTER_DRAIN = false;
    bf16_t* P; bf16_t* AFB;
    __device__ __forceinline__ void operator()(const f32x4 (&acc)[2][2][4][2], const Unit& u, int wr, int wc, int fr, int fq) const {
        const int row0 = u.pm * BM + wr * 64 + fr; const int col0 = u.pn * BM + wc * 32 + 8 * fq;
#pragma unroll
        for (int ai = 0; ai < 2; ++ai)
#pragma unroll
            for (int m = 0; m < 4; ++m) { const size_t row = (size_t)(row0 + ai * HALF + m * 16);
#pragma unroll
                for (int bj = 0; bj < 2; ++bj) { const f32x4 v0 = acc[ai][bj][m][0], v1 = acc[ai][bj][m][1]; const int col = col0 + bj * HALF;
                    u32x4 w; w.x = cvt_pk_bf16(v0[0], v0[1]); w.y = cvt_pk_bf16(v0[2], v0[3]); w.z = cvt_pk_bf16(v1[0], v1[1]); w.w = cvt_pk_bf16(v1[2], v1[3]);
                    if (NOSTORE) { *(u32x4*)(P + (row & 63) * PW + (col & 1023)) = w; }
                    else if (col < PW) *(u32x4*)(P + row * PW + col) = w;
                    else if (col < PW + 32) *(u32x4*)(AFB + row * 32 + (col - PW)) = w; } }
    }
};
typedef EpiInprojT<false> EpiInproj;
struct EpiBf16Plain {
    static constexpr bool PERM = true, AFTER_DRAIN = false;
    bf16_t* O; int ldc;
    __device__ __forceinline__ void operator()(const f32x4 (&acc)[2][2][4][2], const Unit& u, int wr, int wc, int fr, int fq) const {
        const int row0 = u.pm * BM + wr * 64 + fr; const int col0 = u.pn * BM + wc * 32 + 8 * fq;
#pragma unroll
        for (int ai = 0; ai < 2; ++ai)
#pragma unroll
            for (int m = 0; m < 4; ++m) { bf16_t* rowp = O + (size_t)(row0 + ai * HALF + m * 16) * ldc + col0;
#pragma unroll
                for (int bj = 0; bj < 2; ++bj) { const f32x4 v0 = acc[ai][bj][m][0], v1 = acc[ai][bj][m][1];
                    u32x4 w; w.x = cvt_pk_bf16(v0[0], v0[1]); w.y = cvt_pk_bf16(v0[2], v0[3]); w.z = cvt_pk_bf16(v1[0], v1[1]); w.w = cvt_pk_bf16(v1[2], v1[3]);
                    *(u32x4*)(rowp + bj * HALF) = w; } }
    }
};
struct EpiResid {
    static constexpr bool PERM = false, AFTER_DRAIN = false;
    const float* base_lat; const float* base_ctx; float* out_lat; float* out_ctx; const float* gate;
    __device__ __forceinline__ void operator()(const f32x4 (&acc)[2][2][4][2], const Unit& u, int wr, int wc, int fr, int fq) const {
        const bool lat = u.pm * BM < ML;
        const int slot = lat ? (u.pm * BM) / SEQ : BATCH;
        const int lrow0 = (lat ? u.pm * BM : u.pm * BM - ML) + wr * 64 + fr;
        const float* bs = lat ? base_lat : base_ctx; float* os = lat ? out_lat : out_ctx;
        const float* g = gate + (size_t)slot * 6 * D;
        const int col0 = u.pn * BM + wc * 32 + 4 * fq;
        f32x4 gv[2][2];
#pragma unroll
        for (int bj = 0; bj < 2; ++bj)
#pragma unroll
            for (int n = 0; n < 2; ++n) gv[bj][n] = *(const f32x4*)(g + col0 + bj * HALF + n * 16);
#pragma unroll
        for (int ai = 0; ai < 2; ++ai)
#pragma unroll
            for (int m = 0; m < 4; ++m) { const size_t off = (size_t)(lrow0 + ai * HALF + m * 16) * D + col0;
#pragma unroll
                for (int bj = 0; bj < 2; ++bj)
#pragma unroll
                    for (int n = 0; n < 2; ++n) { const f32x4 b = *(const f32x4*)(bs + off + bj * HALF + n * 16);
                        *(f32x4*)(os + off + bj * HALF + n * 16) = b + gv[bj][n] * acc[ai][bj][m][n]; } }
    }
};
}

constexpr size_t MiB = 1u << 20;
constexpr size_t WS_CTL = 0, CTL_ZERO_BYTES = 1 * MiB;
constexpr size_t WS_MOD = 1 * MiB, WS_ROPE = 2 * MiB;
constexpr size_t WS_WIN = 3 * MiB, WS_WOUT = 10 * MiB, WS_WGU = 12 * MiB, WS_WD = 23 * MiB;
constexpr size_t WS_HC = 29 * MiB, WS_XN = 37 * MiB, WS_AFB = 105 * MiB, WS_R1 = 108 * MiB, WS_R2 = 312 * MiB;
constexpr size_t WS_GO = WS_R2, WS_ALF = WS_R2 + 68 * MiB, WS_ALB = WS_R2 + 102 * MiB, WS_DT = WS_R2 + 136 * MiB, WS_US = WS_R2, WS_AD = WS_R2 + 136 * MiB, WS_EA = WS_R1, WS_EU = WS_R1 + 16 * MiB, WS_XN2 = WS_R1 + 40 * MiB, WS_HB = WS_R1 + 112 * MiB, WS_SS1 = WS_ROPE + 256 * 1024, WS_SS2 = WS_ROPE + 400 * 1024, WS_B2IN = WS_ROPE + 544 * 1024, WS_B2GU = WS_ROPE + 672 * 1024, WS_END = 499 * MiB;
constexpr int NPAD_IN = (IN_W + 255) / 256 * 256;
static_assert(WS_WIN + (size_t)NPAD_IN * D * 2 <= WS_WOUT && WS_WOUT + (size_t)D * D * 2 <= WS_WGU && WS_WGU + (size_t)2 * FFN * D * 2 <= WS_WD && WS_WD + (size_t)D * FFN * 2 <= WS_HC, "weights map");
static_assert(WS_HC + (size_t)MC * D * 4 <= WS_XN && WS_XN + (size_t)M * D * 2 <= WS_AFB && WS_AFB + (size_t)M * 32 * 2 <= WS_R1, "ws map 1");
static_assert(WS_R1 + (size_t)M * PW * 2 <= WS_R2 && WS_R1 + (size_t)M * GUP * 2 <= WS_R2 && WS_R2 + (size_t)M * FFN * 2 <= WS_END, "ws map 2");
static_assert(WS_ALB + (size_t)M * GK_W * 4 <= WS_DT && WS_DT + (size_t)M * DV_W * 4 <= WS_END, "ws map 4");
static_assert(WS_XN2 + (size_t)M * D * 2 <= WS_HB && WS_HB + (size_t)M * D * 2 <= WS_R2, "ws map 8");
static_assert(WS_XN2 + (size_t)M * D * 2 <= WS_R2 && WS_EU + (size_t)(M / 64) * 2 * FFN * 2 <= WS_XN2 && (size_t)M * 4 <= 144 * 1024 && (size_t)9 * NPAD_IN * 4 <= 128 * 1024 && WS_B2GU + (size_t)9 * 2 * FFN * 4 <= WS_WIN, "ws map 7");
static_assert(WS_EA + (size_t)(M / 64) * 4 * FFN * 2 <= WS_EU && WS_EU + (size_t)(M / 64) * 2 * FFN * 2 <= WS_R2, "ws map 6");
static_assert(WS_US + (size_t)BATCH * GLH * 2 * NCH * 32768 <= WS_AD && WS_AD + (size_t)BATCH * GLH * 2 * NCH * 256 <= WS_END, "ws map 5");
static_assert(WS_GO + (size_t)M * GV_W * 4 <= WS_ALF && WS_ALF + (size_t)M * GK_W * 4 <= WS_ALB && WS_ALB + (size_t)M * GK_W * 4 <= WS_END, "ws map 3");
constexpr int CW_BAR = 4096, CW_SPLIT = 16384;
#ifndef SPLITK
#define SPLITK 4
#endif
static_assert(WS_R2 + (size_t)64 * SPLITK * 262144 <= WS_END && WS_XN2 + (size_t)64 * SPLITK * 262144 <= WS_HB, "split-K partials");
constexpr int RING_OFF = 0, RING_BYTES = 131072;
constexpr int LDSCTL_OFF = RING_BYTES, MISC_OFF = LDSCTL_OFF + 320;
constexpr int LDS_BYTES = 147456;
constexpr int NWAVES = 8, NTHREADS = 512;

__device__ __forceinline__ void transpose_item(const float* W, int ldw, bf16* WT, int ldt, int k0, int n0, int dst_row0, LAS float* scr, int lane) {
    float tmp[32];
#pragma unroll
    for (int i = 0; i < 32; ++i) { const int kk = 2 * i + (lane >> 5); tmp[i] = W[(size_t)(k0 + kk) * ldw + n0 + (lane & 31)]; }
#pragma unroll
    for (int i = 0; i < 32; ++i) { const int kk = 2 * i + (lane >> 5); scr[kk * 33 + (lane & 31)] = tmp[i]; }
    LDS_WAIT(); asm volatile("" ::: "memory");
    const int c = lane & 7;
#pragma unroll
    for (int j = 0; j < 4; ++j) { const int n = (lane >> 3) + 8 * j; const LAS float* s = scr + (8 * c) * 33 + n;
        v4u o; o.x = pk2(s[0 * 33], s[1 * 33]); o.y = pk2(s[2 * 33], s[3 * 33]); o.z = pk2(s[4 * 33], s[5 * 33]); o.w = pk2(s[6 * 33], s[7 * 33]);
        *(GAS v4u*)(WT + (size_t)(dst_row0 + n) * ldt + k0 + 8 * c) = o; }
    LDS_WAIT(); asm volatile("" ::: "memory");
}
__device__ __forceinline__ void ph_weights(const Params& p, int l, LAS unsigned char* lds, int gw, int NGW, int wave, int lane, int mask = 15) {
    LAS float* scr = (LAS float*)(lds + RING_OFF + wave * 16384);
    constexpr int NB_IN = IN_W / 32, I_IN = (D / 64) * NB_IN, I_OUT = (D / 64) * (D / 32), I_G = (D / 64) * (FFN / 32), I_D = (FFN / 64) * (D / 32);
    constexpr int NITEMS = I_IN + I_OUT + 2 * I_G + I_D;
    static_assert(IN_W % 32 == 0 && FFN % 64 == 0, "transpose items");
    for (int it = gw; it < NITEMS; it += NGW) {
        int r = it;
        if (r < I_IN) { if (!(mask & 1)) continue; const int kb = r / NB_IN, nb = r % NB_IN; const int n0 = 32 * nb;
            const int dst = n0 < 512 ? (n0 & ~255) + 128 * ((n0 >> 5) & 1) + 32 * ((n0 >> 6) & 3) : n0;
            transpose_item(p.w_in + (size_t)l * D * IN_W, IN_W, p.WIN_T, D, 64 * kb, n0, dst, scr, lane); continue; } r -= I_IN;
        if (r < I_OUT) { if (!(mask & 2)) continue; const int kb = r / (D / 32), nb = r % (D / 32); transpose_item(p.w_out + (size_t)l * D * D, D, p.WOUT_T, D, 64 * kb, 32 * nb, 32 * nb, scr, lane); continue; } r -= I_OUT;
        if (r < 2 * I_G) { if (!(mask & 4)) continue; const int s = r / I_G; r -= s * I_G; const int kb = r / (FFN / 32), nb = r % (FFN / 32); const int n0 = 32 * nb;
            transpose_item((s ? p.w_u : p.w_g) + (size_t)l * D * FFN, FFN, p.WGU_T, D, 64 * kb, n0, 256 * (n0 / 128) + 128 * s + (n0 % 128), scr, lane); continue; } r -= 2 * I_G;
        if (mask & 8) { const int kb = r / (D / 32), nb = r % (D / 32); transpose_item(p.w_d + (size_t)l * FFN * D, D, p.WD_T, FFN, 64 * kb, 32 * nb, 32 * nb, scr, lane); }
    }
    if (mask & 1) { const int tot = (NPAD_IN - IN_W) * D / 8; v4u z = {0u, 0u, 0u, 0u};
      for (int i = gw * 64 + lane; i < tot; i += NGW * 64) *(GAS v4u*)(p.WIN_T + (size_t)IN_W * D + (size_t)i * 8) = z; }
}

#ifndef NOGLA
#define NOGLA 0
#endif
struct Args { Params p; int ph_lo, ph_hi; };
constexpr int PH_PER_LAYER = 9, N_PHASES = 1 + DEPTH * PH_PER_LAYER;

struct Ctx { LAS unsigned char* lds; long gtid, gsize; int gw, NGW, wave, lane, G; };
__device__ __forceinline__ Ctx make_ctx(LAS unsigned char* lds) {
    int tid = threadIdx.x; asm volatile("" : "+v"(tid));
    Ctx c; c.lds = lds; c.lane = tid & 63; c.wave = __builtin_amdgcn_readfirstlane(tid >> 6); c.G = gridDim.x;
    c.gtid = (long)blockIdx.x * NTHREADS + tid; c.gsize = (long)c.G * NTHREADS; c.gw = blockIdx.x * NWAVES + c.wave; c.NGW = c.G * NWAVES; return c; }

template <int PH> __device__ __forceinline__ void run_phase(const Params& p, LAS unsigned char* lds_) {
    const Ctx c = make_ctx(lds_);
    if constexpr (PH == 0) {
        ph_mod_fast(p, c.lds, (int)blockIdx.x, c.G); ph_rope_table(p, c.gtid, c.gsize);
        __syncthreads();
        ph_weights(p, 0, c.lds, c.gw, c.NGW, c.wave, c.lane);
    } else {
        constexpr int l = (PH - 1) / PH_PER_LAYER, s = (PH - 1) % PH_PER_LAYER;
        constexpr bool wc = l < DEPTH - 1; constexpr int mrows = wc ? M : ML;
        const float* modl = p.MOD + (size_t)l * (BATCH + 1) * 6 * D;
        if constexpr (s == 0) {
            if (l == 0) { ph_norm_fast(p, l, 0, true, M, c.gw, c.NGW, c.lane);
                ph_bias2(p.WGU_T, 2 * FFN, modl + 3 * D, p.B2GU, c.gw, c.NGW, c.lane); }
        }
        if constexpr (s == 1) { pg8::Gemm g{p.XN, p.WIN_T, M, NPAD_IN, D}; pg8::StaticOrder S; S.init(M, NPAD_IN, c.G, (int)blockIdx.x);
            if constexpr (l == 0) { pg8::EpiInprojPost<false> E{p.P, p.AFB, p.SS1, p.B2IN, NPAD_IN, p.qn_a + l * 64, p.kn_a + l * 64, p.qn_b + l * 32, p.kn_b + l * 32, p.ROPE};
                pg8::gemm_phase<pg8::EpiInprojPost<false>, pg8::StaticOrder, true, true>(c.lds + RING_OFF, g, S, E); }
            else { pg8::EpiInprojPost<true> E{p.P, p.AFB, p.SS1, p.B2IN, NPAD_IN, p.qn_a + l * 64, p.kn_a + l * 64, p.qn_b + l * 32, p.kn_b + l * 32, p.ROPE};
                pg8::gemm_phase<pg8::EpiInprojPost<true>, pg8::StaticOrder, true, true>(c.lds + RING_OFF, g, S, E); } }
        if constexpr (s == 2) { for (long i = c.gtid; i < M; i += c.gsize) { p.SS2[i] = 0.f; if (l == 0) p.SS1[i] = 0.f; }
            if constexpr (l > 0) { ph_weights(p, l, c.lds, c.gw, c.NGW, c.wave, c.lane, 8); ph_bias2(p.WGU_T, 2 * FFN, modl + 3 * D, p.B2GU, c.gw, c.NGW, c.lane); __syncthreads(); }
            ph_gla_A(p, l, c.lds, (int)blockIdx.x, c.G);
#ifdef REP_A
            __syncthreads(); ph_gla_A(p, l, c.lds, (int)blockIdx.x, c.G); __syncthreads();
#endif
            ph_na_fast(p, l, wc, c.lds, (int)blockIdx.x, c.G);
#ifdef REP_NA
            __syncthreads(); ph_na_fast(p, l, wc, c.lds, (int)blockIdx.x, c.G);
#endif
            }
        if constexpr (s == 3) { ph_gla_B(p, (int)blockIdx.x, c.G);
            unsigned* ctlw = (unsigned*)(p.ws + WS_CTL);
            asm volatile("s_waitcnt vmcnt(0)" ::: "memory"); __syncthreads();
            if (c.wave == 0 && c.lane == 0) (void)xb_add(ctlw + CW_SPLIT + 192, 1u);
            ph_diff_fast(p, l, wc, c.lds, (int)blockIdx.x, c.G);
#ifdef REP_DIFF
            __syncthreads(); ph_diff_fast<REP_DIFF>(p, l, wc, c.lds, (int)blockIdx.x, c.G);
#endif
            if (c.wave == 0 && c.lane == 0) { XB_SPIN(xb_ld(ctlw + CW_SPLIT + 192) < (unsigned)(l + 1) * (unsigned)c.G, ctlw + CW_BAR); __builtin_amdgcn_fence(__ATOMIC_ACQUIRE, "agent"); asm volatile("s_waitcnt vmcnt(0)" ::: "memory"); }
            __syncthreads();
            ph_gla_C(p, l, wc, c.lds, (int)blockIdx.x, c.G);
        }
        if constexpr (s == 5) { pg8::Gemm g{p.XN, p.WOUT_T, mrows, D, D};
                      typedef pg8::EpiResidT<true, (l > 0), true> EpiO;
                      EpiO E{p.x, p.ctx, p.out, p.HC, modl + 2 * D, p.XN2, p.norm2 + (size_t)l * D, modl + 4 * D, p.SS2, (const bf16*)p.out, p.HB};
                      constexpr int ntl = ((mrows / 256) * (D / 256)) % 256;
                      if constexpr (ntl > 0 && ntl * SPLITK <= 256) { pg8::SplitTailOrder<SPLITK> S; S.init(mrows, D, D, c.G, (int)blockIdx.x, (float*)(p.ws + WS_R2), (unsigned*)(p.ws + WS_CTL) + CW_SPLIT, (volatile LAS unsigned*)(c.lds + MISC_OFF) + 12);
                          pg8::gemm_phase<EpiO, pg8::SplitTailOrder<SPLITK>, true, true>(c.lds + RING_OFF, g, S, E); }
                      else { pg8::StaticOrder S; S.init(mrows, D, c.G, (int)blockIdx.x); pg8::gemm_phase<EpiO, pg8::StaticOrder, true, true>(c.lds + RING_OFF, g, S, E); }
                      if constexpr (l + 1 < DEPTH) { constexpr int nfull = (ntl > 0 && ntl * SPLITK <= 256) ? ntl * SPLITK : ntl;
                          __syncthreads(); if ((int)blockIdx.x >= nfull && c.G == 256) ph_weights(p, l + 1, c.lds, ((int)blockIdx.x - nfull) * NWAVES + c.wave, (c.G - nfull) * NWAVES, c.wave, c.lane, 1);
                          else if (c.G != 256) ph_weights(p, l + 1, c.lds, c.gw, c.NGW, c.wave, c.lane, 1); } }
        if constexpr (s == 6) { pg8::Gemm g{p.XN2, p.WGU_T, mrows, 2 * FFN, D}; pg8::StaticOrder S; S.init(mrows, 2 * FFN, c.G, (int)blockIdx.x);
                      pg8::EpiGU E{p.ACT, p.EA, p.EU, p.conv_w + (size_t)l * 3 * FFN, p.conv_b + (size_t)l * FFN, p.SS2, p.B2GU};
                      pg8::gemm_phase<pg8::EpiGU, pg8::StaticOrder, true, true>(c.lds + RING_OFF, g, S, E); }
        if constexpr (s == 7) {
#ifdef OLD_FIX_PHASE
            ph_ffn_fix(p, l, mrows, c.gtid, c.gsize);
#endif
#ifdef CAL_VALU
            if constexpr (l == 0) { float a[16]; _Pragma("unroll") for (int i = 0; i < 16; ++i) a[i] = (float)(c.lane + i);
                for (int it = 0; it < CAL_VALU; ++it) { _Pragma("unroll") for (int i = 0; i < 16; ++i) a[i] = __builtin_fmaf(a[i], 1.0001f, 0.5f); asm volatile("" : "+v"(a[0]), "+v"(a[1]), "+v"(a[2]), "+v"(a[3])); }
                float sacc = 0.f; _Pragma("unroll") for (int i = 0; i < 16; ++i) sacc += a[i]; if (sacc == 1.2345f) p.SS2[0] = sacc; }
#endif
#ifdef CAL_MFMA
            if constexpr (l == 0) { f32x16 acc0, acc1; _Pragma("unroll") for (int i = 0; i < 16; ++i) { acc0[i] = 0.f; acc1[i] = 0.f; }
                bf16x8 av = {(short)c.lane, 1, 2, 3, 4, 5, 6, 7}, bv = {1, 2, 3, 4, 5, 6, 7, (short)c.lane};
                for (int it = 0; it < CAL_MFMA; ++it) { _Pragma("unroll") for (int i = 0; i < 4; ++i) { acc0 = MFMA32(av, bv, acc0); acc1 = MFMA32(bv, av, acc1); } }
                if (acc0[0] + acc1[3] == 1.2345f) p.SS2[0] = acc0[0]; }
#endif
        }
#define FIX_MY_TILES(SCHED) do { int last_pm_ = -1; pg8::Unit uu_; for (int i_ = 0; (SCHED).next(i_, uu_); ++i_) if (uu_.pm != last_pm_) { ffn_fix_rowtile(p, l, uu_.pm, c.wave * 64 + c.lane); last_pm_ = uu_.pm; } \
            asm volatile("s_waitcnt vmcnt(0)" ::: "memory"); __syncthreads(); } while (0)
        if constexpr (s == 8) { pg8::Gemm g{p.ACT, p.WD_T, mrows, D, FFN}; pg8::StaticOrder S; S.init(mrows, D, c.G, (int)blockIdx.x);
                      if constexpr (l + 1 < DEPTH) { const float* modn = p.MOD + (size_t)(l + 1) * (BATCH + 1) * 6 * D;
                          typedef pg8::EpiResidT<true, true, true> EpiD;
                          EpiD E{p.out, p.HC, p.out, p.HC, modl + 5 * D, p.XN, p.norm1 + (size_t)(l + 1) * D, modn + 1 * D, p.SS1, p.HB, (bf16*)p.out};
                          constexpr int ntl = ((mrows / 256) * (D / 256)) % 256;
                          if constexpr (ntl > 0 && ntl * SPLITK <= 256) { pg8::SplitTailOrder<SPLITK> S2; S2.init(mrows, D, FFN, c.G, (int)blockIdx.x, (float*)(p.ws + WS_XN2), (unsigned*)(p.ws + WS_CTL) + CW_SPLIT + 64, (volatile LAS unsigned*)(c.lds + MISC_OFF) + 12);
                              FIX_MY_TILES(S2); pg8::gemm_phase<EpiD, pg8::SplitTailOrder<SPLITK>, true, true>(c.lds + RING_OFF, g, S2, E); }
                          else { FIX_MY_TILES(S); pg8::gemm_phase<EpiD, pg8::StaticOrder, true, true>(c.lds + RING_OFF, g, S, E); }
                          constexpr int nfull = (ntl > 0 && ntl * SPLITK <= 256) ? ntl * SPLITK : ntl;
                          __syncthreads(); if ((int)blockIdx.x >= nfull && c.G == 256) { ph_weights(p, l + 1, c.lds, ((int)blockIdx.x - nfull) * NWAVES + c.wave, (c.G - nfull) * NWAVES, c.wave, c.lane, 6);
                              ph_bias2(p.WIN_T, NPAD_IN, modn + 0 * D, p.B2IN, ((int)blockIdx.x - nfull) * NWAVES + c.wave, (c.G - nfull) * NWAVES, c.lane); }
                          else if (c.G != 256) { ph_weights(p, l + 1, c.lds, c.gw, c.NGW, c.wave, c.lane, 6); ph_bias2(p.WIN_T, NPAD_IN, modn + 0 * D, p.B2IN, c.gw, c.NGW, c.lane); } }
                      else { typedef pg8::EpiResidT<false, true, false> EpiD;
                          EpiD E{p.out, p.HC, p.out, p.HC, modl + 5 * D, nullptr, nullptr, nullptr, nullptr, p.HB, nullptr};
                          FIX_MY_TILES(S); pg8::gemm_phase<EpiD, pg8::StaticOrder, true, true>(c.lds + RING_OFF, g, S, E); } }
#undef FIX_MY_TILES
    }
}

template <int PH> __device__ __forceinline__ void run_from(const Params& p, LAS unsigned char* c, const XcdBarrier& bar, int lo, int hi) {
    if constexpr (PH < N_PHASES) {
        constexpr bool EMPTY_PH = (PH > PH_PER_LAYER && ((PH - 1) % PH_PER_LAYER) == 0) || (PH > 0 && (((PH - 1) % PH_PER_LAYER) == 7 || ((PH - 1) % PH_PER_LAYER) == 4));
        if (lo <= PH && PH < hi && !EMPTY_PH) { run_phase<PH>(p, c);
#ifdef REP_S
            if constexpr ((PH > 0 && ((PH - 1) % PH_PER_LAYER) == REP_S) || (PH == 0 && REP_S == 9)) { xcd_barrier(bar);
#ifdef REP_NOSTORE
                { const Ctx cc = make_ctx(c); pg8::Gemm g{p.XN, p.WIN_T, M, NPAD_IN, D}; pg8::StaticOrder S; S.init(M, NPAD_IN, cc.G, (int)blockIdx.x);
                  pg8::EpiInprojT<true> E{(bf16*)(p.ws + WS_R2 + 140 * MiB), p.AFB}; pg8::gemm_phase<pg8::EpiInprojT<true>, pg8::StaticOrder, true, true>(cc.lds + RING_OFF, g, S, E); }
#else
                run_phase<PH>(p, c);
#endif
            }
#endif
            if (PH + 1 < hi) xcd_barrier(bar); }
        run_from<PH + 1>(p, c, bar, lo, hi);
    }
}

#ifdef PHASE_PROBE
template <int PH> __global__ void __launch_bounds__(NTHREADS, 2) k_probe(Args args) {
    extern __shared__ __attribute__((aligned(16))) unsigned char lds_raw[];
    run_phase<PH>(args.p, (LAS unsigned char*)lds_raw);
}
template __global__ void k_probe<0>(Args); template __global__ void k_probe<1>(Args); template __global__ void k_probe<2>(Args); template __global__ void k_probe<3>(Args);
template __global__ void k_probe<4>(Args); template __global__ void k_probe<5>(Args); template __global__ void k_probe<6>(Args); template __global__ void k_probe<7>(Args);
template __global__ void k_probe<8>(Args); template __global__ void k_probe<9>(Args); template __global__ void k_probe<12>(Args); template __global__ void k_probe<13>(Args);
#endif

__global__ void __launch_bounds__(NTHREADS, 2) mk_fwd(Args args) {
    extern __shared__ __attribute__((aligned(16))) unsigned char lds_raw[];
    LAS unsigned char* lds = (LAS unsigned char*)lds_raw;
    const Params& p = args.p;
    const int tid = threadIdx.x;
    volatile LAS unsigned* MISC = (volatile LAS unsigned*)(lds + MISC_OFF);
    for (int u = tid; u < (LDS_BYTES - LDSCTL_OFF) / 4; u += NTHREADS) ((LAS unsigned*)(lds + LDSCTL_OFF))[u] = 0u;
    __syncthreads();
    gu32* ctl = (gu32*)(p.ws + WS_CTL);
    XcdBarrier bar = xcd_barrier_post((unsigned*)(ctl + CW_BAR), MISC + 8);
    run_from<0>(p, lds, bar, args.ph_lo, args.ph_hi);
}

#ifndef MK_MULTI
#define MK_MULTI 0
#endif
extern "C" void kernel_launch(void* const* d_in, const int* in_sizes, int n_in, void* d_out, int out_size, void* d_ws, size_t ws_size, hipStream_t stream) {
    static int grid = 0;
    if (grid == 0) {
        if (n_in != 30 || in_sizes[0] != ML * D || out_size != ML * D || ws_size < WS_END) { fprintf(stderr, "kernel_launch: unexpected shapes: n_in %d in0 %d out %d ws %zu (need %zu)\n", n_in, n_in > 0 ? in_sizes[0] : -1, out_size, ws_size, (size_t)WS_END); grid = -1; return; }
        int dev = 0, cus = 0, per_cu = 0;
        if (hipGetDevice(&dev) != hipSuccess || hipDeviceGetAttribute(&cus, hipDeviceAttributeMultiprocessorCount, dev) != hipSuccess) { grid = -1; return; }
        if (hipFuncSetAttribute((const void*)mk_fwd, hipFuncAttributeMaxDynamicSharedMemorySize, LDS_BYTES) != hipSuccess) { fprintf(stderr, "kernel_launch: hipFuncSetAttribute failed\n"); grid = -1; return; }
        if (hipOccupancyMaxActiveBlocksPerMultiprocessor(&per_cu, (const void*)mk_fwd, NTHREADS, LDS_BYTES) != hipSuccess || per_cu < 1) { fprintf(stderr, "kernel_launch: occupancy query reports %d workgroups per CU; nothing launched\n", per_cu); (void)hipGetLastError(); grid = -1; return; }
        (void)hipGetLastError();
        grid = cus;
    }
    if (grid < 0) return;
    if (hipMemsetAsync((char*)d_ws + WS_CTL, 0, CTL_ZERO_BYTES, stream) != hipSuccess) { fprintf(stderr, "kernel_launch: memset failed\n"); return; }
    Args a; memset(&a, 0, sizeof(a));
    Params& p = a.p;
    const float* const* in = (const float* const*)d_in;
    p.x = in[0]; p.c = in[1]; p.ctx = in[2]; p.c_ctx = in[3]; p.norm1 = in[4]; p.norm2 = in[5]; p.w_ada = in[6]; p.b_ada = in[7]; p.w_in = in[8];
    p.qn_a = in[9]; p.kn_a = in[10]; p.rpb_a = in[11]; p.qn_b = in[12]; p.kn_b = in[13]; p.lam_q1 = in[14]; p.lam_k1 = in[15]; p.lam_q2 = in[16]; p.lam_k2 = in[17];
    p.subln_b = in[18]; p.w_a2_f = in[19]; p.b_a_f = in[20]; p.w_a2_b = in[21]; p.b_a_b = in[22]; p.onorm_c = in[23]; p.w_out = in[24]; p.w_g = in[25]; p.w_u = in[26];
    p.conv_w = in[27]; p.conv_b = in[28]; p.w_d = in[29];
    unsigned char* ws = (unsigned char*)d_ws;
    p.out = (float*)d_out; p.ws = ws;
    p.MOD = (float*)(ws + WS_MOD); p.ROPE = (float*)(ws + WS_ROPE); p.HC = (float*)(ws + WS_HC); p.XN = (bf16*)(ws + WS_XN); p.AFB = (bf16*)(ws + WS_AFB);
    p.P = (bf16*)(ws + WS_R1); p.GU = (bf16*)(ws + WS_R1); p.GO = (float*)(ws + WS_GO); p.ALF = (float*)(ws + WS_ALF); p.ALB = (float*)(ws + WS_ALB); p.DT = (float*)(ws + WS_DT); p.US = (float*)(ws + WS_US); p.EA = (bf16*)(ws + WS_EA); p.EU = (bf16*)(ws + WS_EU); p.XN2 = (bf16*)(ws + WS_XN2); p.HB = (bf16*)(ws + WS_HB); p.SS1 = (float*)(ws + WS_SS1); p.SS2 = (float*)(ws + WS_SS2); p.B2IN = (float*)(ws + WS_B2IN); p.B2GU = (float*)(ws + WS_B2GU); p.AD = (float*)(ws + WS_AD); p.ACT = (bf16*)(ws + WS_R2);
    p.WIN_T = (bf16*)(ws + WS_WIN); p.WOUT_T = (bf16*)(ws + WS_WOUT); p.WGU_T = (bf16*)(ws + WS_WGU); p.WD_T = (bf16*)(ws + WS_WD);
#if MK_MULTI
    for (int ph = 0; ph < N_PHASES; ++ph) { a.ph_lo = ph; a.ph_hi = ph + 1; hipLaunchKernelGGL(mk_fwd, dim3(grid), dim3(NTHREADS), LDS_BYTES, stream, a); }
#else
    a.ph_lo = 0; a.ph_hi = N_PHASES;
    hipLaunchKernelGGL(mk_fwd, dim3(grid), dim3(NTHREADS), LDS_BYTES, stream, a);
#endif
    const hipError_t le = hipPeekAtLastError();
    if (le != hipSuccess) fprintf(stderr, "kernel_launch: launch failed: %s\n", hipGetErrorName(le));
}
```

```cpp
#include <hip/hip_runtime.h>
#include <cstdio>
#include <cstdint>
#include <cstring>
#include <cmath>
#define HD __device__ __attribute__((always_inline))
#define NAIVE_GLA_GATES 0
#ifdef HOST_TEST
constexpr int D = HT_D, BATCH = HT_B, SEQ = HT_S, CTX = HT_C;
#else
constexpr int D = 1024, BATCH = 8, SEQ = 4096, CTX = 256;
#endif
constexpr int DEPTH = 2, GRID_W = 64, ROWS = SEQ / GRID_W;
constexpr int NAH = D / 256, DAH = D / 256, GLH = D / 256;
constexpr int NA_W = NAH * 64, DQK_W = DAH * 64, DV_W = DAH * 64, GK_W = GLH * 64, GV_W = GLH * 128;
constexpr int FFN = ((8 * D) / 3 + 127) / 128 * 128;
constexpr int IN_W = 3 * NA_W + 2 * DQK_W + DV_W + 2 * GK_W + 2 * GV_W + 32;
constexpr int PW = IN_W - 32;
constexpr int C_QA = 0, C_KA = NA_W, C_VA = 2 * NA_W, C_QB = 3 * NA_W, C_KB = C_QB + DQK_W, C_VB = C_KB + DQK_W;
constexpr int C_QC = C_VB + DV_W, C_KC = C_QC + GK_W, C_VC = C_KC + GK_W, C_GC = C_VC + GV_W;
constexpr int ML = BATCH * SEQ, MC = BATCH * CTX, M = ML + MC;
constexpr int MO_A = 0, MO_B = NA_W, MO_C = NA_W + DV_W;
constexpr int NT_F = FFN / 128;
constexpr int NT_H0 = (NT_F + 1) / 2;
constexpr int GUP = 256 * NT_H0;
constexpr float EPS = 1e-6f, LOG2E = 1.4426950408889634f;

#define UNR _Pragma("unroll")
typedef unsigned short bf16;
HD inline float bf2f(bf16 v) { unsigned u = (unsigned)v << 16; float f; __builtin_memcpy(&f, &u, 4); return f; }
HD inline bf16 f2bf(float f) { unsigned u; __builtin_memcpy(&u, &f, 4); return (bf16)((u + 0x7fffu + ((u >> 16) & 1u)) >> 16); }

struct alignas(16) U4 { unsigned x, y, z, w; };
HD inline void ld8(const bf16* p, float* o) {
    const U4 v = *(const U4*)p;
    unsigned u;
    u = v.x << 16; __builtin_memcpy(&o[0], &u, 4); u = v.x & 0xffff0000u; __builtin_memcpy(&o[1], &u, 4);
    u = v.y << 16; __builtin_memcpy(&o[2], &u, 4); u = v.y & 0xffff0000u; __builtin_memcpy(&o[3], &u, 4);
    u = v.z << 16; __builtin_memcpy(&o[4], &u, 4); u = v.z & 0xffff0000u; __builtin_memcpy(&o[5], &u, 4);
    u = v.w << 16; __builtin_memcpy(&o[6], &u, 4); u = v.w & 0xffff0000u; __builtin_memcpy(&o[7], &u, 4);
}
struct Params {
    const float *x, *c, *ctx, *c_ctx, *norm1, *norm2, *w_ada, *b_ada, *w_in, *qn_a, *kn_a, *rpb_a, *qn_b, *kn_b;
    const float *lam_q1, *lam_k1, *lam_q2, *lam_k2, *subln_b, *w_a2_f, *b_a_f, *w_a2_b, *b_a_b, *onorm_c, *w_out, *w_g, *w_u, *conv_w, *conv_b, *w_d;
    float* out;
    unsigned char* ws;
    float* MOD;
    float* ROPE;
    float* HC;
    bf16* XN;
    bf16* AFB;
    bf16* P;
    bf16* GU;
    float* GO;
    float* ALF;
    float* ALB;
    float* DT;
    float* US;
    float* AD;
    bf16* EA;
    bf16* EU;
    bf16* HB;
    bf16* XN2;
    float* SS1; float* SS2;
    float* B2IN; float* B2GU;
    bf16* ACT;
    bf16 *WIN_T, *WOUT_T, *WGU_T, *WD_T;
};

HD inline float silu_f(float x) { return x / (1.0f + expf(-x)); }
HD inline float logsigmoid_f(float x) { return fminf(x, 0.0f) - log1pf(expf(-fabsf(x))); }
HD inline int clampi(int v, int lo, int hi) { return v < lo ? lo : (v > hi ? hi : v); }
HD inline int row_batch_slot(int m) { return m < ML ? m / SEQ : BATCH; }
HD inline const float* mod_vec(const Params& p, int l, int m, int which) {
    const int j = m < ML ? m / SEQ : BATCH;
    return p.MOD + ((size_t)(l * (BATCH + 1) + j) * 6 + which) * D;
}
HD inline float* hrow(const Params& p, int m) { return m < ML ? p.out + (size_t)m * D : p.HC + (size_t)(m - ML) * D; }
HD inline const float* xrow(const Params& p, int m) { return m < ML ? p.x + (size_t)m * D : p.ctx + (size_t)(m - ML) * D; }

HD inline void ph_mod(const Params& p, long gtid, long gsize) {
    const long N = (long)DEPTH * (BATCH + 1) * 6 * D;
    for (long i = gtid; i < N; i += gsize) {
        const int n = (int)(i % (6 * D)); const int j = (int)((i / (6 * D)) % (BATCH + 1)); const int l = (int)(i / ((long)6 * D * (BATCH + 1)));
        const float* cv = j < BATCH ? p.c + (size_t)j * D : p.c_ctx;
        const float* w = p.w_ada + (size_t)l * D * 6 * D + n;
        float acc = 0.f;
        for (int k = 0; k < D; ++k) acc += silu_f(cv[k]) * w[(size_t)k * 6 * D];
        p.MOD[i] = acc + p.b_ada[(size_t)l * 6 * D + n];
    }
    for (long i = gtid; i < 64 * 8; i += gsize) {
        const int pos = (int)(i / 8), f = (int)(i % 8);
        const float inv = expf(-((float)f / 8.0f) * logf(10000.0f));
        const float ang = (float)pos * inv;
        p.ROPE[2 * i] = cosf(ang); p.ROPE[2 * i + 1] = sinf(ang);
    }
}

HD inline void ph_norm_naive(const Params& p, int l, int which, bool from_input, int mrows, long gtid, long gsize) {
    for (long m = gtid; m < mrows; m += gsize) {
        const float* h = from_input ? xrow(p, (int)m) : hrow(p, (int)m);
        const float* g = (which ? p.norm2 : p.norm1) + (size_t)l * D;
        const float* sh = mod_vec(p, l, (int)m, which ? 3 : 0); const float* sc = mod_vec(p, l, (int)m, which ? 4 : 1);
        float ss = 0.f; for (int k = 0; k < D; ++k) ss += h[k] * h[k];
        const float rstd = 1.0f / sqrtf(ss / D + EPS);
        bf16* o = p.XN + (size_t)m * D;
        for (int k = 0; k < D; ++k) o[k] = f2bf((h[k] * rstd * g[k]) * (1.0f + sc[k]) + sh[k]);
    }
}

#ifndef NAIVE_GLA_GATES
#define NAIVE_GLA_GATES 1
#endif
constexpr int POST_ITEMS = 2 * NAH + 4 * DAH + GLH + (NAIVE_GLA_GATES ? 2 * GLH : 0);
HD inline void ph_post_naive(const Params& p, int l, long gtid, long gsize) {
    const long N = (long)M * POST_ITEMS;
    for (long i = gtid; i < N; i += gsize) {
        const int m = (int)(i / POST_ITEMS); int it = (int)(i % POST_ITEMS);
        bf16* pr = p.P + (size_t)m * PW;
        if (it < 2 * NAH) {
            const bool isq = it < NAH; const int h = isq ? it : it - NAH;
            bf16* v = pr + (isq ? C_QA : C_KA) + h * 64; const float* g = (isq ? p.qn_a : p.kn_a) + l * 64;
            float x[64], ss = 0.f; UNR for (int d = 0; d < 64; ++d) { x[d] = bf2f(v[d]); ss += x[d] * x[d]; }
            const float r = 1.0f / sqrtf(ss / 64 + EPS) * (isq ? 0.125f * LOG2E : 1.0f);
            UNR for (int d = 0; d < 64; ++d) v[d] = f2bf(x[d] * r * g[d]);
            continue;
        }
        it -= 2 * NAH;
        if (it < 4 * DAH) {
            const bool isq = it < 2 * DAH; const int hc = isq ? it : it - 2 * DAH;
            bf16* v = pr + (isq ? C_QB : C_KB) + hc * 32; const float* g = (isq ? p.qn_b : p.kn_b) + l * 32;
            float x[32], ss = 0.f; UNR for (int d = 0; d < 32; ++d) { x[d] = bf2f(v[d]); ss += x[d] * x[d]; }
            const float r = 1.0f / sqrtf(ss / 32 + EPS);
            UNR for (int d = 0; d < 32; ++d) x[d] = x[d] * r * g[d];
            if (m < ML) {
                const int t = m % SEQ, row = t / GRID_W, col = t % GRID_W;
                UNR for (int f = 0; f < 8; ++f) {
                    const float cr = p.ROPE[(row * 8 + f) * 2], sr = p.ROPE[(row * 8 + f) * 2 + 1];
                    const float a = x[f], b = x[f + 8]; x[f] = a * cr - b * sr; x[f + 8] = b * cr + a * sr;
                    const float cc = p.ROPE[(col * 8 + f) * 2], sn = p.ROPE[(col * 8 + f) * 2 + 1];
                    const float a2 = x[16 + f], b2 = x[24 + f]; x[16 + f] = a2 * cc - b2 * sn; x[24 + f] = b2 * cc + a2 * sn;
                }
            }
            const float s = isq ? 0.17677669529663687f * LOG2E : 1.0f;
            UNR for (int d = 0; d < 32; ++d) v[d] = f2bf(x[d] * s);
            continue;
        }
        it -= 4 * DAH;
        if (it < GLH) {
            bf16* v = pr + C_QC + it * 64;
            UNR for (int d = 0; d < 64; ++d) v[d] = f2bf(bf2f(v[d]) * 0.125f);
            continue;
        }
        it -= GLH;
        {
            const int dir = it / GLH, h = it % GLH;
            const bf16* a = p.AFB + (size_t)m * 32 + dir * 16;
            const float* w2 = (dir ? p.w_a2_b : p.w_a2_f) + (size_t)l * 16 * GK_W + h * 64;
            const float* bb = (dir ? p.b_a_b : p.b_a_f) + (size_t)l * GK_W + h * 64;
            float* o = (dir ? p.ALB : p.ALF) + (size_t)m * GK_W + h * 64;
            float av[16]; UNR for (int r = 0; r < 16; ++r) av[r] = bf2f(a[r]);
            UNR for (int d = 0; d < 64; ++d) {
                float xx = bb[d]; UNR for (int r = 0; r < 16; ++r) xx += av[r] * w2[(size_t)r * GK_W + d];
                o[d] = expf(logsigmoid_f(xx) * (1.0f / 16.0f));
            }
        }
    }
}

HD inline void ph_na_naive(const Params& p, int l, bool with_ctx, long gtid, long gsize) {
    const int mq = with_ctx ? M : ML; const long N = (long)NAH * mq;
    for (long i = gtid; i < N; i += gsize) {
        const int m = (int)(i % mq), h = (int)(i / mq);
        float q[64], o[64]; const bf16* qp = p.P + (size_t)m * PW + C_QA + h * 64;
        UNR for (int d = 0; d < 64; ++d) { q[d] = bf2f(qp[d]); o[d] = 0.f; }
        float mx = -1e30f, ls = 0.f;
        const int b = m < ML ? m / SEQ : (m - ML) / CTX;
        if (m < ML) {
            const int t = m % SEQ, r = t / GRID_W, w = t % GRID_W;
            const int r0 = clampi(r - 4, 0, ROWS - 8), c0 = clampi(w - 8, 0, GRID_W - 16);
            const float* rpb = p.rpb_a + ((size_t)l * NAH + h) * 15 * 31;
            for (int kk = 0; kk < 128; ++kk) {
                const int kr = r0 + (kk >> 4), kc = c0 + (kk & 15); const int km = b * SEQ + kr * GRID_W + kc;
                const bf16* kp = p.P + (size_t)km * PW + C_KA + h * 64; const bf16* vp = p.P + (size_t)km * PW + C_VA + h * 64;
                float s = 0.f; UNR for (int d8 = 0; d8 < 8; ++d8) { float t[8]; ld8(kp + 8 * d8, t); UNR for (int e = 0; e < 8; ++e) s += q[8 * d8 + e] * t[e]; }
                s += rpb[(kr - r + 7) * 31 + (kc - w + 15)] * LOG2E;
                const float mn = fmaxf(mx, s), al = exp2f(mx - mn), pe = exp2f(s - mn);
                ls = ls * al + pe; UNR for (int d8 = 0; d8 < 8; ++d8) { float t[8]; ld8(vp + 8 * d8, t); UNR for (int e = 0; e < 8; ++e) o[8 * d8 + e] = o[8 * d8 + e] * al + pe * t[e]; } mx = mn;
            }
        }
        for (int j = 0; j < CTX; ++j) {
            const int km = ML + b * CTX + j;
            const bf16* kp = p.P + (size_t)km * PW + C_KA + h * 64; const bf16* vp = p.P + (size_t)km * PW + C_VA + h * 64;
            float s = 0.f; UNR for (int d8 = 0; d8 < 8; ++d8) { float t[8]; ld8(kp + 8 * d8, t); UNR for (int e = 0; e < 8; ++e) s += q[8 * d8 + e] * t[e]; }
            const float mn = fmaxf(mx, s), al = exp2f(mx - mn), pe = exp2f(s - mn);
            ls = ls * al + pe; UNR for (int d8 = 0; d8 < 8; ++d8) { float t[8]; ld8(vp + 8 * d8, t); UNR for (int e = 0; e < 8; ++e) o[8 * d8 + e] = o[8 * d8 + e] * al + pe * t[e]; } mx = mn;
        }
        bf16* op = p.XN + (size_t)m * D + MO_A + h * 64; const float il = 1.0f / ls;
        UNR for (int d = 0; d < 64; ++d) op[d] = f2bf(o[d] * il);
    }
}

HD inline float lam_of(const Params& p, int l, float lam_init) {
    float s1 = 0.f, s2 = 0.f;
    for (int i = 0; i < 32; ++i) { s1 += p.lam_q1[l * 32 + i] * p.lam_k1[l * 32 + i]; s2 += p.lam_q2[l * 32 + i] * p.lam_k2[l * 32 + i]; }
    return expf(s1) - expf(s2) + lam_init;
}
HD inline float lam_init_of(int l) { return 0.8f - 0.6f * expf(-0.3f * (float)l); }

HD inline void ph_diff_naive(const Params& p, int l, bool with_ctx, long gtid, long gsize) {
    const int mq = with_ctx ? M : ML; const long N = (long)DAH * mq;
    const float lam_init = lam_init_of(l), lam = lam_of(p, l, lam_init);
    for (long i = gtid; i < N; i += gsize) {
        const int m = (int)(i % mq), h = (int)(i / mq);
        const int b = m < ML ? m / SEQ : (m - ML) / CTX;
        float* dt = p.DT + (size_t)m * DV_W + h * 64;
        float o[64];
        for (int c = 0; c < 2; ++c) {
            float q[32]; const bf16* qp = p.P + (size_t)m * PW + C_QB + h * 64 + c * 32;
            UNR for (int d = 0; d < 32; ++d) q[d] = bf2f(qp[d]);
            UNR for (int d = 0; d < 64; ++d) o[d] = 0.f;
            float mx = -1e30f, ls = 0.f;
            const int nk = (m < ML ? SEQ : 0) + CTX;
            for (int kk = 0; kk < nk; ++kk) {
                const int km = (m < ML) ? (kk < SEQ ? b * SEQ + kk : ML + b * CTX + (kk - SEQ)) : ML + b * CTX + kk;
                const bf16* kp = p.P + (size_t)km * PW + C_KB + h * 64 + c * 32; const bf16* vp = p.P + (size_t)km * PW + C_VB + h * 64;
                float s = 0.f; UNR for (int d8 = 0; d8 < 4; ++d8) { float t[8]; ld8(kp + 8 * d8, t); UNR for (int e = 0; e < 8; ++e) s += q[8 * d8 + e] * t[e]; }
                const float mn = fmaxf(mx, s), al = exp2f(mx - mn), pe = exp2f(s - mn);
                ls = ls * al + pe; UNR for (int d8 = 0; d8 < 8; ++d8) { float t[8]; ld8(vp + 8 * d8, t); UNR for (int e = 0; e < 8; ++e) o[8 * d8 + e] = o[8 * d8 + e] * al + pe * t[e]; } mx = mn;
            }
            const float il = 1.0f / ls;
            if (c == 0) { UNR for (int d = 0; d < 64; ++d) dt[d] = o[d] * il; }
            else { UNR for (int d = 0; d < 64; ++d) o[d] = dt[d] - lam * (o[d] * il); }
        }
        float* res = o;
        float ss = 0.f; UNR for (int d = 0; d < 64; ++d) ss += res[d] * res[d];
        const float r = 1.0f / sqrtf(ss / 64 + EPS) * (1.0f - lam_init);
        bf16* op = p.XN + (size_t)m * D + MO_B + h * 64;
        UNR for (int d = 0; d < 64; ++d) op[d] = f2bf(res[d] * r * p.subln_b[l * 64 + d]);
    }
}

HD inline void ph_gla_naive(const Params& p, long gtid, long gsize) {
    const long N = (long)BATCH * GLH * 128;
    for (long i = gtid; i < N; i += gsize) {
        const int v = (int)(i % 128), h = (int)((i / 128) % GLH), b = (int)(i / (128 * GLH));
        for (int dir = 0; dir < 2; ++dir) {
            float S[64]; UNR for (int d = 0; d < 64; ++d) S[d] = 0.f;
            const float* AL = dir ? p.ALB : p.ALF;
            for (int s = 0; s < CTX + SEQ; ++s) {
                int m;
                if (s < CTX) m = ML + b * CTX + (dir ? CTX - 1 - s : s);
                else m = b * SEQ + (dir ? SEQ - 1 - (s - CTX) : (s - CTX));
                const bf16* pr = p.P + (size_t)m * PW; const float* al = AL + (size_t)m * GK_W + h * 64;
                const float vv = bf2f(pr[C_VC + h * 128 + v]);
                float o = 0.f;
                UNR for (int d8 = 0; d8 < 8; ++d8) { float tk[8], tq[8]; ld8(pr + C_KC + h * 64 + 8 * d8, tk); ld8(pr + C_QC + h * 64 + 8 * d8, tq);
                    UNR for (int e = 0; e < 8; ++e) { const int d = 8 * d8 + e; S[d] = al[d] * S[d] + tk[e] * vv; o += tq[e] * S[d]; } }
                float* go = p.GO + (size_t)m * GV_W + h * 128 + v;
                if (dir == 0) *go = o; else *go += o;
            }
        }
    }
}
HD inline void ph_gla_out_naive(const Params& p, int l, bool with_ctx, long gtid, long gsize) {
    const int mq = with_ctx ? M : ML; const long N = (long)GLH * mq;
    for (long i = gtid; i < N; i += gsize) {
        const int m = (int)(i % mq), h = (int)(i / mq);
        const float* go = p.GO + (size_t)m * GV_W + h * 128; const bf16* gc = p.P + (size_t)m * PW + C_GC + h * 128;
        float ss = 0.f; for (int v = 0; v < 128; ++v) ss += go[v] * go[v];
        const float r = 1.0f / sqrtf(ss / 128 + EPS);
        bf16* op = p.XN + (size_t)m * D + MO_C + h * 128;
        for (int v = 0; v < 128; ++v) op[v] = f2bf(go[v] * r * p.onorm_c[l * 128 + v] * silu_f(bf2f(gc[v])));
    }
}

HD inline void ph_act_naive(const Params& p, int l, int half, int mrows, long gtid, long gsize) {
    const int t0 = half ? NT_H0 : 0, nt = half ? NT_F - NT_H0 : NT_H0; const int nf = nt * 128;
    const long N = (long)mrows * nf;
    for (long i = gtid; i < N; i += gsize) {
        const int m = (int)(i / nf), fl = (int)(i % nf); const int j = fl / 128, ii = fl % 128; const int f = (t0 + j) * 128 + ii;
        int pos, len; if (m < ML) { pos = m % SEQ; len = SEQ; } else { pos = (m - ML) % CTX; len = CTX; }
        const bf16* g = p.GU + (size_t)m * GUP + j * 256 + ii;
        const float* cw = p.conv_w + (size_t)l * 3 * FFN;
        float a = p.conv_b[(size_t)l * FFN + f] + cw[FFN + f] * bf2f(g[0]);
        if (pos > 0) a += cw[f] * bf2f(g[-(long)GUP]);
        if (pos < len - 1) a += cw[2 * FFN + f] * bf2f(g[GUP]);
        p.ACT[(size_t)m * FFN + f] = f2bf(silu_f(a) * bf2f(g[128]));
    }
}
namespace pg8 {
#define PG8_LAS __attribute__((address_space(3)))
typedef unsigned short bf16_t;
typedef short bf16x8 __attribute__((ext_vector_type(8)));
typedef float f32x4 __attribute__((ext_vector_type(4)));
typedef unsigned u32x4 __attribute__((ext_vector_type(4)));
constexpr int BM = 256, BK = 64, HALF = 128, HTB = HALF * BK * 2  , STAGE_BYTES = 8 * HTB, NXCD = 8, WGM = 8;

__host__ __device__ __forceinline__ int lds_byte(int r, int c) { const int st = (r >> 4) * 2 + (c >> 5), rr = r & 15, cc = c & 31, ob = rr * 64 + cc * 2; return st * 1024 + (ob ^ (((ob >> 9) & 1) << 5)); }
__host__ __device__ __forceinline__ void stage_rc(int b, int& R, int& C) { const int st = b / 1024, sb = b % 1024, swz = sb ^ (((sb >> 9) & 1) << 5); R = (st >> 1) * 16 + swz / 64; C = (st & 1) * 32 + (swz % 64) / 2; }
__host__ __device__ __forceinline__ int perm32(int rho) { const int n = rho >> 4, i = rho & 15; return 8 * (i >> 2) + 4 * n + (i & 3); }

struct Unit { int pm, pn; int k0, nk, sp, ti; };
struct Gemm { const bf16_t* A; const bf16_t* Bt; int M, N, K; };

struct StaticOrder {
    int nM, nN, nwg, G, c;
    __host__ __device__ void init(int M, int N, int G_, int c_) { nM = M / BM; nN = N / BM; nwg = nM * nN; G = G_; c = c_; }
    __host__ __device__ bool next(int i, Unit& u) const {
        const long L = (long)i * G + c; if (L >= nwg) return false;
        int wgid = (int)L; { const int q = nwg / NXCD, r = nwg % NXCD, xcd = wgid % NXCD, off = wgid / NXCD; wgid = (xcd < r ? xcd * (q + 1) : r * (q + 1) + (xcd - r) * q) + off; }
        const int nig = WGM * nN, gid = wgid / nig, fm = gid * WGM, gsz = (nM - fm) < WGM ? (nM - fm) : WGM;
        u.pm = fm + ((wgid % nig) % gsz); u.pn = (wgid % nig) / gsz; return true;
    }
    __device__ __forceinline__ void a_ready(const Unit&) const {}
    __device__ __forceinline__ void done(const Unit&) const {}
    static constexpr bool SPLITK = false;
};
template <int NS_> struct SplitTailOrder {
    static constexpr bool SPLITK = true; static constexpr int NS = NS_;
    StaticOrder so; int nfull, ntail, nkt; bool on; float* part; unsigned* cnt; volatile PG8_LAS unsigned* flag;
    __device__ void init(int M, int N, int K, int G_, int c_, float* part_, unsigned* cnt_, volatile PG8_LAS unsigned* flag_) {
        so.init(M, N, G_, c_); nkt = K / BK; ntail = so.nwg % G_; nfull = so.nwg - ntail; part = part_; cnt = cnt_; flag = flag_;
        on = ntail > 0 && ntail * NS <= G_ && (nkt / 2) >= NS; }
    __device__ bool next(int i, Unit& u) const {
        const long L = (long)i * so.G + so.c; u.k0 = 0; u.nk = nkt; u.sp = -1; u.ti = 0;
        if (!on || L < nfull) return so.next(i, u);
        const int j = (int)(L - nfull); if (j >= ntail * NS) return false;
        const int tix = j % ntail, s = j / ntail; StaticOrder t = so; t.c = 0; t.G = 1; (void)t.next(nfull + tix, u);
        const int pairs = nkt / 2, base = pairs / NS, rem = pairs % NS;
        u.k0 = 2 * (s * base + (s < rem ? s : rem)); u.nk = 2 * (base + (s < rem ? 1 : 0)); u.sp = s; u.ti = tix; return true;
    }
    __device__ __forceinline__ void a_ready(const Unit&) const {}
    __device__ __forceinline__ void done(const Unit&) const {}
};

__device__ __forceinline__ unsigned cvt_pk_bf16(float lo, float hi) { unsigned r; asm volatile("v_cvt_pk_bf16_f32 %0, %1, %2" : "=v"(r) : "v"(lo), "v"(hi)); return r; }
struct NoPre {};
template <class T, class = void> struct PreOf { typedef NoPre type;
    template <class U> static __device__ __forceinline__ NoPre get(const T&, const U&, int, int, int, int) { return NoPre{}; }
    template <class A, class U> static __device__ __forceinline__ void call(const T& E, A& acc, const U& u, int wr, int wc, int fr, int fq, const NoPre&) { E(acc, u, wr, wc, fr, fq); } };
template <class T> struct PreOf<T, decltype((void)sizeof(typename T::Pre))> { typedef typename T::Pre type;
    template <class U> static __device__ __forceinline__ type get(const T& E, const U& u, int wr, int wc, int fr, int fq) { return E.pre(u, wr, wc, fr, fq); }
    template <class A, class U> static __device__ __forceinline__ void call(const T& E, A& acc, const U& u, int wr, int wc, int fr, int fq, const type& p) { E(acc, u, wr, wc, fr, fq, p); } };
template <class Epi, class Sched, bool ALIGN_EPI = false, bool SP2 = false>
__device__ __forceinline__ void gemm_phase(PG8_LAS unsigned char* lds, const Gemm g, const Sched& S, const Epi& E) {
    const int tid = threadIdx.x, wid = __builtin_amdgcn_readfirstlane(tid >> 6), lane = tid & 63, wr = wid >> 2, wc = wid & 3, fr = lane & 15, fq = lane >> 4;
    const int K = g.K, nt = K / BK;
    unsigned voffA[2], voffB[2];
#pragma unroll
    for (int i = 0; i < 2; ++i) { int R, C; stage_rc(tid * 16 + i * 8192, R, C); const int Rb = Epi::PERM ? ((R & ~31) + perm32(R & 31)) : R;
        voffA[i] = (unsigned)(R * K + C) * 2u; voffB[i] = (unsigned)(Rb * K + C) * 2u; }
    const size_t kstep = (size_t)(BK * 2);
    const size_t hstep = (size_t)HALF * K * 2;
    const size_t tstep = 2 * hstep;
    const unsigned ldsw = (unsigned)wid * 1024u;
    const int aoff = lds_byte(wr * 64 + fr, fq * 8), boff = lds_byte(wc * 32 + fr, fq * 8);
#define PG8_SA(b, h) (((b) * 2 + (h)) * HTB)
#define PG8_SB(b, h) ((4 + (b) * 2 + (h)) * HTB)
#define PG8_STAGE(bufoff, gbase, voff) do { _Pragma("unroll") for (int _i = 0; _i < 2; ++_i) \
        __builtin_amdgcn_global_load_lds((const unsigned*)((const char*)(gbase) + (voff)[_i]), (PG8_LAS unsigned*)(lds + (bufoff) + ldsw + _i * 8192), 16, 0, 0); } while (0)
#define PG8_LDA(dst, b, h) do { _Pragma("unroll") for (int m = 0; m < 4; ++m) _Pragma("unroll") for (int k = 0; k < 2; ++k) dst[m][k] = *(const PG8_LAS bf16x8*)(lds + PG8_SA(b, h) + aoff + m * 2048 + k * 1024); } while (0)
#define PG8_LDB(dst, b, h) do { _Pragma("unroll") for (int n = 0; n < 2; ++n) _Pragma("unroll") for (int k = 0; k < 2; ++k) dst[n][k] = *(const PG8_LAS bf16x8*)(lds + PG8_SB(b, h) + boff + n * 2048 + k * 1024); } while (0)
#define PG8_MMA(ai, bj, At, Bt) do { __builtin_amdgcn_s_setprio(1); _Pragma("unroll") for (int m = 0; m < 4; ++m) _Pragma("unroll") for (int n = 0; n < 2; ++n) _Pragma("unroll") for (int k = 0; k < 2; ++k) \
        acc[ai][bj][m][n] = __builtin_amdgcn_mfma_f32_16x16x32_bf16(Bt[n][k], At[m][k], acc[ai][bj][m][n], 0, 0, 0); __builtin_amdgcn_s_setprio(0); } while (0)
#define PG8_WAIT_V(n) asm volatile("s_waitcnt vmcnt(" #n ")" ::: "memory")
#define PG8_WAIT_L(n) asm volatile("s_waitcnt lgkmcnt(" #n ")" ::: "memory")
#define PG8_BAR __builtin_amdgcn_s_barrier()
#define PG8_SCHED __builtin_amdgcn_sched_barrier(0)
    Unit cur, nxt; int ui = 0;
    if (!S.next(0, cur)) return;
    f32x4 acc[2][2][4][2];
#pragma unroll
    for (int a = 0; a < 2; ++a)
#pragma unroll
        for (int b = 0; b < 2; ++b)
#pragma unroll
            for (int m = 0; m < 4; ++m)
#pragma unroll
                for (int n = 0; n < 2; ++n) acc[a][b][m][n] = (f32x4){0.f, 0.f, 0.f, 0.f};
    bf16x8 At[4][2], B0[2][2], B1[2][2];
    const char* cA = (const char*)g.A + (size_t)cur.pm * tstep; const char* cB = (const char*)g.Bt + (size_t)cur.pn * tstep;
    if constexpr (Sched::SPLITK) { cA += (size_t)cur.k0 * kstep; cB += (size_t)cur.k0 * kstep; }
    S.a_ready(cur);
    if constexpr (SP2) {
        PG8_STAGE(PG8_SB(0, 0), cB, voffB); PG8_STAGE(PG8_SB(0, 1), cB + hstep, voffB); PG8_STAGE(PG8_SA(0, 0), cA, voffA); PG8_STAGE(PG8_SA(0, 1), cA + hstep, voffA);
        if (wr == 1) PG8_BAR;
        PG8_WAIT_V(2); PG8_BAR;
        PG8_STAGE(PG8_SB(1, 0), cB + kstep, voffB); PG8_STAGE(PG8_SA(1, 0), cA + kstep, voffA); PG8_STAGE(PG8_SB(1, 1), cB + hstep + kstep, voffB);
        PG8_WAIT_V(6); PG8_BAR;
    } else {
        PG8_STAGE(PG8_SB(0, 0), cB, voffB); PG8_STAGE(PG8_SA(0, 0), cA, voffA); PG8_STAGE(PG8_SB(0, 1), cB + hstep, voffB); PG8_STAGE(PG8_SA(0, 1), cA + hstep, voffA);
        if (wr == 1) PG8_BAR;
        PG8_WAIT_V(4); PG8_BAR;
        PG8_STAGE(PG8_SB(1, 0), cB + kstep, voffB); PG8_STAGE(PG8_SA(1, 0), cA + kstep, voffA); PG8_STAGE(PG8_SB(1, 1), cB + hstep + kstep, voffB);
        PG8_WAIT_V(6); PG8_BAR;
    }
    for (;;) {
        const bool has_next = S.next(ui + 1, nxt);
        const char* nA = has_next ? (const char*)g.A + (size_t)nxt.pm * tstep : cA; const char* nB = has_next ? (const char*)g.Bt + (size_t)nxt.pn * tstep : cB;
        if constexpr (Sched::SPLITK) { if (has_next) { nA += (size_t)nxt.k0 * kstep; nB += (size_t)nxt.k0 * kstep; } }
        const int unt = Sched::SPLITK ? cur.nk : nt;
        for (int t = 0; t < unt; t += 2) {
            const bool last = (t == unt - 2);
            const char* a1 = cA + (size_t)(t + 1) * kstep;
            const char* a2 = last ? nA : cA + (size_t)(t + 2) * kstep; const char* b2 = last ? nB : cB + (size_t)(t + 2) * kstep;
            const char* a3 = a2 + kstep; const char* b3 = b2 + kstep;
            if (last && has_next) S.a_ready(nxt);
            if constexpr (SP2) {
            PG8_LDB(B0, 0, 0); PG8_LDB(B1, 0, 1); PG8_SCHED; PG8_LDA(At, 0, 0); PG8_STAGE(PG8_SA(1, 1), a1 + hstep, voffA);
            PG8_WAIT_V(8); PG8_WAIT_L(0); PG8_BAR; PG8_MMA(0, 0, At, B0); PG8_MMA(0, 1, At, B1); PG8_BAR; PG8_SCHED;
            PG8_LDA(At, 0, 1); PG8_STAGE(PG8_SB(0, 0), b2, voffB); PG8_STAGE(PG8_SB(0, 1), b2 + hstep, voffB); PG8_STAGE(PG8_SA(0, 0), a2, voffA);
            PG8_WAIT_V(8); PG8_WAIT_L(0); PG8_BAR; PG8_MMA(1, 0, At, B0); PG8_MMA(1, 1, At, B1); PG8_BAR; PG8_SCHED;
            PG8_LDB(B0, 1, 0); PG8_LDB(B1, 1, 1); PG8_SCHED; PG8_LDA(At, 1, 0); PG8_STAGE(PG8_SA(0, 1), a2 + hstep, voffA);
            PG8_WAIT_V(8); PG8_WAIT_L(0); PG8_BAR; PG8_MMA(0, 0, At, B0); PG8_MMA(0, 1, At, B1); PG8_BAR; PG8_SCHED;
            PG8_LDA(At, 1, 1); PG8_STAGE(PG8_SB(1, 0), b3, voffB); PG8_STAGE(PG8_SB(1, 1), b3 + hstep, voffB); PG8_STAGE(PG8_SA(1, 0), a3, voffA);
            PG8_WAIT_V(8); PG8_WAIT_L(0); PG8_BAR; PG8_MMA(1, 0, At, B0); PG8_MMA(1, 1, At, B1); PG8_BAR; PG8_SCHED;
            } else {
            PG8_LDB(B0, 0, 0); PG8_SCHED; PG8_LDA(At, 0, 0); PG8_STAGE(PG8_SA(1, 1), a1 + hstep, voffA);
            PG8_WAIT_L(8); PG8_BAR; PG8_WAIT_L(0); PG8_MMA(0, 0, At, B0); PG8_BAR; PG8_SCHED;
            PG8_LDB(B1, 0, 1); PG8_STAGE(PG8_SB(0, 0), b2, voffB);
            PG8_BAR; PG8_WAIT_L(0); PG8_MMA(0, 1, At, B1); PG8_BAR;
            PG8_LDA(At, 0, 1); PG8_STAGE(PG8_SA(0, 0), a2, voffA);
            PG8_BAR; PG8_WAIT_L(0); PG8_MMA(1, 0, At, B0); PG8_BAR; PG8_SCHED;
            PG8_STAGE(PG8_SB(0, 1), b2 + hstep, voffB);
            PG8_WAIT_V(6); PG8_BAR; PG8_MMA(1, 1, At, B1); PG8_BAR;
            PG8_LDB(B0, 1, 0); PG8_SCHED; PG8_LDA(At, 1, 0); PG8_STAGE(PG8_SA(0, 1), a2 + hstep, voffA);
            PG8_WAIT_L(8); PG8_BAR; PG8_WAIT_L(0); PG8_MMA(0, 0, At, B0); PG8_BAR; PG8_SCHED;
            PG8_LDB(B1, 1, 1); PG8_STAGE(PG8_SB(1, 0), b3, voffB);
            PG8_BAR; PG8_WAIT_L(0); PG8_MMA(0, 1, At, B1); PG8_BAR;
            PG8_LDA(At, 1, 1); PG8_STAGE(PG8_SA(1, 0), a3, voffA);
            PG8_BAR; PG8_WAIT_L(0); PG8_MMA(1, 0, At, B0); PG8_BAR; PG8_SCHED;
            PG8_STAGE(PG8_SB(1, 1), b3 + hstep, voffB);
            PG8_WAIT_V(6); PG8_BAR; PG8_MMA(1, 1, At, B1); PG8_BAR;
            }
        }
        const typename PreOf<Epi>::type epre = PreOf<Epi>::get(E, cur, wr, wc, fr, fq);
        if constexpr (ALIGN_EPI) { if (wr == 0) PG8_BAR; }
        bool do_epi = true;
        if constexpr (Sched::SPLITK) { if (cur.sp >= 0) {
            static_assert(ALIGN_EPI && !Epi::AFTER_DRAIN, "split-K needs aligned register epilogues");
            const __amdgpu_buffer_rsrc_t prs = __builtin_amdgcn_make_buffer_rsrc(S.part, 0, (int)(64u * Sched::NS * 262144u), 0x00020000);
            const unsigned poff = ((unsigned)(cur.ti * Sched::NS + cur.sp) * 65536u + (unsigned)tid * 4u) * 4u;
#pragma unroll
            for (int a = 0; a < 2; ++a)
#pragma unroll
                for (int b = 0; b < 2; ++b)
#pragma unroll
                    for (int m = 0; m < 4; ++m)
#pragma unroll
                        for (int n = 0; n < 2; ++n) __builtin_amdgcn_raw_buffer_store_b128(__builtin_bit_cast(u32x4, acc[a][b][m][n]), prs, poff + (unsigned)((((a * 2 + b) * 4 + m) * 2 + n) * 8192), 0,   16);
            PG8_WAIT_V(0); PG8_BAR;
            if (tid == 0) {
                const unsigned old = __hip_atomic_fetch_add(S.cnt + cur.ti, 1u, __ATOMIC_RELAXED, __HIP_MEMORY_SCOPE_AGENT);
                if (old == (unsigned)(Sched::NS - 1)) { __builtin_amdgcn_fence(__ATOMIC_ACQUIRE, "agent"); PG8_WAIT_V(0); }
                *S.flag = old; PG8_WAIT_L(0); }
            PG8_BAR;
            do_epi = (*S.flag == (unsigned)(Sched::NS - 1));
            if (do_epi) {
                const float* qq = S.part + (size_t)(cur.ti * Sched::NS) * 65536 + tid * 4;
#pragma unroll
                for (int a = 0; a < 2; ++a)
#pragma unroll
                    for (int b = 0; b < 2; ++b)
#pragma unroll
                        for (int m = 0; m < 4; ++m)
#pragma unroll
                            for (int n = 0; n < 2; ++n) { const float* q1 = qq + (((a * 2 + b) * 4 + m) * 2 + n) * 2048; f32x4 sum = *(const f32x4*)q1;
#pragma unroll
                                for (int s = 1; s < Sched::NS; ++s) sum += *(const f32x4*)(q1 + (size_t)s * 65536);
                                acc[a][b][m][n] = sum; }
            }
        } }
        if constexpr (!Epi::AFTER_DRAIN) { if (do_epi) PreOf<Epi>::call(E, acc, cur, wr, wc, fr, fq, epre); S.done(cur); }
        if (!has_next) break;
#pragma unroll
        for (int a = 0; a < 2; ++a)
#pragma unroll
            for (int b = 0; b < 2; ++b)
#pragma unroll
                for (int m = 0; m < 4; ++m)
#pragma unroll
                    for (int n = 0; n < 2; ++n) acc[a][b][m][n] = (f32x4){0.f, 0.f, 0.f, 0.f};
        cur = nxt; cA = nA; cB = nB; ++ui;
        if constexpr (ALIGN_EPI) { if (wr == 1) PG8_BAR; }
    }
    PG8_WAIT_V(0);
    if constexpr (!ALIGN_EPI) { if (wr == 0) PG8_BAR; }
    PG8_BAR;
    if constexpr (Epi::AFTER_DRAIN) { E.fused(acc, cur, wr, wc, fr, fq, lds, wid, lane); S.done(cur); }
#undef PG8_SA
#undef PG8_SB
#undef PG8_STAGE
#undef PG8_LDA
#undef PG8_LDB
#undef PG8_MMA
#undef PG8_WAIT_V
#undef PG8_WAIT_L
#undef PG8_BAR
#undef PG8_SCHED
}
}

#ifndef PG8_SP2
#define PG8_SP2 true
#endif
#define GAS __attribute__((address_space(1)))
#define LAS __attribute__((address_space(3)))
typedef unsigned v4u __attribute__((ext_vector_type(4)));
typedef float f32x4 __attribute__((ext_vector_type(4)));
typedef short bf16x8 __attribute__((ext_vector_type(8)));
typedef GAS unsigned gu32;
typedef GAS unsigned long long gu64;
#define RLX_AGENT __ATOMIC_RELAXED, __HIP_MEMORY_SCOPE_AGENT
#define LDS_WAIT() asm volatile("s_waitcnt lgkmcnt(0)" ::: "memory")
#define VM_WAIT() asm volatile("s_waitcnt vmcnt(0)" ::: "memory")
__device__ __forceinline__ unsigned long long rt() { return __builtin_amdgcn_s_memrealtime(); }
__device__ __forceinline__ unsigned pk2(float lo, float hi) { return (unsigned)f2bf(lo) | ((unsigned)f2bf(hi) << 16); }
#define XB_TMO      128
#define XB_XCNT(j)  (256  + 64 * (j))
#define XB_XSUB(j)  (1280 + 64 * (j))
#define XB_XGEN(j)  (2304 + 64 * (j))
#define XB_TOP      3328
#define XB_TOPGEN   3392
#define XCD_BAR_WORDS 3456
#define XB_SPIN_CAP (1u << 18)

__device__ __forceinline__ unsigned xb_ld(unsigned* p)              { return __hip_atomic_load(p, __ATOMIC_RELAXED, __HIP_MEMORY_SCOPE_AGENT); }
__device__ __forceinline__ unsigned xb_add(unsigned* p, unsigned v) { return __hip_atomic_fetch_add(p, v, __ATOMIC_RELAXED, __HIP_MEMORY_SCOPE_AGENT); }
__device__ __forceinline__ unsigned xb_xcc_id() { return (unsigned)__builtin_amdgcn_s_getreg((3 << 11) | 20) & 0xFu; }
#define XB_SPIN(cond, bar) do { unsigned _sp = 0; while (cond) { __builtin_amdgcn_s_sleep(1); \
    if ((++_sp & 255u) == 0u) { if (xb_ld(&(bar)[XB_TMO])) break; if (_sp > XB_SPIN_CAP) { atomicAdd(&(bar)[XB_TMO], 1u); break; } } } } while (0)

struct XcdBarrier {
    unsigned* bar; unsigned x;
    volatile LAS unsigned* st;
};

__device__ __forceinline__ XcdBarrier xcd_barrier_post(unsigned* bar, volatile LAS unsigned* st) {
    XcdBarrier b; b.bar = bar; b.x = xb_xcc_id(); b.st = st;
    if (threadIdx.x == 0) (void)xb_add(&bar[XB_XCNT(b.x)], 1u);
    return b;
}
__device__ __forceinline__ void xcd_barrier_complete(unsigned* bar, unsigned x, unsigned& nloc, unsigned& nx) {
    const unsigned G = gridDim.x * gridDim.y * gridDim.z;
    unsigned sum, cnt, mine, sp = 0u;
    for (;;) {
        sum = 0u; cnt = 0u; mine = 0u;
#pragma unroll
        for (unsigned j = 0; j < 16; ++j) { const unsigned c = xb_ld(&bar[XB_XCNT(j)]); sum += c; cnt += (c > 0u) ? 1u : 0u; mine = (j == x) ? c : mine; }
        if (sum == G) break;
        __builtin_amdgcn_s_sleep(1);
        if ((++sp & 255u) == 0u) { if (xb_ld(&bar[XB_TMO])) break; if (sp > XB_SPIN_CAP) { atomicAdd(&bar[XB_TMO], 1u); break; } }
    }
    nloc = mine > 0u ? mine : 1u; nx = cnt > 0u ? cnt : 1u;
}

__device__ __forceinline__ void xcd_barrier(const XcdBarrier& b) {
    asm volatile("s_waitcnt vmcnt(0)" ::: "memory");
    __syncthreads();
    if (threadIdx.x == 0) {
        unsigned* bar = b.bar;
        __builtin_amdgcn_s_waitcnt(0);
        unsigned nloc = b.st[0], nx = b.st[1];
        if (nloc == 0u) { xcd_barrier_complete(bar, b.x, nloc, nx); b.st[0] = nloc; b.st[1] = nx; }
        const unsigned old = xb_add(&bar[XB_XSUB(b.x)], 1u);
        const unsigned gen = old / nloc;
        if (old + 1u == (gen + 1u) * nloc) {
            __builtin_amdgcn_fence(__ATOMIC_RELEASE, "agent");
            asm volatile("s_waitcnt vmcnt(0)" ::: "memory");
            const unsigned og = xb_add(&bar[XB_TOP], 1u);
            const unsigned tg = og / nx;
            if (og + 1u == (tg + 1u) * nx) xb_add(&bar[XB_TOPGEN], 1u);
            else XB_SPIN(xb_ld(&bar[XB_TOPGEN]) == tg, bar);
            __builtin_amdgcn_fence(__ATOMIC_ACQUIRE, "agent");
            xb_add(&bar[XB_XGEN(b.x)], 1u);
            asm volatile("s_waitcnt vmcnt(0)" ::: "memory");
        } else {
            XB_SPIN(xb_ld(&bar[XB_XGEN(b.x)]) == gen, bar);
            __builtin_amdgcn_fence(__ATOMIC_ACQUIRE, "agent");
            asm volatile("s_waitcnt vmcnt(0)" ::: "memory");
        }
    }
    __syncthreads();
}
#ifdef HOST_TEST
#define LASQ
#define MFMA32(a, b, c) emu_mfma_32x32x16((a), (b), (c))
#define TR16(p) emu_ds_read_tr16_b64((const void*)(p))
#define RFL(x) (x)
#define EXP2(x) exp2f(x)
#define LOG2(x) log2f(x)
#define DEVFN inline
#define LAUNDER(x)
#define SETPRIO(x)
#define ROR16(x, n) emu_ror16((x), (n))
#define SCHEDBAR()
#define __any(x) emu_any(x)
namespace pg8 { struct Unit { int pm, pn; }; constexpr int BM = 256, HALF = 128; }
static inline unsigned cvtpk(float lo, float hi) { return (unsigned)f2bf(lo) | ((unsigned)f2bf(hi) << 16); }
#else
#define LASQ __attribute__((address_space(3)))
#define MFMA32(a, b, c) __builtin_amdgcn_mfma_f32_32x32x16_bf16((a), (b), (c), 0, 0, 0)
typedef short v4i16_t __attribute__((ext_vector_type(4)));
typedef short s16x4 __attribute__((ext_vector_type(4)));
typedef float f32x16 __attribute__((ext_vector_type(16)));
typedef unsigned u32x2 __attribute__((ext_vector_type(2)));
typedef unsigned u32x4 __attribute__((ext_vector_type(4)));
#define TR16(p) __builtin_bit_cast(s16x4, __builtin_amdgcn_ds_read_tr16_b64_v4i16((LASQ v4i16_t*)(p)))
#define RFL(x) __builtin_amdgcn_readfirstlane(x)
#define EXP2(x) __builtin_amdgcn_exp2f(x)
#define LOG2(x) __builtin_amdgcn_logf(x)
#define DEVFN __device__ __forceinline__
#define LAUNDER(x) asm volatile("" : "+v"(x))
#define SETPRIO(x) __builtin_amdgcn_s_setprio(x)
#define ROR16(x, n) __builtin_bit_cast(float, __builtin_amdgcn_update_dpp(0, __builtin_bit_cast(int, (float)(x)), 0x120 + (n), 0xf, 0xf, false))
#define SCHEDBAR() __builtin_amdgcn_sched_barrier(0)
typedef float f32x2_t __attribute__((ext_vector_type(2))); typedef __bf16 bf16x2_t __attribute__((ext_vector_type(2)));
__device__ __forceinline__ unsigned cvtpk(float lo, float hi) { f32x2_t v = {lo, hi}; bf16x2_t b = __builtin_convertvector(v, bf16x2_t); return __builtin_bit_cast(unsigned, b); }
#endif
typedef LASQ unsigned char* ldsp_t;
#ifdef HOST_TEST
#define RCP(x) (1.0f / (x))
#define RSQ(x) (1.0f / sqrtf(x))
#else
#define RCP(x) __builtin_amdgcn_rcpf(x)
#define RSQ(x) __builtin_amdgcn_rsqf(x)
#endif
DEVFN float silu_fast(float x) { return x * RCP(1.0f + EXP2(-x * LOG2E)); }

DEVFN bf16x8 pack8(const f32x16& p, int b) {
    u32x4 w; w.x = cvtpk(p[b], p[b + 1]); w.y = cvtpk(p[b + 2], p[b + 3]); w.z = cvtpk(p[b + 4], p[b + 5]); w.w = cvtpk(p[b + 6], p[b + 7]);
    return __builtin_bit_cast(bf16x8, w);
}
DEVFN bf16x8 cat44(s16x4 a, s16x4 b) { return (bf16x8){a[0], a[1], a[2], a[3], b[0], b[1], b[2], b[3]}; }
DEVFN void unpack4(u32x2 w, float* o) { unsigned u; u = w.x << 16; __builtin_memcpy(&o[0], &u, 4); u = w.x & 0xffff0000u; __builtin_memcpy(&o[1], &u, 4); u = w.y << 16; __builtin_memcpy(&o[2], &u, 4); u = w.y & 0xffff0000u; __builtin_memcpy(&o[3], &u, 4); }
DEVFN float wave_sum64(float v) { UNR for (int o = 1; o < 64; o <<= 1) v += __shfl_xor(v, o); return v; }
DEVFN float max16(const f32x16& p) { float a = fmaxf(fmaxf(p[0], p[1]), fmaxf(p[2], p[3])), b = fmaxf(fmaxf(p[4], p[5]), fmaxf(p[6], p[7])), c = fmaxf(fmaxf(p[8], p[9]), fmaxf(p[10], p[11])), d = fmaxf(fmaxf(p[12], p[13]), fmaxf(p[14], p[15])); return fmaxf(fmaxf(a, b), fmaxf(c, d)); }
DEVFN float sum16(const f32x16& p) { return ((p[0] + p[1]) + (p[2] + p[3])) + ((p[4] + p[5]) + (p[6] + p[7])) + (((p[8] + p[9]) + (p[10] + p[11])) + ((p[12] + p[13]) + (p[14] + p[15]))); }

constexpr int AT_KP = 144, AT_VP = 192, AT_SUB = 64 * AT_KP + 64 * AT_VP;
#ifndef AT_THR_V
#define AT_THR_V 3.0f
#endif
#ifndef AT_BIG_V
#define AT_BIG_V 4096.0f
#endif
#ifndef AT_FORCE_SLOW
#define AT_FORCE_SLOW false
#endif
constexpr float AT_BIG = AT_BIG_V, AT_TINY = 1e-20f;
constexpr float AT_THR = AT_THR_V;

template <int MODE> DEVFN int attn_tile_row(int ub, bool uctxq, int ug4, int j) {
    if (uctxq) return ML + ub * CTX + 64 * j;
    if (MODE == 0) return j < SEQ / 64 ? ub * SEQ + 64 * j : ML + ub * CTX + 64 * (j - SEQ / 64);
    const int kr0 = clampi(ug4 - 4, 0, ROWS - 8), kr1 = clampi(ug4 + 3 - 4, 0, ROWS - 8) + 8, nwin = kr1 - kr0;
    return j < nwin ? ub * SEQ + (kr0 + j) * GRID_W : ML + ub * CTX + 64 * (j - nwin);
}
struct AU { int b, h, q0, ntiles, g4; bool ctxq; };
template <int MODE, int TPI> DEVFN void attn_unit(const Params& p, int l, int ub, int uh, int uq0, int untiles, bool uctxq, int ug4, ldsp_t lds, float lam, float lam_init) {
    constexpr int NC = MODE == 0 ? 2 : 1, KS = MODE == 0 ? 2 : 4;
    constexpr int CQ = MODE == 0 ? C_QB : C_QA, CK = MODE == 0 ? C_KB : C_KA, CV = MODE == 0 ? C_VB : C_VA, MO = MODE == 0 ? MO_B : MO_A;
    constexpr int SLOT = TPI * AT_SUB;
    int tid = threadIdx.x; LAUNDER(tid); const int lane = tid & 63, wid = RFL(tid >> 6), r32 = lane & 31, hh = lane >> 5;
    const int qrow = uq0 + wid * 32 + r32;
    bf16x8 qf[NC][KS];
    { const bf16* qp = p.P + (size_t)qrow * PW + CQ + uh * 64 + 8 * hh;
      UNR for (int c = 0; c < NC; ++c) UNR for (int ks = 0; ks < KS; ++ks) qf[c][ks] = *(const bf16x8*)(qp + c * 32 + 16 * ks); }
    int na_r = 0, na_w = 0, na_r0 = 0, na_c0 = 0, na_kr0 = 0, na_nwin = 0;
    if (MODE == 1 && !uctxq) { na_r = ug4 + (wid >> 1); na_w = 32 * (wid & 1) + r32; na_r0 = clampi(na_r - 4, 0, ROWS - 8); na_c0 = clampi(na_w - 8, 0, GRID_W - 16);
        na_kr0 = clampi(ug4 - 4, 0, ROWS - 8); na_nwin = clampi(ug4 + 3 - 4, 0, ROWS - 8) + 8 - na_kr0; }
    LASQ float* rpbl = (LASQ float*)(lds + 2 * SLOT);
    if (MODE == 1) { for (int i = tid; i < 15 * 31; i += 512) rpbl[i] = p.rpb_a[((size_t)l * NAH + uh) * 465 + i] * LOG2E; }
    float m_run[NC], l_run[NC]; f32x16 o[NC][2];
    UNR for (int c = 0; c < NC; ++c) { m_run[c] = 0.f; l_run[c] = 0.f; UNR for (int t = 0; t < 2; ++t) UNR for (int i = 0; i < 16; ++i) o[c][t][i] = 0.f; }
    bool first = true;
    const int srow = tid >> 3, spc = tid & 7;
    u32x4 kreg[TPI], vreg[TPI];
    const int nit = (untiles + TPI - 1) / TPI;
    UNR for (int s = 0; s < TPI; ++s) { const int jt = s < untiles ? s : untiles - 1; const bf16* g = p.P + (size_t)(attn_tile_row<MODE>(ub, uctxq, ug4, jt) + srow) * PW + uh * 64 + 8 * spc; kreg[s] = *(const u32x4*)(g + CK); vreg[s] = *(const u32x4*)(g + CV); }
    UNR for (int s = 0; s < TPI; ++s) { *(LASQ u32x4*)(lds + s * AT_SUB + srow * AT_KP + 16 * spc) = kreg[s]; *(LASQ u32x4*)(lds + s * AT_SUB + 64 * AT_KP + srow * AT_VP + 16 * spc) = vreg[s]; }
    __syncthreads();
    int cur = 0;
    for (int it = 0; it < nit; ++it) {
        const bool more = it + 1 < nit;
        UNR for (int s = 0; s < TPI; ++s) {
            if (more && s == TPI - 1) { UNR for (int s2 = 0; s2 < TPI; ++s2) { int jt = (it + 1) * TPI + s2; jt = jt < untiles ? jt : untiles - 1;
                const bf16* g = p.P + (size_t)(attn_tile_row<MODE>(ub, uctxq, ug4, jt) + srow) * PW + uh * 64 + 8 * spc; kreg[s2] = *(const u32x4*)(g + CK); vreg[s2] = *(const u32x4*)(g + CV); } }
            const int j = it * TPI + s;
            const ldsp_t kb = lds + cur * SLOT + s * AT_SUB, vb = kb + 64 * AT_KP;
            bool active = j < untiles; int kr = 0;
            if (MODE == 1 && !uctxq && j < na_nwin) { kr = na_kr0 + j; active = kr >= na_r0 && kr < na_r0 + 8; }
            if (active) {
                bf16x8 pb[NC][4];
                UNR for (int c = 0; c < NC; ++c) {
                    f32x16 s0, s1; { const float nm = -m_run[c]; UNR for (int i = 0; i < 16; ++i) { s0[i] = nm; s1[i] = nm; } }
                    UNR for (int ks = 0; ks < KS; ++ks) {
                        const bf16x8 k0 = *(const LASQ bf16x8*)(kb + r32 * AT_KP + (c * 32 + 16 * ks + 8 * hh) * 2);
                        const bf16x8 k1 = *(const LASQ bf16x8*)(kb + (32 + r32) * AT_KP + (c * 32 + 16 * ks + 8 * hh) * 2);
                        s0 = MFMA32(k0, qf[c][ks], s0); s1 = MFMA32(k1, qf[c][ks], s1);
                    }
                    if (MODE == 1 && !uctxq && j < na_nwin) {
                        const LASQ float* rb = rpbl + (kr - na_r + 7) * 31 + 15 - na_w;
                        UNR for (int i = 0; i < 16; ++i) { const int kc = (i & 3) + 8 * (i >> 2) + 4 * hh;
                            s0[i] = (kc >= na_c0 && kc < na_c0 + 16) ? s0[i] + rb[kc] : -1e30f;
                            s1[i] = (kc + 32 >= na_c0 && kc + 32 < na_c0 + 16) ? s1[i] + rb[kc + 32] : -1e30f; }
                    }
                    float rm = fmaxf(max16(s0), max16(s1)); rm = fmaxf(rm, __shfl_xor(rm, 32));
                    if (first || __any(rm > AT_THR)) {
                        const float dl = first ? rm : fmaxf(rm, 0.f); const float al = EXP2(-dl);
                        m_run[c] += dl; l_run[c] *= al;
                        UNR for (int t = 0; t < 2; ++t) UNR for (int i = 0; i < 16; ++i) o[c][t][i] *= al;
                        UNR for (int i = 0; i < 16; ++i) { s0[i] -= dl; s1[i] -= dl; }
                    }
                    UNR for (int i = 0; i < 16; ++i) { s0[i] = EXP2(s0[i]); s1[i] = EXP2(s1[i]); }
                    l_run[c] += sum16(s0) + sum16(s1);
                    pb[c][0] = pack8(s0, 0); pb[c][1] = pack8(s0, 8); pb[c][2] = pack8(s1, 0); pb[c][3] = pack8(s1, 8);
                }
                { const int gi = lane & 15; const ldsp_t vp = vb + (4 * hh + (gi >> 2)) * AT_VP + (16 * ((lane >> 4) & 1) + 4 * (gi & 3)) * 2;
                  UNR for (int t = 0; t < 2; ++t) { bf16x8 vf[4];
                      UNR for (int g = 0; g < 4; ++g) vf[g] = cat44(TR16(vp + 16 * g * AT_VP + t * 64), TR16(vp + (16 * g + 8) * AT_VP + t * 64));
                      UNR for (int g = 0; g < 4; ++g) UNR for (int c = 0; c < NC; ++c) o[c][t] = MFMA32(vf[g], pb[c][g], o[c][t]); } }
                first = false;
            }
        }
        if (more) { const ldsp_t nk = lds + (cur ^ 1) * SLOT;
            UNR for (int s = 0; s < TPI; ++s) { *(LASQ u32x4*)(nk + s * AT_SUB + srow * AT_KP + 16 * spc) = kreg[s]; *(LASQ u32x4*)(nk + s * AT_SUB + 64 * AT_KP + srow * AT_VP + 16 * spc) = vreg[s]; } }
        __syncthreads();
        cur ^= 1;
    }
    float res[2][16];
    if (MODE == 0) {
        const float L0 = l_run[0] + __shfl_xor(l_run[0], 32), L1 = l_run[NC - 1] + __shfl_xor(l_run[NC - 1], 32);
        const float i0 = 1.0f / L0, i1 = lam / L1; float ss = 0.f;
        UNR for (int t = 0; t < 2; ++t) UNR for (int i = 0; i < 16; ++i) { res[t][i] = o[0][t][i] * i0 - o[NC - 1][t][i] * i1; ss += res[t][i] * res[t][i]; }
        ss += __shfl_xor(ss, 32);
        const float r = 1.0f / sqrtf(ss / 64 + EPS) * (1.0f - lam_init);
        UNR for (int t = 0; t < 2; ++t) UNR for (int i = 0; i < 16; ++i) res[t][i] *= r * p.subln_b[l * 64 + 32 * t + (i & 3) + 8 * (i >> 2) + 4 * hh];
    } else {
        const float L0 = l_run[0] + __shfl_xor(l_run[0], 32), i0 = 1.0f / L0;
        UNR for (int t = 0; t < 2; ++t) UNR for (int i = 0; i < 16; ++i) res[t][i] = o[0][t][i] * i0;
    }
    bf16* op = p.XN + (size_t)qrow * D + MO + uh * 64 + 4 * hh;
    UNR for (int t = 0; t < 2; ++t) UNR for (int g = 0; g < 4; ++g) { u32x2 w; w.x = cvtpk(res[t][4 * g], res[t][4 * g + 1]); w.y = cvtpk(res[t][4 * g + 2], res[t][4 * g + 3]); *(u32x2*)(op + 32 * t + 8 * g) = w; }
}

template <int MODE> struct AttnState {
    static constexpr int NC = MODE == 0 ? 2 : 1, KS = MODE == 0 ? 2 : 4;
    bf16x8 qf[NC][KS]; float m_run[NC], l_run[NC]; f32x16 o[NC][2]; bool slow;
    int na_r, na_w, na_r0, na_c0, na_kr0, na_nwin;
};
template <int MODE> DEVFN bool attn_active(const AttnState<MODE>& A, bool uctxq, int untiles, int t) {
    if (t >= untiles) return false;
    if (MODE == 1 && !uctxq && t < A.na_nwin) { const int kr = A.na_kr0 + t; return kr >= A.na_r0 && kr < A.na_r0 + 8; }
    return true;
}
template <int MODE, int ABL = 0> DEVFN void attn_kload(int c, ldsp_t kb, int r32, int hh, bf16x8 (&kf)[2 * AttnState<MODE>::KS]) {
    if (ABL & 64) { UNR for (int i = 0; i < 2 * AttnState<MODE>::KS; ++i) kf[i] = (bf16x8){(short)r32, 1, 2, 3, 4, 5, (short)c, (short)i}; return; }
    UNR for (int ks = 0; ks < AttnState<MODE>::KS; ++ks) {
        kf[2 * ks] = *(const LASQ bf16x8*)(kb + r32 * AT_KP + (c * 32 + 16 * ks + 8 * hh) * 2);
        kf[2 * ks + 1] = *(const LASQ bf16x8*)(kb + (32 + r32) * AT_KP + (c * 32 + 16 * ks + 8 * hh) * 2); }
}
template <int MODE, int ABL = 0> DEVFN void attn_qk(const AttnState<MODE>& A, int c, const bf16x8 (&kf)[2 * AttnState<MODE>::KS], f32x16& s0, f32x16& s1, bool slow) {
    const float nm = slow ? -A.m_run[c] : 0.f; UNR for (int i = 0; i < 16; ++i) { s0[i] = nm; s1[i] = nm; }
    UNR for (int ks = 0; ks < AttnState<MODE>::KS; ++ks) {
        if ((ABL & 4) || ((ABL & 128) && (threadIdx.x >= 256))) { s0[0] += __builtin_bit_cast(float, (int)kf[2 * ks][0]); s1[0] += __builtin_bit_cast(float, (int)kf[2 * ks + 1][0]); } else { s0 = MFMA32(kf[2 * ks], A.qf[c][ks], s0); s1 = MFMA32(kf[2 * ks + 1], A.qf[c][ks], s1); }
    }
}
template <int MODE, int ABL = 0> DEVFN void attn_softmax(AttnState<MODE>& A, int c, bool uctxq, int t, const LASQ float* rpbl, int hh, f32x16& s0, f32x16& s1, bf16x8 (&pb)[4], f32x16& n0, f32x16& n1, bool next_issued) {
    if (MODE == 1 && !uctxq && t < A.na_nwin) {
        const int kr = A.na_kr0 + t; const LASQ float* rb = rpbl + (kr - A.na_r + 7) * 31 + 15 - A.na_w;
        UNR for (int i = 0; i < 16; ++i) { const int kc = (i & 3) + 8 * (i >> 2) + 4 * hh;
            s0[i] = (kc >= A.na_c0 && kc < A.na_c0 + 16) ? s0[i] + rb[kc] : -1e30f;
            s1[i] = (kc + 32 >= A.na_c0 && kc + 32 < A.na_c0 + 16) ? s1[i] + rb[kc + 32] : -1e30f; }
    }
    if (A.slow) {
    float rm = fmaxf(max16(s0), max16(s1)); rm = fmaxf(rm, __shfl_xor(rm, 32));
    if (__any(rm > AT_THR)) {
        const float dl = fmaxf(rm, 0.f); const float al = EXP2(-dl);
        A.m_run[c] += dl; A.l_run[c] *= al;
        UNR for (int tt = 0; tt < 2; ++tt) UNR for (int i = 0; i < 16; ++i) A.o[c][tt][i] *= al;
        UNR for (int i = 0; i < 16; ++i) { s0[i] -= dl; s1[i] -= dl; }
        if (AttnState<MODE>::NC == 1 && next_issued) { UNR for (int i = 0; i < 16; ++i) { n0[i] -= dl; n1[i] -= dl; } }
    }
    }
    if (!(ABL & 1) && !((ABL & 128) && (threadIdx.x < 256))) { UNR for (int i = 0; i < 16; ++i) { s0[i] = EXP2(s0[i]); s1[i] = EXP2(s1[i]); } }
    const float ts = sum16(s0) + sum16(s1);
    A.l_run[c] += ts;
    if (!A.slow) { if (__any(ts > AT_BIG || !(A.l_run[c] > AT_TINY))) A.slow = true; }
    pb[0] = pack8(s0, 0); pb[1] = pack8(s0, 8); pb[2] = pack8(s1, 0); pb[3] = pack8(s1, 8);
}
template <int ABL = 0> DEVFN void attn_vload(ldsp_t vb, int lane, int hh, int tt, bf16x8 (&vf)[4]) {
    if (ABL & 32) { UNR for (int g = 0; g < 4; ++g) vf[g] = (bf16x8){(short)lane, 1, 2, 3, 4, 5, 6, (short)g}; return; }
    const int gi = lane & 15; const ldsp_t vp = vb + (4 * hh + (gi >> 2)) * AT_VP + (16 * ((lane >> 4) & 1) + 4 * (gi & 3)) * 2 + tt * 64;
    UNR for (int g = 0; g < 4; ++g) vf[g] = cat44(TR16(vp + 16 * g * AT_VP), TR16(vp + (16 * g + 8) * AT_VP));
}
template <int MODE, int ABL = 0> DEVFN void attn_pv(AttnState<MODE>& A, int c, int tt, const bf16x8 (&vf)[4], const bf16x8 (&pb)[4]) {
    UNR for (int g = 0; g < 4; ++g) { if ((ABL & 2) || ((ABL & 128) && (threadIdx.x >= 256))) A.o[c][tt][0] += (float)(vf[g][0] + pb[g][0]); else A.o[c][tt] = MFMA32(vf[g], pb[g], A.o[c][tt]); }
}

template <int MODE, int DEAD = 0> DEVFN float attn_fast_p(const AttnState<MODE>& A, bool uctxq, int t, const LASQ float* rpbl, int hh, const f32x16& s0, const f32x16& s1, bf16x8 (&pb)[4]) {
    const bool na_win = DEAD != 0 || (MODE == 1 && !uctxq && t < A.na_nwin);
    const LASQ float* rb = rpbl; if (na_win) rb = rpbl + (A.na_kr0 + t - A.na_r + 7) * 31 + 15 - A.na_w;
    float ts = 0.f;
    UNR for (int g = 0; g < 4; ++g) { float e[8];
        if ((DEAD == 1 && g == 3) || (DEAD == 2 && g == 0)) { pb[g] = (bf16x8){0, 0, 0, 0, 0, 0, 0, 0}; continue; }
        UNR for (int j = 0; j < 8; ++j) { const int i = 8 * (g & 1) + j; float x = g < 2 ? s0[i] : s1[i];
            if ((DEAD == 1 && g == 2 && j >= 4) || (DEAD == 2 && g == 1 && j < 4)) { e[j] = 0.f; continue; }
            if (na_win) { const int kc = (i & 3) + 8 * (i >> 2) + 4 * hh + (g < 2 ? 0 : 32); x = (kc >= A.na_c0 && kc < A.na_c0 + 16) ? x + rb[kc] : -1e30f; }
            e[j] = EXP2(x); }
        ts += ((e[0] + e[1]) + (e[2] + e[3])) + ((e[4] + e[5]) + (e[6] + e[7]));
        u32x4 w; w.x = cvtpk(e[0], e[1]); w.y = cvtpk(e[2], e[3]); w.z = cvtpk(e[4], e[5]); w.w = cvtpk(e[6], e[7]); pb[g] = __builtin_bit_cast(bf16x8, w); }
    return ts;
}
template <int DEAD = 0> DEVFN void attn_vload8(ldsp_t vb, int lane, int hh, bf16x8 (&vf)[2][4]) {
    const int gi = lane & 15; const ldsp_t vp = vb + (4 * hh + (gi >> 2)) * AT_VP + (16 * ((lane >> 4) & 1) + 4 * (gi & 3)) * 2;
    UNR for (int g = 0; g < 4; ++g) { if ((DEAD == 1 && g == 3) || (DEAD == 2 && g == 0)) continue; vf[0][g] = cat44(TR16(vp + 16 * g * AT_VP), TR16(vp + (16 * g + 8) * AT_VP)); vf[1][g] = cat44(TR16(vp + 16 * g * AT_VP + 64), TR16(vp + (16 * g + 8) * AT_VP + 64)); }
}
template <int MODE, bool DO_QK, int ABL = 0, int DEAD = 0> DEVFN void attn_fast_stepA(AttnState<MODE>& A, int c, int cn, bool uctxq, int t, const LASQ float* rpbl, int lane, int r32, int hh,
                                                           ldsp_t vb, ldsp_t kbn, const f32x16& s0, const f32x16& s1, f32x16& n0, f32x16& n1, bf16x8 (&vf)[2][4]) {
    constexpr int KS = AttnState<MODE>::KS;
    bf16x8 kf[2 * KS]; bf16x8 pb[4];
    attn_vload8<DEAD>(vb, lane, hh, vf);
    if (DO_QK) attn_kload<MODE, ABL>(cn, kbn, r32, hh, kf);
    const float ts = attn_fast_p<MODE, DEAD>(A, uctxq, t, rpbl, hh, s0, s1, pb);
    UNR for (int g = 0; g < 4; ++g) { if ((DEAD == 1 && g == 3) || (DEAD == 2 && g == 0)) continue; A.o[c][0] = MFMA32(vf[0][g], pb[g], A.o[c][0]); A.o[c][1] = MFMA32(vf[1][g], pb[g], A.o[c][1]); }
    if (DO_QK) { UNR for (int i = 0; i < 16; ++i) { n0[i] = 0.f; n1[i] = 0.f; }
        UNR for (int ks = 0; ks < KS; ++ks) { n0 = MFMA32(kf[2 * ks], A.qf[cn][ks], n0); n1 = MFMA32(kf[2 * ks + 1], A.qf[cn][ks], n1); } }
    A.l_run[c] += ts;
    if (__any(ts > AT_BIG || !(A.l_run[c] > AT_TINY))) A.slow = true;
}
template <int MODE, bool DO_QK, int ABL = 0> DEVFN void attn_fast_stepB(AttnState<MODE>& A, int c, int cn, int r32, int hh, ldsp_t kbn, const f32x16& s0, const f32x16& s1, f32x16& n0, f32x16& n1, const bf16x8 (&vf)[2][4]) {
    constexpr int KS = AttnState<MODE>::KS;
    bf16x8 kf[2 * KS];
    if (DO_QK) attn_kload<MODE, ABL>(cn, kbn, r32, hh, kf);
    float ts = 0.f;
    UNR for (int g = 0; g < 4; ++g) { float e[8];
        UNR for (int j = 0; j < 8; ++j) { const int i = 8 * (g & 1) + j; e[j] = EXP2(g < 2 ? s0[i] : s1[i]); }
        ts += ((e[0] + e[1]) + (e[2] + e[3])) + ((e[4] + e[5]) + (e[6] + e[7]));
        u32x4 w; w.x = cvtpk(e[0], e[1]); w.y = cvtpk(e[2], e[3]); w.z = cvtpk(e[4], e[5]); w.w = cvtpk(e[6], e[7]); const bf16x8 pbg = __builtin_bit_cast(bf16x8, w);
        A.o[c][0] = MFMA32(vf[0][g], pbg, A.o[c][0]); A.o[c][1] = MFMA32(vf[1][g], pbg, A.o[c][1]); }
    if (DO_QK) { UNR for (int i = 0; i < 16; ++i) { n0[i] = 0.f; n1[i] = 0.f; }
        UNR for (int ks = 0; ks < KS; ++ks) { n0 = MFMA32(kf[2 * ks], A.qf[cn][ks], n0); n1 = MFMA32(kf[2 * ks + 1], A.qf[cn][ks], n1); } }
    A.l_run[c] += ts;
    if (__any(ts > AT_BIG || !(A.l_run[c] > AT_TINY))) A.slow = true;
}

template <int MODE, int ABL = 0> DEVFN void attn_unit2(const Params& p, int l, int ub, int uh, int uq0, int untiles, bool uctxq, int ug4, ldsp_t lds, float lam, float lam_init) {
    constexpr int NC = AttnState<MODE>::NC, KS = AttnState<MODE>::KS;
    constexpr int CQ = MODE == 0 ? C_QB : C_QA, CK = MODE == 0 ? C_KB : C_KA, CV = MODE == 0 ? C_VB : C_VA, MO = MODE == 0 ? MO_B : MO_A;
    int tid = threadIdx.x; LAUNDER(tid); const int lane = tid & 63, wid = RFL(tid >> 6), r32 = lane & 31, hh = lane >> 5;
    const bool late = (wid & 1) != 0;
    const int qrow = uq0 + wid * 32 + r32;
    AttnState<MODE> A;
    { const bf16* qp = p.P + (size_t)qrow * PW + CQ + uh * 64 + 8 * hh;
      UNR for (int c = 0; c < NC; ++c) UNR for (int ks = 0; ks < KS; ++ks) A.qf[c][ks] = *(const bf16x8*)(qp + c * 32 + 16 * ks); }
    A.na_r = A.na_w = A.na_r0 = A.na_c0 = A.na_kr0 = A.na_nwin = 0;
    if (MODE == 1 && !uctxq) { A.na_r = ug4 + (wid >> 1); A.na_w = 32 * (wid & 1) + r32; A.na_r0 = clampi(A.na_r - 4, 0, ROWS - 8); A.na_c0 = clampi(A.na_w - 8, 0, GRID_W - 16);
        A.na_kr0 = clampi(ug4 - 4, 0, ROWS - 8); A.na_nwin = clampi(ug4 + 3 - 4, 0, ROWS - 8) + 8 - A.na_kr0; }
    LASQ float* rpbl = (LASQ float*)(lds + 4 * AT_SUB);
    if (MODE == 1) { for (int i = tid; i < 15 * 31; i += 512) rpbl[i] = p.rpb_a[((size_t)l * NAH + uh) * 465 + i] * LOG2E; }
    UNR for (int c = 0; c < NC; ++c) { A.m_run[c] = 0.f; A.l_run[c] = 0.f; UNR for (int t = 0; t < 2; ++t) UNR for (int i = 0; i < 16; ++i) A.o[c][t][i] = 0.f; }
    A.slow = AT_FORCE_SLOW;
    const int srow = tid >> 3, spc = tid & 7;
    u32x4 kregA, vregA;
#define kregB kregA
#define vregB vregA
#define AT_GLOAD(t, KR, VR) do { const int jt_ = (t) < untiles ? (t) : untiles - 1; const bf16* g_ = p.P + (size_t)(attn_tile_row<MODE>(ub, uctxq, ug4, jt_) + srow) * PW + uh * 64 + 8 * spc; KR = *(const u32x4*)(g_ + CK); VR = *(const u32x4*)(g_ + CV); } while (0)
#define AT_LWRITE(t, KR, VR) do { const ldsp_t d_ = lds + ((t) & 3) * AT_SUB; *(LASQ u32x4*)(d_ + srow * AT_KP + 16 * spc) = KR; *(LASQ u32x4*)(d_ + 64 * AT_KP + srow * AT_VP + 16 * spc) = VR; } while (0)
    { u32x4 k0_, v0_, k1_, v1_; AT_GLOAD(0, k0_, v0_); AT_GLOAD(1, k1_, v1_); AT_GLOAD(2, kregA, vregA); AT_LWRITE(0, k0_, v0_); AT_LWRITE(1, k1_, v1_); }
    __syncthreads();
    f32x16 x0, x1, y0, y1;
    bf16x8 kf[2 * KS];
    if (attn_active<MODE>(A, uctxq, untiles, 0)) { attn_kload<MODE>(0, lds, r32, hh, kf); attn_qk<MODE, ABL>(A, 0, kf, x0, x1, A.slow); }
#define AT_TILE_START(t) do { if (!(ABL & 8)) { AT_LWRITE((t) + 2, kregA, vregA); AT_GLOAD((t) + 3, kregA, vregA); } if (!late && !(ABL & 16)) __syncthreads(); } while (0)
#define AT_VB(t) (lds + ((t) & 3) * AT_SUB + 64 * AT_KP)
#define AT_KB(t) (lds + ((t) & 3) * AT_SUB)
    int t = 0; bf16x8 vfT[2][4];
    if (!ABL) {
        if (MODE == 0) {
            for (; t + 1 < untiles && !A.slow; ++t) {
                AT_TILE_START(t);
                attn_fast_stepA<MODE, true, ABL>(A, 0, NC - 1, uctxq, t, rpbl, lane, r32, hh, AT_VB(t), AT_KB(t), x0, x1, y0, y1, vfT);
                if (late) __syncthreads();
                attn_fast_stepB<MODE, true, ABL>(A, NC - 1, 0, r32, hh, AT_KB(t + 1), y0, y1, x0, x1, vfT);
            }
            if (!A.slow && t + 1 == untiles) {
                AT_TILE_START(t);
                attn_fast_stepA<MODE, true, ABL>(A, 0, NC - 1, uctxq, t, rpbl, lane, r32, hh, AT_VB(t), AT_KB(t), x0, x1, y0, y1, vfT);
                if (late) __syncthreads();
                attn_fast_stepB<MODE, false, ABL>(A, NC - 1, 0, r32, hh, AT_KB(t), y0, y1, x0, x1, vfT);
                ++t;
            }
        } else {
#define AT_NA_STEP(tt, sc0, sc1, sn0, sn1) do { AT_TILE_START(tt); const bool act_ = attn_active<MODE>(A, uctxq, untiles, (tt)), nact_ = attn_active<MODE>(A, uctxq, untiles, (tt) + 1); \
                if (act_) { const int dd_ = (!uctxq && (tt) < A.na_nwin) ? 1 + (wid & 1) : 0; \
                    if (nact_) { if (dd_ == 0) attn_fast_stepA<MODE, true, 0, 0>(A, 0, 0, uctxq, (tt), rpbl, lane, r32, hh, AT_VB(tt), AT_KB((tt) + 1), sc0, sc1, sn0, sn1, vfT); \
                                 else if (dd_ == 1) attn_fast_stepA<MODE, true, 0, 1>(A, 0, 0, uctxq, (tt), rpbl, lane, r32, hh, AT_VB(tt), AT_KB((tt) + 1), sc0, sc1, sn0, sn1, vfT); \
                                 else attn_fast_stepA<MODE, true, 0, 2>(A, 0, 0, uctxq, (tt), rpbl, lane, r32, hh, AT_VB(tt), AT_KB((tt) + 1), sc0, sc1, sn0, sn1, vfT); } \
                    else { if (dd_ == 0) attn_fast_stepA<MODE, false, 0, 0>(A, 0, 0, uctxq, (tt), rpbl, lane, r32, hh, AT_VB(tt), AT_KB(tt), sc0, sc1, sn0, sn1, vfT); \
                           else if (dd_ == 1) attn_fast_stepA<MODE, false, 0, 1>(A, 0, 0, uctxq, (tt), rpbl, lane, r32, hh, AT_VB(tt), AT_KB(tt), sc0, sc1, sn0, sn1, vfT); \
                           else attn_fast_stepA<MODE, false, 0, 2>(A, 0, 0, uctxq, (tt), rpbl, lane, r32, hh, AT_VB(tt), AT_KB(tt), sc0, sc1, sn0, sn1, vfT); } } \
                else if (nact_) { attn_kload<MODE>(0, AT_KB((tt) + 1), r32, hh, kf); attn_qk<MODE, 0>(A, 0, kf, sn0, sn1, false); } \
                if (late) __syncthreads(); } while (0)
            for (; t + 1 < untiles && !A.slow; t += 2) { AT_NA_STEP(t, x0, x1, y0, y1); AT_NA_STEP(t + 1, y0, y1, x0, x1); }
            if (!A.slow && t + 1 == untiles) { AT_NA_STEP(t, x0, x1, y0, y1); ++t; }
#undef AT_NA_STEP
        }
    }
#define AT_STEP(t, c, sc0, sc1, sn0, sn1) do { \
        const int t_ = (t); const int tn_ = (c) + 1 < NC ? t_ : t_ + 1; const int cn_ = (c) + 1 < NC ? (c) + 1 : 0; \
        if ((c) == 0) AT_TILE_START(t_); \
        const bool nact_ = attn_active<MODE>(A, uctxq, untiles, tn_); \
        const bool act_ = attn_active<MODE>(A, uctxq, untiles, t_); \
        if (nact_) { attn_kload<MODE, ABL>(cn_, AT_KB(tn_), r32, hh, kf); attn_qk<MODE, ABL>(A, cn_, kf, sn0, sn1, true); } \
        bf16x8 pb_[4]; bf16x8 vfa_[4], vfb_[4]; \
        if (act_) attn_vload<ABL>(AT_VB(t_), lane, hh, 0, vfa_); \
        if (act_) attn_softmax<MODE, ABL>(A, (c), uctxq, t_, rpbl, hh, sc0, sc1, pb_, sn0, sn1, nact_); \
        if ((c) == 0 && late && !(ABL & 16)) __syncthreads(); \
        if (act_) { attn_vload<ABL>(AT_VB(t_), lane, hh, 1, vfb_); attn_pv<MODE, ABL>(A, (c), 0, vfa_, pb_); attn_pv<MODE, ABL>(A, (c), 1, vfb_, pb_); } \
    } while (0)
    if (t < untiles) {
        A.slow = true;
        if (NC == 2) { for (; t < untiles; ++t) { AT_STEP(t, 0, x0, x1, y0, y1); AT_STEP(t, 1, y0, y1, x0, x1); } }
        else { if (t & 1) { AT_STEP(t, 0, y0, y1, x0, x1); ++t; }
               for (; t < untiles; t += 2) { AT_STEP(t, 0, x0, x1, y0, y1); if (t + 1 < untiles) AT_STEP(t + 1, 0, y0, y1, x0, x1); } }
    }
#undef AT_TILE_START
#undef AT_VB
#undef AT_KB
#undef AT_STEP
#undef AT_GLOAD
#undef AT_LWRITE
    __syncthreads();
    float res[2][16];
    if (MODE == 0) {
        const float L0 = A.l_run[0] + __shfl_xor(A.l_run[0], 32), L1 = A.l_run[NC - 1] + __shfl_xor(A.l_run[NC - 1], 32);
        const float i0 = 1.0f / L0, i1 = lam / L1; float ss = 0.f;
        UNR for (int t = 0; t < 2; ++t) UNR for (int i = 0; i < 16; ++i) { res[t][i] = A.o[0][t][i] * i0 - A.o[NC - 1][t][i] * i1; ss += res[t][i] * res[t][i]; }
        ss += __shfl_xor(ss, 32);
        const float r = 1.0f / sqrtf(ss / 64 + EPS) * (1.0f - lam_init);
        UNR for (int t = 0; t < 2; ++t) UNR for (int i = 0; i < 16; ++i) res[t][i] *= r * p.subln_b[l * 64 + 32 * t + (i & 3) + 8 * (i >> 2) + 4 * hh];
    } else {
        const float L0 = A.l_run[0] + __shfl_xor(A.l_run[0], 32), i0 = 1.0f / L0;
        UNR for (int t = 0; t < 2; ++t) UNR for (int i = 0; i < 16; ++i) res[t][i] = A.o[0][t][i] * i0;
    }
    bf16* op = p.XN + (size_t)qrow * D + MO + uh * 64 + 4 * hh;
    UNR for (int t = 0; t < 2; ++t) UNR for (int g = 0; g < 4; ++g) { u32x2 w; w.x = cvtpk(res[t][4 * g], res[t][4 * g + 1]); w.y = cvtpk(res[t][4 * g + 2], res[t][4 * g + 3]);
        if (ABL) { if (w.x == 0x12345678u && w.y == 0x9abcdef0u) *(u32x2*)(op + 32 * t + 8 * g) = w; } else *(u32x2*)(op + 32 * t + 8 * g) = w; }
}

template <int ABL = 0> DEVFN void ph_diff_fast(const Params& p, int l, bool with_ctx, ldsp_t lds, int bid, int nblk) {
    const float lam_init = lam_init_of(l), lam = lam_of(p, l, lam_init);
    const int nlat = BATCH * DAH * (SEQ / 256), nctx = with_ctx ? BATCH * DAH * (CTX / 256) : 0;
    for (int i0 = bid; i0 < nlat + nctx; i0 += nblk) {
        AU u; u.g4 = 0; int i = i0;
        if (i0 < nlat && nblk % 8 == 0 && nlat % nblk == 0) {
            const int rnd = i0 / nblk, b_ = i0 % nblk, per = nblk / 8; i = rnd * nblk + (b_ % 8) * per + b_ / 8; }
        if (i < nlat) { const int qb = i % (SEQ / 256), bh = i / (SEQ / 256); u.b = bh / DAH; u.h = bh % DAH; u.q0 = u.b * SEQ + 256 * qb; u.ntiles = SEQ / 64 + CTX / 64; u.ctxq = false; }
        else { const int k = i - nlat; const int qb = k % (CTX / 256), bh = k / (CTX / 256); u.b = bh / DAH; u.h = bh % DAH; u.q0 = ML + u.b * CTX + 256 * qb; u.ntiles = CTX / 64; u.ctxq = true; }
        attn_unit2<0, ABL>(p, l, u.b, u.h, u.q0, u.ntiles, u.ctxq, u.g4, lds, lam, lam_init);
    }
}
DEVFN void ph_na_fast(const Params& p, int l, bool with_ctx, ldsp_t lds, int bid, int nblk) {
    const int nlat = BATCH * NAH * (ROWS / 4), nctx = with_ctx ? BATCH * NAH * (CTX / 256) : 0;
    for (int i = bid; i < nlat + nctx; i += nblk) {
        AU u;
        if (i < nlat) { const int g = i % (ROWS / 4), bh = i / (ROWS / 4); u.b = bh / NAH; u.h = bh % NAH; u.g4 = 4 * g; u.q0 = u.b * SEQ + 256 * g; u.ctxq = false;
            const int kr0 = clampi(u.g4 - 4, 0, ROWS - 8), kr1 = clampi(u.g4 + 3 - 4, 0, ROWS - 8) + 8; u.ntiles = (kr1 - kr0) + CTX / 64; }
        else { const int k = i - nlat; const int qb = k % (CTX / 256), bh = k / (CTX / 256); u.b = bh / NAH; u.h = bh % NAH; u.g4 = 0; u.q0 = ML + u.b * CTX + 256 * qb; u.ntiles = CTX / 64; u.ctxq = true; }
        attn_unit2<1>(p, l, u.b, u.h, u.q0, u.ntiles, u.ctxq, u.g4, lds, 0.f, 0.f);
    }
}

constexpr int NCC = CTX / 64, NLC = SEQ / 64, NCH = NCC + NLC;
constexpr int GL_VP = 320, GL_KP = 144, GL_TP = 192;
constexpr int GL_G = 0, GL_W = 32768, GL_T = GL_W + 8704, GL_V = GL_T + 2048, GL_OP = GL_V + 64 * GL_VP, GL_RED = GL_OP + 6 * 64 * GL_KP, GL_LDS = GL_RED + 1024;
static_assert(GL_LDS <= 131072 && 2 * 64 * GL_TP <= 6 * 64 * GL_KP, "GLA LDS map");
DEVFN int gla_chunk_row(int b, int c) { return c < NCC ? ML + b * CTX + 64 * c : b * SEQ + 64 * (c - NCC); }
DEVFN int gla_scan_chunk(int dir, int step) { return dir == 0 ? step : (step < NCC ? NCC - 1 - step : NCC + (NLC - 1 - (step - NCC))); }

struct GlaRegs { u32x4 af, v0, v1, k, q; };
struct GlaW { bf16x8 hi, lo; float bias; };
DEVFN void gla_unit_decode(int unit, int ncu, int c_lo, int& b, int& h, int& c) { h = unit % GLH; const int r = unit / GLH; c = c_lo + r % ncu; b = r / ncu; }
DEVFN void gla_load(const Params& p, GlaRegs& R, int h, int m0, int tid, bool want_q) {
    { const int lane = tid & 63, wid = tid >> 6, dir = wid >> 2, st = (wid >> 1) & 1; R.af = *(const u32x4*)(p.AFB + (size_t)(m0 + 32 * st + (lane & 31)) * 32 + dir * 16 + 8 * (lane >> 5)); }
    { const int row = tid >> 4, pc = tid & 15; R.v0 = *(const u32x4*)(p.P + (size_t)(m0 + row) * PW + C_VC + h * 128 + 8 * pc); R.v1 = *(const u32x4*)(p.P + (size_t)(m0 + 32 + row) * PW + C_VC + h * 128 + 8 * pc); }
    { const int row = tid >> 3, d8 = (tid & 7) * 8; const bf16* pr = p.P + (size_t)(m0 + row) * PW + h * 64 + d8; R.k = *(const u32x4*)(pr + C_KC); if (want_q) R.q = *(const u32x4*)(pr + C_QC); }
}
DEVFN void unpack8(const u32x4& w, float* o) { unsigned u; u = w.x << 16; __builtin_memcpy(&o[0], &u, 4); u = w.x & 0xffff0000u; __builtin_memcpy(&o[1], &u, 4); u = w.y << 16; __builtin_memcpy(&o[2], &u, 4); u = w.y & 0xffff0000u; __builtin_memcpy(&o[3], &u, 4);
    u = w.z << 16; __builtin_memcpy(&o[4], &u, 4); u = w.z & 0xffff0000u; __builtin_memcpy(&o[5], &u, 4); u = w.w << 16; __builtin_memcpy(&o[6], &u, 4); u = w.w & 0xffff0000u; __builtin_memcpy(&o[7], &u, 4); }
DEVFN void gla_load_w(const Params& p, int l, int h, GlaW& W, int tid) {
    const int lane = tid & 63, wid = tid >> 6, dir = wid >> 2, dt = wid & 1, d = h * 64 + 32 * dt + (lane & 31), hh = lane >> 5;
    const float* w2 = (dir ? p.w_a2_b : p.w_a2_f) + (size_t)l * 16 * GK_W + d; float hi[8], lo[8];
    UNR for (int j = 0; j < 8; ++j) { const float w = w2[(size_t)(8 * hh + j) * GK_W]; hi[j] = bf2f(f2bf(w)); lo[j] = w - hi[j]; }
    u32x4 a, b2; a.x = cvtpk(hi[0], hi[1]); a.y = cvtpk(hi[2], hi[3]); a.z = cvtpk(hi[4], hi[5]); a.w = cvtpk(hi[6], hi[7]); b2.x = cvtpk(lo[0], lo[1]); b2.y = cvtpk(lo[2], lo[3]); b2.z = cvtpk(lo[4], lo[5]); b2.w = cvtpk(lo[6], lo[7]);
    W.hi = __builtin_bit_cast(bf16x8, a); W.lo = __builtin_bit_cast(bf16x8, b2); W.bias = (dir ? p.b_a_b : p.b_a_f)[(size_t)l * GK_W + d];
}
DEVFN void gla_prep(const GlaRegs& R, const GlaW& W, ldsp_t lds, int tid) {
    LASQ float* G = (LASQ float*)(lds + GL_G); LASQ float* T = (LASQ float*)(lds + GL_T);
    { const int row = tid >> 4, pc = tid & 15; *(LASQ u32x4*)(lds + GL_V + row * GL_VP + 16 * pc) = R.v0; *(LASQ u32x4*)(lds + GL_V + (32 + row) * GL_VP + 16 * pc) = R.v1; }
    { const int lane = tid & 63, wid = tid >> 6, dir = wid >> 2, st = (wid >> 1) & 1, dt = wid & 1, hh = lane >> 5;
      f32x16 x; UNR for (int i = 0; i < 16; ++i) x[i] = W.bias;
      const bf16x8 a = __builtin_bit_cast(bf16x8, R.af);
      x = MFMA32(a, W.hi, x); x = MFMA32(a, W.lo, x);
      float g[16], pf[16], gt[4], pt[4], off[4];
      UNR for (int i = 0; i < 16; ++i) g[i] = (fminf(x[i], 0.f) - 0.6931471805599453f * LOG2(1.0f + EXP2(-fabsf(x[i]) * LOG2E))) * (1.0f / 16.0f);
      UNR for (int j = 0; j < 4; ++j) {
          if (dir == 0) { pf[4 * j] = g[4 * j]; pf[4 * j + 1] = pf[4 * j] + g[4 * j + 1]; pf[4 * j + 2] = pf[4 * j + 1] + g[4 * j + 2]; pf[4 * j + 3] = pf[4 * j + 2] + g[4 * j + 3]; gt[j] = pf[4 * j + 3]; }
          else { pf[4 * j + 3] = g[4 * j + 3]; pf[4 * j + 2] = pf[4 * j + 3] + g[4 * j + 2]; pf[4 * j + 1] = pf[4 * j + 2] + g[4 * j + 1]; pf[4 * j] = pf[4 * j + 1] + g[4 * j]; gt[j] = pf[4 * j]; } }
      UNR for (int j = 0; j < 4; ++j) pt[j] = __shfl_xor(gt[j], 32);
      float run = 0.f;
      if (dir == 0) { UNR for (int j = 0; j < 4; ++j) { off[j] = run + (hh ? pt[j] : 0.f); run += gt[j] + pt[j]; } }
      else { UNR for (int j = 3; j >= 0; --j) { off[j] = run + (hh ? 0.f : pt[j]); run += gt[j] + pt[j]; } }
      UNR for (int i = 0; i < 16; ++i) { const int s = 32 * st + (i & 3) + 8 * (i >> 2) + 4 * hh; G[(dir * 64 + s) * 64 + 32 * dt + (lane & 31)] = pf[i] + off[i >> 2]; }
      if (hh == 0) T[(dir * 2 + st) * 64 + 32 * dt + (lane & 31)] = run; }
    __syncthreads();
}
DEVFN void gla_off8(ldsp_t lds, int dir, int row, int d8, float* o) {
    const LASQ float* T = (const LASQ float*)(lds + GL_T); const bool need = dir == 0 ? row >= 32 : row < 32;
    UNR for (int e = 0; e < 8; ++e) o[e] = need ? T[(dir * 2 + dir) * 64 + d8 + e] : 0.f;
}

DEVFN void ph_gla_A(const Params& p, int l, ldsp_t lds, int bid, int nblk) {
    int tid = threadIdx.x; LAUNDER(tid); const int lane = tid & 63, wid = RFL(tid >> 6), r32 = lane & 31, hh = lane >> 5, gi = lane & 15;
    const LASQ float* G = (const LASQ float*)(lds + GL_G);
    const int nunits = BATCH * GLH * NCH; int cur_h = -1;
    GlaRegs R; GlaW GW; int b, h, c;
    if (bid < nunits) { gla_unit_decode(bid, NCH, 0, b, h, c); gla_load(p, R, h, gla_chunk_row(b, c), tid, false); }
    for (int unit = bid; unit < nunits; unit += nblk) {
        gla_unit_decode(unit, NCH, 0, b, h, c); const int bh = b * GLH + h;
        if (h != cur_h) { gla_load_w(p, l, h, GW, tid); cur_h = h; }
        gla_prep(R, GW, lds, tid);
        { const int row = tid >> 3, d8 = (tid & 7) * 8; float k8[8]; unpack8(R.k, k8);
          UNR for (int dir = 0; dir < 2; ++dir) { const LASQ float* bl = G + (dir * 64 + (dir ? 0 : 63)) * 64 + d8; const LASQ float* bs = G + (dir * 64 + row) * 64 + d8; float o8[8], ol[8], os[8];
              gla_off8(lds, dir, dir ? 0 : 63, d8, ol); gla_off8(lds, dir, row, d8, os);
              UNR for (int e = 0; e < 8; ++e) o8[e] = k8[e] * EXP2(((bl[e] + ol[e]) - (bs[e] + os[e])) * LOG2E);
              u32x4 w; w.x = cvtpk(o8[0], o8[1]); w.y = cvtpk(o8[2], o8[3]); w.z = cvtpk(o8[4], o8[5]); w.w = cvtpk(o8[6], o8[7]);
              *(LASQ u32x4*)(lds + GL_OP + dir * 64 * GL_TP + row * GL_TP + d8 * 2) = w; } }
        if (tid < 128) { const int dir = tid >> 6, d = tid & 63; const LASQ float* T_ = (const LASQ float*)(lds + GL_T);
            p.AD[((size_t)(bh * 2 + dir) * NCH + c) * 64 + d] = EXP2((G[(dir * 64 + (dir ? 0 : 63)) * 64 + d] + T_[(dir * 2 + dir) * 64 + d]) * LOG2E); }
        if (unit + nblk < nunits) { int b2, h2, c2; gla_unit_decode(unit + nblk, NCH, 0, b2, h2, c2); gla_load(p, R, h2, gla_chunk_row(b2, c2), tid, false); }
        __syncthreads();
        const int vt = wid >> 1, dt = wid & 1;
        UNR for (int dir = 0; dir < 2; ++dir) {
            f32x16 u; UNR for (int i = 0; i < 16; ++i) u[i] = 0.f;
            const ldsp_t vp = lds + GL_V + (8 * hh + (gi >> 2)) * GL_VP + (32 * vt + 16 * ((lane >> 4) & 1) + 4 * (gi & 3)) * 2;
            const ldsp_t kp = lds + GL_OP + dir * 64 * GL_TP + (8 * hh + (gi >> 2)) * GL_TP + (32 * dt + 16 * ((lane >> 4) & 1) + 4 * (gi & 3)) * 2;
            UNR for (int ks = 0; ks < 4; ++ks) { const bf16x8 va = cat44(TR16(vp + 16 * ks * GL_VP), TR16(vp + (16 * ks + 4) * GL_VP)); const bf16x8 kb = cat44(TR16(kp + 16 * ks * GL_TP), TR16(kp + (16 * ks + 4) * GL_TP));
                u = MFMA32(va, kb, u); }
            bf16* ub = (bf16*)(p.US + ((size_t)(bh * 2 + dir) * NCH + c) * 8192) + 32 * dt + r32;
            UNR for (int i = 0; i < 16; ++i) ub[(size_t)(32 * vt + (i & 3) + 8 * (i >> 2) + 4 * hh) * 64] = f2bf(u[i]);
        }
        __syncthreads();
    }
}

DEVFN void ph_gla_B(const Params& p, int bid, int nblk) {
    int tid = threadIdx.x; LAUNDER(tid);
    constexpr int PD = (NCH % 17 == 0) ? 17 : 4;
    static_assert(NCH % PD == 0, "scan pipelining");
    for (int unit = bid; unit < BATCH * GLH * 2 * 4; unit += nblk) {
        const int vq = unit & 3, dir = (unit >> 2) & 1, bh = unit >> 3;
        f32x4 S = {0.f, 0.f, 0.f, 0.f};
        u32x2 Un[PD]; f32x4 an[PD];
#define UBASE(step) ((size_t)(bh * 2 + dir) * NCH + gla_scan_chunk(dir, (step)))
        UNR for (int k = 0; k < PD; ++k) { const size_t blk = UBASE(k); Un[k] = *(const u32x2*)((const bf16*)(p.US + blk * 8192) + vq * 2048 + 4 * tid); an[k] = *(const f32x4*)(p.AD + blk * 64 + 4 * (tid & 15)); }
        for (int step = 0; step < NCH; step += PD) {
            UNR for (int k = 0; k < PD; ++k) {
                const size_t blk = UBASE(step + k); float U[4]; unpack4(Un[k], U); const f32x4 a = an[k];
                if (step + k + PD < NCH) { const size_t nb = UBASE(step + k + PD); Un[k] = *(const u32x2*)((const bf16*)(p.US + nb * 8192) + vq * 2048 + 4 * tid); an[k] = *(const f32x4*)(p.AD + nb * 64 + 4 * (tid & 15)); }
                u32x2 w; w.x = cvtpk(S[0], S[1]); w.y = cvtpk(S[2], S[3]);
                *(u32x2*)((bf16*)(p.US + blk * 8192) + 8192 + vq * 2048 + 4 * tid) = w;
                UNR for (int e = 0; e < 4; ++e) S[e] = a[e] * S[e] + U[e];
            }
        }
#undef UBASE
    }
}

DEVFN void ph_gla_C(const Params& p, int l, bool with_ctx, ldsp_t lds, int bid, int nblk) {
    int tid = threadIdx.x; LAUNDER(tid); const int lane = tid & 63, wid = RFL(tid >> 6), r32 = lane & 31, hh = lane >> 5, gi = lane & 15;
    const LASQ float* G = (const LASQ float*)(lds + GL_G); LASQ float* RED = (LASQ float*)(lds + GL_RED);
    const int c_lo = with_ctx ? 0 : NCC, ncu = NCH - c_lo; const int nunits = BATCH * GLH * ncu; int cur_h = -1;
    GlaRegs R; GlaW GW; int b, h, c;
    float onw[16]; { const int vt_ = wid >> 1; UNR for (int i = 0; i < 16; ++i) onw[i] = p.onorm_c[l * 128 + 32 * vt_ + 8 * (i >> 2) + 4 * hh + (i & 3)]; }
    if (bid < nunits) { gla_unit_decode(bid, ncu, c_lo, b, h, c); gla_load(p, R, h, gla_chunk_row(b, c), tid, true); }
    for (int unit = bid; unit < nunits; unit += nblk) {
        gla_unit_decode(unit, ncu, c_lo, b, h, c); const int bh = b * GLH + h; const int m0 = gla_chunk_row(b, c);
        if (h != cur_h) { gla_load_w(p, l, h, GW, tid); cur_h = h; }
        bf16x8 sfr[2][4]; u32x2 gcw[4];
        { const int vt_ = wid >> 1, tt_ = wid & 1;
          UNR for (int dir = 0; dir < 2; ++dir) { const bf16* sb = (const bf16*)(p.US + ((size_t)(bh * 2 + dir) * NCH + c) * 8192) + 8192 + vt_ * 2048 + r32 * 64 + 8 * hh;
              UNR for (int ks = 0; ks < 4; ++ks) sfr[dir][ks] = *(const bf16x8*)(sb + 16 * ks); }
          const bf16* gp_ = p.P + (size_t)(m0 + 32 * tt_ + r32) * PW + C_GC + h * 128 + 32 * vt_ + 4 * hh;
          UNR for (int g = 0; g < 4; ++g) gcw[g] = *(const u32x2*)(gp_ + 8 * g); }
        gla_prep(R, GW, lds, tid);
        { const int row = tid >> 3, d8 = (tid & 7) * 8; float q8[8], k8[8]; unpack8(R.q, q8); unpack8(R.k, k8);
          UNR for (int dir = 0; dir < 2; ++dir) { const LASQ float* rf = G + (dir * 64 + (dir ? 32 : 31)) * 64 + d8; const LASQ float* bsr = G + (dir * 64 + row) * 64 + d8; float t8[8], bs[8]; u32x4 w;
              gla_off8(lds, dir, row, d8, bs); UNR for (int e = 0; e < 8; ++e) bs[e] += bsr[e];
              const ldsp_t ob = lds + GL_OP + dir * 3 * 64 * GL_KP + row * GL_KP + d8 * 2;
              UNR for (int e = 0; e < 8; ++e) t8[e] = q8[e] * EXP2((bs[e] - rf[e]) * LOG2E);
              w.x = cvtpk(t8[0], t8[1]); w.y = cvtpk(t8[2], t8[3]); w.z = cvtpk(t8[4], t8[5]); w.w = cvtpk(t8[6], t8[7]); *(LASQ u32x4*)(ob) = w;
              UNR for (int e = 0; e < 8; ++e) t8[e] = q8[e] * EXP2(bs[e] * LOG2E);
              w.x = cvtpk(t8[0], t8[1]); w.y = cvtpk(t8[2], t8[3]); w.z = cvtpk(t8[4], t8[5]); w.w = cvtpk(t8[6], t8[7]); *(LASQ u32x4*)(ob + 64 * GL_KP) = w;
              UNR for (int e = 0; e < 8; ++e) t8[e] = k8[e] * EXP2((rf[e] - bs[e]) * LOG2E);
              w.x = cvtpk(t8[0], t8[1]); w.y = cvtpk(t8[2], t8[3]); w.z = cvtpk(t8[4], t8[5]); w.w = cvtpk(t8[6], t8[7]); *(LASQ u32x4*)(ob + 2 * 64 * GL_KP) = w; } }
        if (unit + nblk < nunits) { int b2, h2, c2; gla_unit_decode(unit + nblk, ncu, c_lo, b2, h2, c2); gla_load(p, R, h2, gla_chunk_row(b2, c2), tid, true); }
        __syncthreads();
        const int tt = wid & 1, vt = wid >> 1; const int t_in = 32 * tt + r32;
        f32x16 o; UNR for (int i = 0; i < 16; ++i) o[i] = 0.f;
        UNR for (int dir = 0; dir < 2; ++dir) {
            const ldsp_t QT = lds + GL_OP + dir * 3 * 64 * GL_KP, QS = QT + 64 * GL_KP, KT = QT + 2 * 64 * GL_KP;
            f32x16 a0, a1; UNR for (int i = 0; i < 16; ++i) { a0[i] = 0.f; a1[i] = 0.f; }
            UNR for (int ks = 0; ks < 4; ++ks) { const int co = (16 * ks + 8 * hh) * 2;
                const bf16x8 k0 = *(const LASQ bf16x8*)(KT + r32 * GL_KP + co), k1 = *(const LASQ bf16x8*)(KT + (32 + r32) * GL_KP + co), qf = *(const LASQ bf16x8*)(QT + t_in * GL_KP + co);
                a0 = MFMA32(k0, qf, a0); a1 = MFMA32(k1, qf, a1); }
            UNR for (int i = 0; i < 16; ++i) { const int s = (i & 3) + 8 * (i >> 2) + 4 * hh;
                a0[i] = (dir == 0 ? s <= t_in : s >= t_in) ? a0[i] : 0.f; a1[i] = (dir == 0 ? s + 32 <= t_in : s + 32 >= t_in) ? a1[i] : 0.f; }
            const ldsp_t vp = lds + GL_V + (4 * hh + (gi >> 2)) * GL_VP + (32 * vt + 16 * ((lane >> 4) & 1) + 4 * (gi & 3)) * 2;
            UNR for (int g = 0; g < 4; ++g) { const bf16x8 vf = cat44(TR16(vp + 16 * g * GL_VP), TR16(vp + (16 * g + 8) * GL_VP));
                const bf16x8 pb = g == 0 ? pack8(a0, 0) : g == 1 ? pack8(a0, 8) : g == 2 ? pack8(a1, 0) : pack8(a1, 8); o = MFMA32(vf, pb, o); }
            UNR for (int ks = 0; ks < 4; ++ks) { const bf16x8 sf = sfr[dir][ks], qsf = *(const LASQ bf16x8*)(QS + t_in * GL_KP + (16 * ks + 8 * hh) * 2); o = MFMA32(sf, qsf, o); }
        }
        float ss = 0.f; UNR for (int i = 0; i < 16; ++i) ss += o[i] * o[i];
        ss += __shfl_xor(ss, 32);
        if (hh == 0) RED[wid * 32 + r32] = ss;
        __syncthreads();
        ss = RED[tt * 32 + r32] + RED[(tt + 2) * 32 + r32] + RED[(tt + 4) * 32 + r32] + RED[(tt + 6) * 32 + r32];
        const float rs = 1.0f / sqrtf(ss / 128 + EPS);
        const int m = m0 + t_in; const bf16* gp = p.P + (size_t)m * PW + C_GC + h * 128 + 32 * vt + 4 * hh; bf16* op = p.XN + (size_t)m * D + MO_C + h * 128 + 32 * vt + 4 * hh;
        UNR for (int g = 0; g < 4; ++g) { const u32x2 gw = gcw[g]; float gv[4]; unsigned uu;
            uu = gw.x << 16; __builtin_memcpy(&gv[0], &uu, 4); uu = gw.x & 0xffff0000u; __builtin_memcpy(&gv[1], &uu, 4); uu = gw.y << 16; __builtin_memcpy(&gv[2], &uu, 4); uu = gw.y & 0xffff0000u; __builtin_memcpy(&gv[3], &uu, 4);
            float r4[4]; UNR for (int e = 0; e < 4; ++e) r4[e] = o[4 * g + e] * rs * onw[4 * g + e] * silu_fast(gv[e]);
            u32x2 w; w.x = cvtpk(r4[0], r4[1]); w.y = cvtpk(r4[2], r4[3]); *(u32x2*)(op + 8 * g) = w; }
        __syncthreads();
    }
}


DEVFN void ph_norm_fast(const Params& p, int l, int which, bool from_input, int mrows, int gw, int NGW, int lane) {
    static_assert(D % 256 == 0, "norm layout"); constexpr int NJ = D / 256;
    const float* g = (which ? p.norm2 : p.norm1) + (size_t)l * D;
    const int R = (mrows + NGW - 1) / NGW, m_lo = gw * R, m_hi = m_lo + R < mrows ? m_lo + R : mrows;
    f32x4 gg[NJ], s1[NJ], s0[NJ], v[NJ], vn[NJ]; int cur_slot = -1;
    UNR for (int j = 0; j < NJ; ++j) gg[j] = *(const f32x4*)(g + 256 * j + 4 * lane);
    if (m_lo < m_hi) { const float* h = from_input ? xrow(p, m_lo) : hrow(p, m_lo); UNR for (int j = 0; j < NJ; ++j) v[j] = *(const f32x4*)(h + 256 * j + 4 * lane); }
    for (int m = m_lo; m < m_hi; ++m) {
        if (m + 1 < m_hi) { const float* hn = from_input ? xrow(p, m + 1) : hrow(p, m + 1); UNR for (int j = 0; j < NJ; ++j) vn[j] = *(const f32x4*)(hn + 256 * j + 4 * lane); }
        const int slot = m < ML ? m / SEQ : BATCH;
        if (slot != cur_slot) { cur_slot = slot; const float* sh = mod_vec(p, l, m, which ? 3 : 0); const float* sc = mod_vec(p, l, m, which ? 4 : 1);
            UNR for (int j = 0; j < NJ; ++j) { s1[j] = *(const f32x4*)(sc + 256 * j + 4 * lane); s0[j] = *(const f32x4*)(sh + 256 * j + 4 * lane); } }
        float ss = 0.f;
        UNR for (int j = 0; j < NJ; ++j) ss += (v[j][0] * v[j][0] + v[j][1] * v[j][1]) + (v[j][2] * v[j][2] + v[j][3] * v[j][3]);
        const float rstd = 1.0f / sqrtf(wave_sum64(ss) / D + EPS);
        bf16* o = p.XN + (size_t)m * D;
        UNR for (int j = 0; j < NJ; ++j) { const int k = 256 * j + 4 * lane;
            float r[4]; UNR for (int e = 0; e < 4; ++e) r[e] = (v[j][e] * rstd * gg[j][e]) * (1.0f + s1[j][e]) + s0[j][e];
            u32x2 w; w.x = cvtpk(r[0], r[1]); w.y = cvtpk(r[2], r[3]); *(u32x2*)(o + k) = w; }
        UNR for (int j = 0; j < NJ; ++j) v[j] = vn[j];
    }
}

DEVFN void ph_post_fast(const Params& p, int l, int gw, int NGW, int lane) {
    if constexpr (NA_W == 256 && DQK_W == 256 && GK_W == 256) {
    const int c4 = 4 * lane;
    for (int m = gw; m < M; m += NGW) {
        bf16* pr = p.P + (size_t)m * PW;
        float x[4];
        UNR for (int seg = 0; seg < 2; ++seg) {
            bf16* v = pr + (seg ? C_KA : C_QA) + c4; unpack4(*(const u32x2*)v, x);
            float ss = (x[0] * x[0] + x[1] * x[1]) + (x[2] * x[2] + x[3] * x[3]);
            ss += __shfl_xor(ss, 1); ss += __shfl_xor(ss, 2); ss += __shfl_xor(ss, 4); ss += __shfl_xor(ss, 8);
            const float r = 1.0f / sqrtf(ss / 64 + EPS) * (seg ? 1.0f : 0.125f * LOG2E); const float* g = (seg ? p.kn_a : p.qn_a) + l * 64 + (c4 & 63);
            u32x2 w; w.x = cvtpk(x[0] * r * g[0], x[1] * r * g[1]); w.y = cvtpk(x[2] * r * g[2], x[3] * r * g[3]); *(u32x2*)v = w;
        }
        UNR for (int seg = 0; seg < 2; ++seg) {
            bf16* v = pr + (seg ? C_KB : C_QB) + c4; unpack4(*(const u32x2*)v, x);
            float ss = (x[0] * x[0] + x[1] * x[1]) + (x[2] * x[2] + x[3] * x[3]);
            ss += __shfl_xor(ss, 1); ss += __shfl_xor(ss, 2); ss += __shfl_xor(ss, 4);
            const float r = 1.0f / sqrtf(ss / 32 + EPS); const float* g = (seg ? p.kn_b : p.qn_b) + l * 32 + (c4 & 31);
            UNR for (int e = 0; e < 4; ++e) x[e] = x[e] * r * g[e];
            float px[4]; UNR for (int e = 0; e < 4; ++e) px[e] = __shfl_xor(x[e], 2);
            if (m < ML) { const int t = m % SEQ, pos = (lane & 4) ? t % GRID_W : t / GRID_W; const bool isx2 = (lane >> 1) & 1; const float* rt = p.ROPE + (pos * 8 + 4 * (lane & 1)) * 2;
                UNR for (int e = 0; e < 4; ++e) { const float cs = rt[2 * e], sn = rt[2 * e + 1]; x[e] = isx2 ? x[e] * cs + px[e] * sn : x[e] * cs - px[e] * sn; } }
            const float s = seg ? 1.0f : 0.17677669529663687f * LOG2E;
            u32x2 w; w.x = cvtpk(x[0] * s, x[1] * s); w.y = cvtpk(x[2] * s, x[3] * s); *(u32x2*)v = w;
        }
        { bf16* v = pr + C_QC + c4; unpack4(*(const u32x2*)v, x); u32x2 w; w.x = cvtpk(x[0] * 0.125f, x[1] * 0.125f); w.y = cvtpk(x[2] * 0.125f, x[3] * 0.125f); *(u32x2*)v = w; }
    }
    }
}

DEVFN void ph_mod_fast(const Params& p, ldsp_t lds, int bid, int nblk) {
    int tid = threadIdx.x; LAUNDER(tid); const int lane = tid & 63, wid = RFL(tid >> 6);
    constexpr int NR = BATCH + 1, KW = D / 8, NU = DEPTH * (6 * D / 64);
    LASQ float* SL = (LASQ float*)lds; LASQ float* RED = SL + NR * D;
    if (bid < NU) { for (int i = tid; i < NR * D; i += 512) { const int j = i / D, k = i % D; SL[i] = silu_f(j < BATCH ? p.c[(size_t)j * D + k] : p.c_ctx[k]); } }
    __syncthreads();
    for (int unit = bid; unit < NU; unit += nblk) {
        const int l = unit / (6 * D / 64), n0 = 64 * (unit % (6 * D / 64));
        const float* w = p.w_ada + ((size_t)l * D + KW * wid) * 6 * D + n0 + lane;
        float acc[NR]; UNR for (int j = 0; j < NR; ++j) acc[j] = 0.f;
        for (int k = 0; k < KW; k += 4) { float wv[4]; UNR for (int e = 0; e < 4; ++e) wv[e] = w[(size_t)(k + e) * 6 * D];
            UNR for (int e = 0; e < 4; ++e) UNR for (int j = 0; j < NR; ++j) acc[j] += SL[j * D + KW * wid + k + e] * wv[e]; }
        UNR for (int j = 0; j < NR; ++j) RED[(wid * NR + j) * 64 + lane] = acc[j];
        __syncthreads();
        for (int i = tid; i < NR * 64; i += 512) { const int j = i / 64, ln = i % 64; float s = p.b_ada[(size_t)l * 6 * D + n0 + ln]; UNR for (int ww = 0; ww < 8; ++ww) s += RED[(ww * NR + j) * 64 + ln];
            p.MOD[((size_t)l * NR + j) * 6 * D + n0 + ln] = s; }
        __syncthreads();
    }
}
DEVFN void ph_rope_table(const Params& p, long gtid, long gsize) {
    for (long i = gtid; i < 64 * 8; i += gsize) { const int pos = (int)(i / 8), f = (int)(i % 8); const float inv = expf(-((float)f / 8.0f) * logf(10000.0f)); const float ang = (float)pos * inv;
        p.ROPE[2 * i] = cosf(ang); p.ROPE[2 * i + 1] = sinf(ang); }
}

#ifdef HOST_TEST
#define ATOMIC_ADDF(p, v) (*(p) += (v))
#else
#define ATOMIC_ADDF(p, v) atomicAdd((p), (v))
#endif
namespace pg8 {
struct EpiGU {
    static constexpr bool PERM = true, AFTER_DRAIN = false;
    bf16* ACT; bf16* EA; bf16* EU; const float* cw; const float* cb;
    const float* SS; const float* b2;
    struct Pre { f32x4 w0[2], w1[2], w2[2], bb[2], ba[2], bu[2]; float ssv[2][4]; };
    DEVFN Pre pre(const Unit& u, int wr, int wc, int fr, int fq) const {
        Pre P; const int f0 = 128 * u.pn + 32 * wc + 8 * fq; const int slot = u.pm * BM < ML ? (u.pm * BM) / SEQ : BATCH;
        const float* bp = b2 + (size_t)slot * 2 * FFN + 256 * u.pn + 32 * wc + 8 * fq;
        UNR for (int q = 0; q < 2; ++q) { P.w0[q] = *(const f32x4*)(cw + f0 + 4 * q); P.w1[q] = *(const f32x4*)(cw + FFN + f0 + 4 * q); P.w2[q] = *(const f32x4*)(cw + 2 * FFN + f0 + 4 * q);
            P.bb[q] = *(const f32x4*)(cb + f0 + 4 * q); P.ba[q] = *(const f32x4*)(bp + 4 * q); P.bu[q] = *(const f32x4*)(bp + 128 + 4 * q); }
        UNR for (int ai = 0; ai < 2; ++ai) UNR for (int m = 0; m < 4; ++m) P.ssv[ai][m] = SS[u.pm * BM + ai * HALF + wr * 64 + 16 * m + fr];
        return P;
    }
    DEVFN void operator()(const f32x4 (&acc)[2][2][4][2], const Unit& u, int wr, int wc, int fr, int fq, const Pre& P) const {
        const int f0 = 128 * u.pn + 32 * wc + 8 * fq; const int lane = fq * 16 + fr;
        const int src_prev = (lane & ~15) | ((fr + 15) & 15), src_next = (lane & ~15) | ((fr + 1) & 15);
        float w0[8], w1[8], w2[8], bb[8], ba[8], bu[8];
        UNR for (int e = 0; e < 8; ++e) { w0[e] = P.w0[e >> 2][e & 3]; w1[e] = P.w1[e >> 2][e & 3]; w2[e] = P.w2[e >> 2][e & 3]; bb[e] = P.bb[e >> 2][e & 3]; ba[e] = P.ba[e >> 2][e & 3]; bu[e] = P.bu[e >> 2][e & 3]; }
        UNR for (int ai = 0; ai < 2; ++ai) {
            const int rowb = u.pm * BM + ai * HALF + wr * 64;
            float rs[4]; UNR for (int m = 0; m < 4; ++m) rs[m] = RSQ(P.ssv[ai][m] * (1.0f / D) + EPS);
#define GU_A(m_, n_, e_) (rs[m_] * acc[ai][0][m_][n_][e_] + ba[4 * (n_) + (e_)])
#define GU_U(m_, n_, e_) (rs[m_] * acc[ai][1][m_][n_][e_] + bu[4 * (n_) + (e_)])
            UNR for (int m = 0; m < 4; ++m) {
                const int row = rowb + 16 * m + fr; float act[8], av[8], uv[8];
                UNR for (int n = 0; n < 2; ++n) UNR for (int e = 0; e < 4; ++e) {
                    const float cur = GU_A(m, n, e);
                    const float sp = (fr == 15 && m > 0) ? GU_A(m > 0 ? m - 1 : 0, n, e) : cur;
                    const float sn = (fr == 0 && m < 3) ? GU_A(m < 3 ? m + 1 : 3, n, e) : cur;
                    const float prev = ROR16(sp, 1), next = ROR16(sn, 15);
                    const float a = bb[4 * n + e] + w0[4 * n + e] * prev + w1[4 * n + e] * cur + w2[4 * n + e] * next;
                    av[4 * n + e] = cur; uv[4 * n + e] = GU_U(m, n, e);
                    act[4 * n + e] = silu_fast(a) * uv[4 * n + e];
                }
                const bool e0 = (m == 0 && fr == 0), e63 = (m == 3 && fr == 15), e1 = (m == 0 && fr == 1), e62 = (m == 3 && fr == 14);
                { u32x4 w; w.x = cvtpk(act[0], act[1]); w.y = cvtpk(act[2], act[3]); w.z = cvtpk(act[4], act[5]); w.w = cvtpk(act[6], act[7]); *(u32x4*)(ACT + (size_t)row * FFN + f0) = w; }
                if (e0 || e1 || e62 || e63) { u32x4 w; w.x = cvtpk(av[0], av[1]); w.y = cvtpk(av[2], av[3]); w.z = cvtpk(av[4], av[5]); w.w = cvtpk(av[6], av[7]);
                    *(u32x4*)(EA + ((size_t)(rowb / 64) * 4 + (e0 ? 0 : e1 ? 1 : e62 ? 2 : 3)) * FFN + f0) = w; }
                if (e0 || e63) { u32x4 w; w.x = cvtpk(uv[0], uv[1]); w.y = cvtpk(uv[2], uv[3]); w.z = cvtpk(uv[4], uv[5]); w.w = cvtpk(uv[6], uv[7]);
                    *(u32x4*)(EU + ((size_t)(rowb / 64) * 2 + (e0 ? 0 : 1)) * FFN + f0) = w; }
            }
#undef GU_A
#undef GU_U
        }
    }
};
template <bool OUT_BF16, bool BASE_BF16, bool FUSE> struct EpiResidT {
    static constexpr bool PERM = true, AFTER_DRAIN = false;
    const float* base_lat; const float* base_ctx; float* out_lat; float* out_ctx; const float* gate;
    bf16* XNo; const float* nw; const float* scb; float* SS;
    const bf16* baseb; bf16* outb;
    struct Pre { f32x4 gv[2][2], gm[2][2]; };
    DEVFN Pre pre(const Unit& u, int wr, int wc, int fr, int fq) const {
        Pre P; const int slot = u.pm * BM < ML ? (u.pm * BM) / SEQ : BATCH; const float* g = gate + (size_t)slot * 6 * D; const int col0 = u.pn * BM + wc * 32 + 8 * fq;
        UNR for (int bj = 0; bj < 2; ++bj) UNR for (int n = 0; n < 2; ++n) { const int c = col0 + bj * HALF + 4 * n; P.gv[bj][n] = *(const f32x4*)(g + c);
            if (FUSE) { const float* sc = scb + (size_t)slot * 6 * D; const f32x4 w = *(const f32x4*)(nw + c), s1 = *(const f32x4*)(sc + c); P.gm[bj][n] = w * (1.0f + s1); } else P.gm[bj][n] = P.gv[bj][n]; }
        return P;
    }
    DEVFN void operator()(const f32x4 (&acc)[2][2][4][2], const Unit& u, int wr, int wc, int fr, int fq, const Pre& P) const {
        const bool lat = u.pm * BM < ML;
        const int lrow0 = (lat ? u.pm * BM : u.pm * BM - ML) + wr * 64 + fr, grow0 = u.pm * BM + wr * 64 + fr;
        const float* bs = lat ? base_lat : base_ctx; float* os = lat ? out_lat : out_ctx;
        const int col0 = u.pn * BM + wc * 32 + 8 * fq;
        f32x4 gv[2][2], gm[2][2];
        UNR for (int bj = 0; bj < 2; ++bj) UNR for (int n = 0; n < 2; ++n) { gv[bj][n] = P.gv[bj][n]; gm[bj][n] = P.gm[bj][n]; }
        UNR for (int ai = 0; ai < 2; ++ai) UNR for (int m = 0; m < 4; ++m) {
            const size_t off = (size_t)(lrow0 + ai * HALF + m * 16) * D + col0, goff = (size_t)(grow0 + ai * HALF + m * 16) * D + col0; float ss = 0.f;
            UNR for (int bj = 0; bj < 2; ++bj) { const int cc = bj * HALF;
                f32x4 b0, b1;
                if (BASE_BF16) { float t8[8]; const u32x4 bw = *(const u32x4*)(baseb + goff + cc); unpack8(bw, t8); b0 = (f32x4){t8[0], t8[1], t8[2], t8[3]}; b1 = (f32x4){t8[4], t8[5], t8[6], t8[7]}; }
                else { b0 = *(const f32x4*)(bs + off + cc); b1 = *(const f32x4*)(bs + off + cc + 4); }
                const f32x4 o0 = b0 + gv[bj][0] * acc[ai][bj][m][0], o1 = b1 + gv[bj][1] * acc[ai][bj][m][1];
                if (OUT_BF16) { u32x4 w1; w1.x = cvtpk(o0[0], o0[1]); w1.y = cvtpk(o0[2], o0[3]); w1.z = cvtpk(o1[0], o1[1]); w1.w = cvtpk(o1[2], o1[3]); *(u32x4*)(outb + goff + cc) = w1; }
                else { *(f32x4*)(os + off + cc) = o0; *(f32x4*)(os + off + cc + 4) = o1; }
                if (FUSE) { ss += ((o0[0] * o0[0] + o0[1] * o0[1]) + (o0[2] * o0[2] + o0[3] * o0[3])) + ((o1[0] * o1[0] + o1[1] * o1[1]) + (o1[2] * o1[2] + o1[3] * o1[3]));
                    const f32x4 x0 = o0 * gm[bj][0], x1 = o1 * gm[bj][1]; u32x4 w2; w2.x = cvtpk(x0[0], x0[1]); w2.y = cvtpk(x0[2], x0[3]); w2.z = cvtpk(x1[0], x1[1]); w2.w = cvtpk(x1[2], x1[3]); *(u32x4*)(XNo + goff + cc) = w2; } }
            if (FUSE) { ss += __shfl_xor(ss, 16); ss += __shfl_xor(ss, 32); if (fq == 0) ATOMIC_ADDF(SS + grow0 + ai * HALF + m * 16, ss); }
        }
    }
};
typedef EpiResidT<false, false, true> EpiResidN;
struct EpiInprojN {
    static constexpr bool PERM = true, AFTER_DRAIN = false;
    bf16* P; bf16* AFB; const float* SS; const float* b2; int ldb;
    DEVFN void operator()(const f32x4 (&acc)[2][2][4][2], const Unit& u, int wr, int wc, int fr, int fq) const {
        const int row0 = u.pm * BM + wr * 64 + fr; const int col0 = u.pn * BM + wc * 32 + 8 * fq;
        const int slot = u.pm * BM < ML ? (u.pm * BM) / SEQ : BATCH;
        f32x4 bv[2][2]; UNR for (int bj = 0; bj < 2; ++bj) UNR for (int n = 0; n < 2; ++n) bv[bj][n] = *(const f32x4*)(b2 + (size_t)slot * ldb + col0 + bj * HALF + 4 * n);
        UNR for (int ai = 0; ai < 2; ++ai) UNR for (int m = 0; m < 4; ++m) { const size_t row = (size_t)(row0 + ai * HALF + m * 16); const float rs = 1.0f / sqrtf(SS[row] * (1.0f / D) + EPS);
            UNR for (int bj = 0; bj < 2; ++bj) { const f32x4 v0 = acc[ai][bj][m][0] * rs + bv[bj][0], v1 = acc[ai][bj][m][1] * rs + bv[bj][1]; const int col = col0 + bj * HALF;
                u32x4 w; w.x = cvtpk(v0[0], v0[1]); w.y = cvtpk(v0[2], v0[3]); w.z = cvtpk(v1[0], v1[1]); w.w = cvtpk(v1[2], v1[3]);
                if (col < PW) *(u32x4*)(P + row * PW + col) = w;
                else if (col < PW + 32) *(u32x4*)(AFB + row * 32 + (col - PW)) = w; } }
    }
};
}
namespace pg8 {
template <bool NORMIN> struct EpiInprojPost {
    static constexpr bool PERM = true, AFTER_DRAIN = false;
    bf16* P; bf16* AFB; const float* SS; const float* b2; int ldb;
    const float* qn_a; const float* kn_a; const float* qn_b; const float* kn_b; const float* rope;
    struct Pre { f32x4 bias[2][2]; float ssv[2][4]; };
    DEVFN Pre pre(const Unit& u, int wr, int wc, int fr, int fq) const {
        Pre PR; const int slot = u.pm * BM < ML ? (u.pm * BM) / SEQ : BATCH; const int vcol0 = wc * 32 + 8 * fq;
        UNR for (int bj = 0; bj < 2; ++bj) UNR for (int q = 0; q < 2; ++q) PR.bias[bj][q] = NORMIN ? *(const f32x4*)(b2 + (size_t)slot * ldb + u.pn * BM + bj * HALF + vcol0 + 4 * q) : (f32x4){0.f, 0.f, 0.f, 0.f};
        UNR for (int ai = 0; ai < 2; ++ai) UNR for (int m = 0; m < 4; ++m) PR.ssv[ai][m] = NORMIN ? SS[u.pm * BM + wr * 64 + fr + ai * HALF + m * 16] : 0.f;
        return PR;
    }
    DEVFN void operator()(const f32x4 (&acc)[2][2][4][2], const Unit& u, int wr, int wc, int fr, int fq, const Pre& PR) const {
        const int row0 = u.pm * BM + wr * 64 + fr; const int pn = u.pn; const int vcol0 = wc * 32 + 8 * fq;
        const bool lat = u.pm * BM < ML;
        float bias[2][8];
        if (NORMIN) { UNR for (int bj = 0; bj < 2; ++bj) UNR for (int e = 0; e < 8; ++e) bias[bj][e] = PR.bias[bj][e >> 2][e & 3]; }
        UNR for (int ai = 0; ai < 2; ++ai) UNR for (int m = 0; m < 4; ++m) {
            const int row = row0 + ai * HALF + m * 16; float v[2][8];
            { float rs = 1.f; if (NORMIN) rs = RSQ(PR.ssv[ai][m] * (1.0f / D) + EPS);
              UNR for (int bj = 0; bj < 2; ++bj) UNR for (int e = 0; e < 8; ++e) { const float a = acc[ai][bj][m][e >> 2][e & 3]; v[bj][e] = NORMIN ? a * rs + bias[bj][e] : a; } }
            if (pn <= 1) {
                float ss = 0.f; UNR for (int bj = 0; bj < 2; ++bj) UNR for (int e = 0; e < 8; ++e) ss += v[bj][e] * v[bj][e];
                ss += __shfl_xor(ss, 16); ss += __shfl_xor(ss, 32);
                const float r = RSQ(ss * (1.0f / 64) + EPS) * (pn == 0 ? 0.125f * LOG2E : 1.0f); const float* g = (pn == 0 ? qn_a : kn_a);
                UNR for (int bj = 0; bj < 2; ++bj) { u32x4 w; float o[8]; UNR for (int e = 0; e < 8; ++e) o[e] = v[bj][e] * r * g[32 * bj + 8 * fq + e];
                    w.x = cvtpk(o[0], o[1]); w.y = cvtpk(o[2], o[3]); w.z = cvtpk(o[4], o[5]); w.w = cvtpk(o[6], o[7]);
                    *(u32x4*)(P + (size_t)row * PW + pn * BM + 64 * wc + 32 * bj + 8 * fq) = w; }
            } else if (pn == 3 || pn == 4) {
                const float* g = (pn == 3 ? qn_b : kn_b); int t = 0, prow = 0, pcol = 0; if (lat) { t = row % SEQ; prow = t / GRID_W; pcol = t % GRID_W; }
                UNR for (int bj = 0; bj < 2; ++bj) {
                    float ss = 0.f; UNR for (int e = 0; e < 8; ++e) ss += v[bj][e] * v[bj][e];
                    ss += __shfl_xor(ss, 16); ss += __shfl_xor(ss, 32);
                    const float r = RSQ(ss * (1.0f / 32) + EPS); float o[8], po[8];
                    UNR for (int e = 0; e < 8; ++e) o[e] = v[bj][e] * r * g[8 * fq + e];
                    UNR for (int e = 0; e < 8; ++e) po[e] = __shfl_xor(o[e], 16);
                    if (lat) { const float* rt = rope + ((fq & 2) ? pcol : prow) * 16; const bool isx2 = fq & 1;
                        UNR for (int e = 0; e < 8; ++e) { const float cs = rt[2 * e], sn = rt[2 * e + 1]; o[e] = isx2 ? o[e] * cs + po[e] * sn : o[e] * cs - po[e] * sn; } }
                    const float sc = pn == 3 ? 0.17677669529663687f * LOG2E : 1.0f; u32x4 w;
                    w.x = cvtpk(o[0] * sc, o[1] * sc); w.y = cvtpk(o[2] * sc, o[3] * sc); w.z = cvtpk(o[4] * sc, o[5] * sc); w.w = cvtpk(o[6] * sc, o[7] * sc);
                    *(u32x4*)(P + (size_t)row * PW + pn * BM + bj * HALF + vcol0) = w; }
            } else {
                const float sc = pn == 6 ? 0.125f : 1.0f;
                UNR for (int bj = 0; bj < 2; ++bj) { const int col = pn * BM + bj * HALF + vcol0; u32x4 w;
                    w.x = cvtpk(v[bj][0] * sc, v[bj][1] * sc); w.y = cvtpk(v[bj][2] * sc, v[bj][3] * sc); w.z = cvtpk(v[bj][4] * sc, v[bj][5] * sc); w.w = cvtpk(v[bj][6] * sc, v[bj][7] * sc);
                    if (col < PW) *(u32x4*)(P + (size_t)row * PW + col) = w;
                    else if (col < PW + 32) *(u32x4*)(AFB + (size_t)row * 32 + (col - PW)) = w; }
            }
        }
    }
};
}
DEVFN void ph_bias2(const bf16* Bt, int N, const float* shb, float* out, int gw, int NGW, int lane) {
    static_assert(D % 512 == 0, "bias2 layout"); constexpr int NJ = D / 512, SP = 3;
    for (int s0 = 0; s0 <= BATCH; s0 += SP) {
        f32x4 sv[SP][NJ][2];
        UNR for (int s = 0; s < SP; ++s) { const int sl = s0 + s <= BATCH ? s0 + s : BATCH; const float* sh = shb + (size_t)sl * 6 * D;
            UNR for (int j = 0; j < NJ; ++j) UNR for (int q = 0; q < 2; ++q) sv[s][j][q] = *(const f32x4*)(sh + 512 * j + 8 * lane + 4 * q); }
        for (int n = gw; n < N; n += NGW) {
            float w[NJ][8]; UNR for (int j = 0; j < NJ; ++j) ld8(Bt + (size_t)n * D + 512 * j + 8 * lane, w[j]);
            float a[SP]; UNR for (int s = 0; s < SP; ++s) { a[s] = 0.f; UNR for (int j = 0; j < NJ; ++j) UNR for (int e = 0; e < 8; ++e) a[s] += w[j][e] * sv[s][j][e >> 2][e & 3]; }
            UNR for (int s = 0; s < SP; ++s) a[s] = wave_sum64(a[s]);
            if (lane == 0) { UNR for (int s = 0; s < SP; ++s) if (s0 + s <= BATCH) out[(size_t)(s0 + s) * N + n] = a[s]; }
        }
    }
}
DEVFN void ffn_fix_rowtile(const Params& p, int l, int pm, int tid) {
    if (tid >= FFN / 8) return;
    const float* cw = p.conv_w + (size_t)l * 3 * FFN; const float* cb = p.conv_b + (size_t)l * FFN; const int f0 = 8 * tid;
    float wb[8], w0[8], w1[8], w2[8];
    UNR for (int q = 0; q < 2; ++q) { const f32x4 vb = *(const f32x4*)(cb + f0 + 4 * q), v0 = *(const f32x4*)(cw + f0 + 4 * q), v1 = *(const f32x4*)(cw + FFN + f0 + 4 * q), v2 = *(const f32x4*)(cw + 2 * FFN + f0 + 4 * q);
        UNR for (int e = 0; e < 4; ++e) { wb[4 * q + e] = vb[e]; w0[4 * q + e] = v0[e]; w1[4 * q + e] = v1[e]; w2[4 * q + e] = v2[e]; } }
    {
        U4 curw[8], uuw[8], prvw[8], nxtw[8];
        UNR for (int k = 0; k < 8; ++k) { const int kb = 4 * pm + (k >> 1), edge = k & 1; const int row = 64 * kb + (edge ? 63 : 0);
            int pos, len; if (row < ML) { pos = row & (SEQ - 1); len = SEQ; } else { pos = (row - ML) & (CTX - 1); len = CTX; }
            const unsigned ea0 = (unsigned)kb * 4u * (unsigned)FFN + (unsigned)f0;
            curw[k] = *(const U4*)(p.EA + ea0 + (edge ? 3u : 0u) * (unsigned)FFN); uuw[k] = *(const U4*)(p.EU + ((unsigned)kb * 2u + (unsigned)edge) * (unsigned)FFN + (unsigned)f0);
            prvw[k] = curw[k]; nxtw[k] = curw[k];
            if (edge == 0) { if (pos > 0) prvw[k] = *(const U4*)(p.EA + ea0 - (unsigned)FFN); nxtw[k] = *(const U4*)(p.EA + ea0 + (unsigned)FFN); }
            else { prvw[k] = *(const U4*)(p.EA + ea0 + 2u * (unsigned)FFN); if (pos < len - 1) nxtw[k] = *(const U4*)(p.EA + ea0 + 4u * (unsigned)FFN); } }
        UNR for (int k = 0; k < 8; ++k) { const int kb = 4 * pm + (k >> 1), edge = k & 1; const int row = 64 * kb + (edge ? 63 : 0);
            int pos, len; if (row < ML) { pos = row & (SEQ - 1); len = SEQ; } else { pos = (row - ML) & (CTX - 1); len = CTX; }
            const bool hp = edge == 1 || pos > 0, hn = edge == 0 || pos < len - 1;
            float cur[8], prv[8], nxt[8], uu[8], act[8]; ld8((const bf16*)&curw[k], cur); ld8((const bf16*)&uuw[k], uu); ld8((const bf16*)&prvw[k], prv); ld8((const bf16*)&nxtw[k], nxt);
            UNR for (int e = 0; e < 8; ++e) { float a = wb[e] + w1[e] * cur[e]; if (hp) a += w0[e] * prv[e]; if (hn) a += w2[e] * nxt[e]; act[e] = silu_fast(a) * uu[e]; }
            u32x4 w; w.x = cvtpk(act[0], act[1]); w.y = cvtpk(act[2], act[3]); w.z = cvtpk(act[4], act[5]); w.w = cvtpk(act[6], act[7]); *(u32x4*)(p.ACT + (unsigned)row * (unsigned)FFN + (unsigned)f0) = w; }
    }
}
DEVFN void ph_ffn_fix(const Params& p, int l, int mrows, long gtid, long gsize) {
    const float* cw = p.conv_w + (size_t)l * 3 * FFN; const float* cb = p.conv_b + (size_t)l * FFN;
    const long N = (long)(mrows / 64) * 2 * (FFN / 8);
    for (long i = gtid; i < N; i += gsize) {
        const int f0 = (int)(i % (FFN / 8)) * 8, edge = (int)((i / (FFN / 8)) & 1), kb = (int)(i / (2 * (FFN / 8)));
        const int row = 64 * kb + (edge ? 63 : 0); int pos, len; if (row < ML) { pos = row % SEQ; len = SEQ; } else { pos = (row - ML) % CTX; len = CTX; }
        float cur[8], prv[8], nxt[8], uu[8];
        ld8(p.EA + ((size_t)kb * 4 + (edge ? 3 : 0)) * FFN + f0, cur); ld8(p.EU + ((size_t)kb * 2 + edge) * FFN + f0, uu);
        if (edge == 0) { if (pos > 0) ld8(p.EA + ((size_t)(kb - 1) * 4 + 3) * FFN + f0, prv); ld8(p.EA + ((size_t)kb * 4 + 1) * FFN + f0, nxt); }
        else { ld8(p.EA + ((size_t)kb * 4 + 2) * FFN + f0, prv); if (pos < len - 1) ld8(p.EA + ((size_t)(kb + 1) * 4 + 0) * FFN + f0, nxt); }
        const bool hp = edge == 1 || pos > 0, hn = edge == 0 || pos < len - 1; float act[8];
        float wb[8], w0[8], w1[8], w2[8];
        UNR for (int q = 0; q < 2; ++q) { const f32x4 vb = *(const f32x4*)(cb + f0 + 4 * q), v0 = *(const f32x4*)(cw + f0 + 4 * q), v1 = *(const f32x4*)(cw + FFN + f0 + 4 * q), v2 = *(const f32x4*)(cw + 2 * FFN + f0 + 4 * q);
            UNR for (int e = 0; e < 4; ++e) { wb[4 * q + e] = vb[e]; w0[4 * q + e] = v0[e]; w1[4 * q + e] = v1[e]; w2[4 * q + e] = v2[e]; } }
        UNR for (int e = 0; e < 8; ++e) { float a = wb[e] + w1[e] * cur[e]; if (hp) a += w0[e] * prv[e]; if (hn) a += w2[e] * nxt[e]; act[e] = silu_fast(a) * uu[e]; }
        u32x4 w; w.x = cvtpk(act[0], act[1]); w.y = cvtpk(act[2], act[3]); w.z = cvtpk(act[4], act[5]); w.w = cvtpk(act[6], act[7]); *(u32x4*)(p.ACT + (size_t)row * FFN + f0) = w;
    }
}
namespace pg8 {
template <bool NOSTORE = false> struct EpiInprojT {
    static constexpr bool PERM = true, AFTER_DRAIN = false;
    bf16_t* P; bf16_t* AFB;
    __device__ __forceinline__ void operator()(const f32x4 (&acc)[2][2][4][2], const Unit& u, int wr, int wc, int fr, int fq) const {
        const int row0 = u.pm * BM + wr * 64 + fr; const int col0 = u.pn * BM + wc * 32 + 8 * fq;
#pragma unroll
        for (int ai = 0; ai < 2; ++ai)
#pragma unroll
            for (int m = 0; m < 4; ++m) { const size_t row = (size_t)(row0 + ai * HALF + m * 16);
#pragma unroll
                for (int bj = 0; bj < 2; ++bj) { const f32x4 v0 = acc[ai][bj][m][0], v1 = acc[ai][bj][m][1]; const int col = col0 + bj * HALF;
                    u32x4 w; w.x = cvt_pk_bf16(v0[0], v0[1]); w.y = cvt_pk_bf16(v0[2], v0[3]); w.z = cvt_pk_bf16(v1[0], v1[1]); w.w = cvt_pk_bf16(v1[2], v1[3]);
                    if (NOSTORE) { *(u32x4*)(P + (row & 63) * PW + (col & 1023)) = w; }
                    else if (col < PW) *(u32x4*)(P + row * PW + col) = w;
                    else if (col < PW + 32) *(u32x4*)(AFB + row * 32 + (col - PW)) = w; } }
    }
};
typedef EpiInprojT<false> EpiInproj;
struct EpiBf16Plain {
    static constexpr bool PERM = true, AFTER_DRAIN = false;
    bf16_t* O; int ldc;
    __device__ __forceinline__ void operator()(const f32x4 (&acc)[2][2][4][2], const Unit& u, int wr, int wc, int fr, int fq) const {
        const int row0 = u.pm * BM + wr * 64 + fr; const int col0 = u.pn * BM + wc * 32 + 8 * fq;
#pragma unroll
        for (int ai = 0; ai < 2; ++ai)
#pragma unroll
            for (int m = 0; m < 4; ++m) { bf16_t* rowp = O + (size_t)(row0 + ai * HALF + m * 16) * ldc + col0;
#pragma unroll
                for (int bj = 0; bj < 2; ++bj) { const f32x4 v0 = acc[ai][bj][m][0], v1 = acc[ai][bj][m][1];
                    u32x4 w; w.x = cvt_pk_bf16(v0[0], v0[1]); w.y = cvt_pk_bf16(v0[2], v0[3]); w.z = cvt_pk_bf16(v1[0], v1[1]); w.w = cvt_pk_bf16(v1[2], v1[3]);
                    *(u32x4*)(rowp + bj * HALF) = w; } }
    }
};
struct EpiResid {
    static constexpr bool PERM = false, AFTER_DRAIN = false;
    const float* base_lat; const float* base_ctx; float* out_lat; float* out_ctx; const float* gate;
    __device__ __forceinline__ void operator()(const f32x4 (&acc)[2][2][4][2], const Unit& u, int wr, int wc, int fr, int fq) const {
        const bool lat = u.pm * BM < ML;
        const int slot = lat ? (u.pm * BM) / SEQ : BATCH;
        const int lrow0 = (lat ? u.pm * BM : u.pm * BM - ML) + wr * 64 + fr;
        const float* bs = lat ? base_lat : base_ctx; float* os = lat ? out_lat : out_ctx;
        const float* g = gate + (size_t)slot * 6 * D;
        const int col0 = u.pn * BM + wc * 32 + 4 * fq;
        f32x4 gv[2][2];
#pragma unroll
        for (int bj = 0; bj < 2; ++bj)
#pragma unroll
            for (int n = 0; n < 2; ++n) gv[bj][n] = *(const f32x4*)(g + col0 + bj * HALF + n * 16);
#pragma unroll
        for (int ai = 0; ai < 2; ++ai)
#pragma unroll
            for (int m = 0; m < 4; ++m) { const size_t off = (size_t)(lrow0 + ai * HALF + m * 16) * D + col0;
#pragma unroll
                for (int bj = 0; bj < 2; ++bj)
#pragma unroll
                    for (int n = 0; n < 2; ++n) { const f32x4 b = *(const f32x4*)(bs + off + bj * HALF + n * 16);
                        *(f32x4*)(os + off + bj * HALF + n * 16) = b + gv[bj][n] * acc[ai][bj][m][n]; } }
    }
};
}

constexpr size_t MiB = 1u << 20;
constexpr size_t WS_CTL = 0, CTL_ZERO_BYTES = 1 * MiB;
constexpr size_t WS_MOD = 1 * MiB, WS_ROPE = 2 * MiB;
constexpr size_t WS_WIN = 3 * MiB, WS_WOUT = 10 * MiB, WS_WGU = 12 * MiB, WS_WD = 23 * MiB;
constexpr size_t WS_HC = 29 * MiB, WS_XN = 37 * MiB, WS_AFB = 105 * MiB, WS_R1 = 108 * MiB, WS_R2 = 312 * MiB;
constexpr size_t WS_GO = WS_R2, WS_ALF = WS_R2 + 68 * MiB, WS_ALB = WS_R2 + 102 * MiB, WS_DT = WS_R2 + 136 * MiB, WS_US = WS_R2, WS_AD = WS_R2 + 136 * MiB, WS_EA = WS_R1, WS_EU = WS_R1 + 16 * MiB, WS_XN2 = WS_R1 + 40 * MiB, WS_HB = WS_R1 + 112 * MiB, WS_SS1 = WS_ROPE + 256 * 1024, WS_SS2 = WS_ROPE + 400 * 1024, WS_B2IN = WS_ROPE + 544 * 1024, WS_B2GU = WS_ROPE + 672 * 1024, WS_END = 499 * MiB;
constexpr int NPAD_IN = (IN_W + 255) / 256 * 256;
static_assert(WS_WIN + (size_t)NPAD_IN * D * 2 <= WS_WOUT && WS_WOUT + (size_t)D * D * 2 <= WS_WGU && WS_WGU + (size_t)2 * FFN * D * 2 <= WS_WD && WS_WD + (size_t)D * FFN * 2 <= WS_HC, "weights map");
static_assert(WS_HC + (size_t)MC * D * 4 <= WS_XN && WS_XN + (size_t)M * D * 2 <= WS_AFB && WS_AFB + (size_t)M * 32 * 2 <= WS_R1, "ws map 1");
static_assert(WS_R1 + (size_t)M * PW * 2 <= WS_R2 && WS_R1 + (size_t)M * GUP * 2 <= WS_R2 && WS_R2 + (size_t)M * FFN * 2 <= WS_END, "ws map 2");
static_assert(WS_ALB + (size_t)M * GK_W * 4 <= WS_DT && WS_DT + (size_t)M * DV_W * 4 <= WS_END, "ws map 4");
static_assert(WS_XN2 + (size_t)M * D * 2 <= WS_HB && WS_HB + (size_t)M * D * 2 <= WS_R2, "ws map 8");
static_assert(WS_XN2 + (size_t)M * D * 2 <= WS_R2 && WS_EU + (size_t)(M / 64) * 2 * FFN * 2 <= WS_XN2 && (size_t)M * 4 <= 144 * 1024 && (size_t)9 * NPAD_IN * 4 <= 128 * 1024 && WS_B2GU + (size_t)9 * 2 * FFN * 4 <= WS_WIN, "ws map 7");
static_assert(WS_EA + (size_t)(M / 64) * 4 * FFN * 2 <= WS_EU && WS_EU + (size_t)(M / 64) * 2 * FFN * 2 <= WS_R2, "ws map 6");
static_assert(WS_US + (size_t)BATCH * GLH * 2 * NCH * 32768 <= WS_AD && WS_AD + (size_t)BATCH * GLH * 2 * NCH * 256 <= WS_END, "ws map 5");
static_assert(WS_GO + (size_t)M * GV_W * 4 <= WS_ALF && WS_ALF + (size_t)M * GK_W * 4 <= WS_ALB && WS_ALB + (size_t)M * GK_W * 4 <= WS_END, "ws map 3");
constexpr int CW_BAR = 4096, CW_SPLIT = 16384;
#ifndef SPLITK
#define SPLITK 4
#endif
static_assert(WS_R2 + (size_t)64 * SPLITK * 262144 <= WS_END && WS_XN2 + (size_t)64 * SPLITK * 262144 <= WS_HB, "split-K partials");
constexpr int RING_OFF = 0, RING_BYTES = 131072;
constexpr int LDSCTL_OFF = RING_BYTES, MISC_OFF = LDSCTL_OFF + 320;
constexpr int LDS_BYTES = 147456;
constexpr int NWAVES = 8, NTHREADS = 512;

__device__ __forceinline__ void transpose_item(const float* W, int ldw, bf16* WT, int ldt, int k0, int n0, int dst_row0, LAS float* scr, int lane) {
    float tmp[32];
#pragma unroll
    for (int i = 0; i < 32; ++i) { const int kk = 2 * i + (lane >> 5); tmp[i] = W[(size_t)(k0 + kk) * ldw + n0 + (lane & 31)]; }
#pragma unroll
    for (int i = 0; i < 32; ++i) { const int kk = 2 * i + (lane >> 5); scr[kk * 33 + (lane & 31)] = tmp[i]; }
    LDS_WAIT(); asm volatile("" ::: "memory");
    const int c = lane & 7;
#pragma unroll
    for (int j = 0; j < 4; ++j) { const int n = (lane >> 3) + 8 * j; const LAS float* s = scr + (8 * c) * 33 + n;
        v4u o; o.x = pk2(s[0 * 33], s[1 * 33]); o.y = pk2(s[2 * 33], s[3 * 33]); o.z = pk2(s[4 * 33], s[5 * 33]); o.w = pk2(s[6 * 33], s[7 * 33]);
        *(GAS v4u*)(WT + (size_t)(dst_row0 + n) * ldt + k0 + 8 * c) = o; }
    LDS_WAIT(); asm volatile("" ::: "memory");
}
__device__ __forceinline__ void ph_weights(const Params& p, int l, LAS unsigned char* lds, int gw, int NGW, int wave, int lane, int mask = 15) {
    LAS float* scr = (LAS float*)(lds + RING_OFF + wave * 16384);
    constexpr int NB_IN = IN_W / 32, I_IN = (D / 64) * NB_IN, I_OUT = (D / 64) * (D / 32), I_G = (D / 64) * (FFN / 32), I_D = (FFN / 64) * (D / 32);
    constexpr int NITEMS = I_IN + I_OUT + 2 * I_G + I_D;
    static_assert(IN_W % 32 == 0 && FFN % 64 == 0, "transpose items");
    for (int it = gw; it < NITEMS; it += NGW) {
        int r = it;
        if (r < I_IN) { if (!(mask & 1)) continue; const int kb = r / NB_IN, nb = r % NB_IN; const int n0 = 32 * nb;
            const int dst = n0 < 512 ? (n0 & ~255) + 128 * ((n0 >> 5) & 1) + 32 * ((n0 >> 6) & 3) : n0;
            transpose_item(p.w_in + (size_t)l * D * IN_W, IN_W, p.WIN_T, D, 64 * kb, n0, dst, scr, lane); continue; } r -= I_IN;
        if (r < I_OUT) { if (!(mask & 2)) continue; const int kb = r / (D / 32), nb = r % (D / 32); transpose_item(p.w_out + (size_t)l * D * D, D, p.WOUT_T, D, 64 * kb, 32 * nb, 32 * nb, scr, lane); continue; } r -= I_OUT;
        if (r < 2 * I_G) { if (!(mask & 4)) continue; const int s = r / I_G; r -= s * I_G; const int kb = r / (FFN / 32), nb = r % (FFN / 32); const int n0 = 32 * nb;
            transpose_item((s ? p.w_u : p.w_g) + (size_t)l * D * FFN, FFN, p.WGU_T, D, 64 * kb, n0, 256 * (n0 / 128) + 128 * s + (n0 % 128), scr, lane); continue; } r -= 2 * I_G;
        if (mask & 8) { const int kb = r / (D / 32), nb = r % (D / 32); transpose_item(p.w_d + (size_t)l * FFN * D, D, p.WD_T, FFN, 64 * kb, 32 * nb, 32 * nb, scr, lane); }
    }
    if (mask & 1) { const int tot = (NPAD_IN - IN_W) * D / 8; v4u z = {0u, 0u, 0u, 0u};
      for (int i = gw * 64 + lane; i < tot; i += NGW * 64) *(GAS v4u*)(p.WIN_T + (size_t)IN_W * D + (size_t)i * 8) = z; }
}

#ifndef NOGLA
#define NOGLA 0
#endif
struct Args { Params p; int ph_lo, ph_hi; };
constexpr int PH_PER_LAYER = 9, N_PHASES = 1 + DEPTH * PH_PER_LAYER;

struct Ctx { LAS unsigned char* lds; long gtid, gsize; int gw, NGW, wave, lane, G; };
__device__ __forceinline__ Ctx make_ctx(LAS unsigned char* lds) {
    int tid = threadIdx.x; asm volatile("" : "+v"(tid));
    Ctx c; c.lds = lds; c.lane = tid & 63; c.wave = __builtin_amdgcn_readfirstlane(tid >> 6); c.G = gridDim.x;
    c.gtid = (long)blockIdx.x * NTHREADS + tid; c.gsize = (long)c.G * NTHREADS; c.gw = blockIdx.x * NWAVES + c.wave; c.NGW = c.G * NWAVES; return c; }

template <int PH> __device__ __forceinline__ void run_phase(const Params& p, LAS unsigned char* lds_) {
    const Ctx c = make_ctx(lds_);
    if constexpr (PH == 0) {
        ph_mod_fast(p, c.lds, (int)blockIdx.x, c.G); ph_rope_table(p, c.gtid, c.gsize);
        __syncthreads();
        ph_weights(p, 0, c.lds, c.gw, c.NGW, c.wave, c.lane);
    } else {
        constexpr int l = (PH - 1) / PH_PER_LAYER, s = (PH - 1) % PH_PER_LAYER;
        constexpr bool wc = l < DEPTH - 1; constexpr int mrows = wc ? M : ML;
        const float* modl = p.MOD + (size_t)l * (BATCH + 1) * 6 * D;
        if constexpr (s == 0) {
            if (l == 0) { ph_norm_fast(p, l, 0, true, M, c.gw, c.NGW, c.lane);
                ph_bias2(p.WGU_T, 2 * FFN, modl + 3 * D, p.B2GU, c.gw, c.NGW, c.lane); }
        }
        if constexpr (s == 1) { pg8::Gemm g{p.XN, p.WIN_T, M, NPAD_IN, D}; pg8::StaticOrder S; S.init(M, NPAD_IN, c.G, (int)blockIdx.x);
            if constexpr (l == 0) { pg8::EpiInprojPost<false> E{p.P, p.AFB, p.SS1, p.B2IN, NPAD_IN, p.qn_a + l * 64, p.kn_a + l * 64, p.qn_b + l * 32, p.kn_b + l * 32, p.ROPE};
                pg8::gemm_phase<pg8::EpiInprojPost<false>, pg8::StaticOrder, true, true>(c.lds + RING_OFF, g, S, E); }
            else { pg8::EpiInprojPost<true> E{p.P, p.AFB, p.SS1, p.B2IN, NPAD_IN, p.qn_a + l * 64, p.kn_a + l * 64, p.qn_b + l * 32, p.kn_b + l * 32, p.ROPE};
                pg8::gemm_phase<pg8::EpiInprojPost<true>, pg8::StaticOrder, true, true>(c.lds + RING_OFF, g, S, E); } }
        if constexpr (s == 2) { for (long i = c.gtid; i < M; i += c.gsize) { p.SS2[i] = 0.f; if (l == 0) p.SS1[i] = 0.f; }
            if constexpr (l > 0) { ph_weights(p, l, c.lds, c.gw, c.NGW, c.wave, c.lane, 8); ph_bias2(p.WGU_T, 2 * FFN, modl + 3 * D, p.B2GU, c.gw, c.NGW, c.lane); __syncthreads(); }
            ph_gla_A(p, l, c.lds, (int)blockIdx.x, c.G);
#ifdef REP_A
            __syncthreads(); ph_gla_A(p, l, c.lds, (int)blockIdx.x, c.G); __syncthreads();
#endif
            ph_na_fast(p, l, wc, c.lds, (int)blockIdx.x, c.G);
#ifdef REP_NA
            __syncthreads(); ph_na_fast(p, l, wc, c.lds, (int)blockIdx.x, c.G);
#endif
            }
        if constexpr (s == 3) { ph_gla_B(p, (int)blockIdx.x, c.G);
#ifdef REP_B
            __syncthreads(); ph_gla_B(p, (int)blockIdx.x, c.G); __syncthreads(); ph_gla_B(p, (int)blockIdx.x, c.G);
#endif
            ph_diff_fast(p, l, wc, c.lds, (int)blockIdx.x, c.G);
#ifdef REP_DIFF
            __syncthreads(); ph_diff_fast<REP_DIFF>(p, l, wc, c.lds, (int)blockIdx.x, c.G);
#endif
        }
        if constexpr (s == 4) ph_gla_C(p, l, wc, c.lds, (int)blockIdx.x, c.G);
        if constexpr (s == 5) { pg8::Gemm g{p.XN, p.WOUT_T, mrows, D, D};
                      typedef pg8::EpiResidT<true, (l > 0), true> EpiO;
                      EpiO E{p.x, p.ctx, p.out, p.HC, modl + 2 * D, p.XN2, p.norm2 + (size_t)l * D, modl + 4 * D, p.SS2, (const bf16*)p.out, p.HB};
                      constexpr int ntl = ((mrows / 256) * (D / 256)) % 256;
                      if constexpr (ntl > 0 && ntl * SPLITK <= 256) { pg8::SplitTailOrder<SPLITK> S; S.init(mrows, D, D, c.G, (int)blockIdx.x, (float*)(p.ws + WS_R2), (unsigned*)(p.ws + WS_CTL) + CW_SPLIT, (volatile LAS unsigned*)(c.lds + MISC_OFF) + 12);
                          pg8::gemm_phase<EpiO, pg8::SplitTailOrder<SPLITK>, true, true>(c.lds + RING_OFF, g, S, E); }
                      else { pg8::StaticOrder S; S.init(mrows, D, c.G, (int)blockIdx.x); pg8::gemm_phase<EpiO, pg8::StaticOrder, true, true>(c.lds + RING_OFF, g, S, E); }
                      if constexpr (l + 1 < DEPTH) { constexpr int nfull = (ntl > 0 && ntl * SPLITK <= 256) ? ntl * SPLITK : ntl;
                          __syncthreads(); if ((int)blockIdx.x >= nfull && c.G == 256) ph_weights(p, l + 1, c.lds, ((int)blockIdx.x - nfull) * NWAVES + c.wave, (c.G - nfull) * NWAVES, c.wave, c.lane, 1);
                          else if (c.G != 256) ph_weights(p, l + 1, c.lds, c.gw, c.NGW, c.wave, c.lane, 1); } }
        if constexpr (s == 6) { pg8::Gemm g{p.XN2, p.WGU_T, mrows, 2 * FFN, D}; pg8::StaticOrder S; S.init(mrows, 2 * FFN, c.G, (int)blockIdx.x);
                      pg8::EpiGU E{p.ACT, p.EA, p.EU, p.conv_w + (size_t)l * 3 * FFN, p.conv_b + (size_t)l * FFN, p.SS2, p.B2GU};
                      pg8::gemm_phase<pg8::EpiGU, pg8::StaticOrder, true, true>(c.lds + RING_OFF, g, S, E); }
        if constexpr (s == 7) {
#ifdef OLD_FIX_PHASE
            ph_ffn_fix(p, l, mrows, c.gtid, c.gsize);
#endif
#ifdef CAL_VALU
            if constexpr (l == 0) { float a[16]; _Pragma("unroll") for (int i = 0; i < 16; ++i) a[i] = (float)(c.lane + i);
                for (int it = 0; it < CAL_VALU; ++it) { _Pragma("unroll") for (int i = 0; i < 16; ++i) a[i] = __builtin_fmaf(a[i], 1.0001f, 0.5f); asm volatile("" : "+v"(a[0]), "+v"(a[1]), "+v"(a[2]), "+v"(a[3])); }
                float sacc = 0.f; _Pragma("unroll") for (int i = 0; i < 16; ++i) sacc += a[i]; if (sacc == 1.2345f) p.SS2[0] = sacc; }
#endif
#ifdef CAL_MFMA
            if constexpr (l == 0) { f32x16 acc0, acc1; _Pragma("unroll") for (int i = 0; i < 16; ++i) { acc0[i] = 0.f; acc1[i] = 0.f; }
                bf16x8 av = {(short)c.lane, 1, 2, 3, 4, 5, 6, 7}, bv = {1, 2, 3, 4, 5, 6, 7, (short)c.lane};
                for (int it = 0; it < CAL_MFMA; ++it) { _Pragma("unroll") for (int i = 0; i < 4; ++i) { acc0 = MFMA32(av, bv, acc0); acc1 = MFMA32(bv, av, acc1); } }
                if (acc0[0] + acc1[3] == 1.2345f) p.SS2[0] = acc0[0]; }
#endif
        }
#define FIX_MY_TILES(SCHED) do { int last_pm_ = -1; pg8::Unit uu_; for (int i_ = 0; (SCHED).next(i_, uu_); ++i_) if (uu_.pm != last_pm_) { ffn_fix_rowtile(p, l, uu_.pm, c.wave * 64 + c.lane); last_pm_ = uu_.pm; } \
            asm volatile("s_waitcnt vmcnt(0)" ::: "memory"); __syncthreads(); } while (0)
        if constexpr (s == 8) { pg8::Gemm g{p.ACT, p.WD_T, mrows, D, FFN}; pg8::StaticOrder S; S.init(mrows, D, c.G, (int)blockIdx.x);
                      if constexpr (l + 1 < DEPTH) { const float* modn = p.MOD + (size_t)(l + 1) * (BATCH + 1) * 6 * D;
                          typedef pg8::EpiResidT<true, true, true> EpiD;
                          EpiD E{p.out, p.HC, p.out, p.HC, modl + 5 * D, p.XN, p.norm1 + (size_t)(l + 1) * D, modn + 1 * D, p.SS1, p.HB, (bf16*)p.out};
                          constexpr int ntl = ((mrows / 256) * (D / 256)) % 256;
                          if constexpr (ntl > 0 && ntl * SPLITK <= 256) { pg8::SplitTailOrder<SPLITK> S2; S2.init(mrows, D, FFN, c.G, (int)blockIdx.x, (float*)(p.ws + WS_XN2), (unsigned*)(p.ws + WS_CTL) + CW_SPLIT + 64, (volatile LAS unsigned*)(c.lds + MISC_OFF) + 12);
                              FIX_MY_TILES(S2); pg8::gemm_phase<EpiD, pg8::SplitTailOrder<SPLITK>, true, true>(c.lds + RING_OFF, g, S2, E); }
                          else { FIX_MY_TILES(S); pg8::gemm_phase<EpiD, pg8::StaticOrder, true, true>(c.lds + RING_OFF, g, S, E); }
                          constexpr int nfull = (ntl > 0 && ntl * SPLITK <= 256) ? ntl * SPLITK : ntl;
                          __syncthreads(); if ((int)blockIdx.x >= nfull && c.G == 256) { ph_weights(p, l + 1, c.lds, ((int)blockIdx.x - nfull) * NWAVES + c.wave, (c.G - nfull) * NWAVES, c.wave, c.lane, 6);
                              ph_bias2(p.WIN_T, NPAD_IN, modn + 0 * D, p.B2IN, ((int)blockIdx.x - nfull) * NWAVES + c.wave, (c.G - nfull) * NWAVES, c.lane); }
                          else if (c.G != 256) { ph_weights(p, l + 1, c.lds, c.gw, c.NGW, c.wave, c.lane, 6); ph_bias2(p.WIN_T, NPAD_IN, modn + 0 * D, p.B2IN, c.gw, c.NGW, c.lane); } }
                      else { typedef pg8::EpiResidT<false, true, false> EpiD;
                          EpiD E{p.out, p.HC, p.out, p.HC, modl + 5 * D, nullptr, nullptr, nullptr, nullptr, p.HB, nullptr};
                          FIX_MY_TILES(S); pg8::gemm_phase<EpiD, pg8::StaticOrder, true, true>(c.lds + RING_OFF, g, S, E); } }
#undef FIX_MY_TILES
    }
}

template <int PH> __device__ __forceinline__ void run_from(const Params& p, LAS unsigned char* c, const XcdBarrier& bar, int lo, int hi) {
    if constexpr (PH < N_PHASES) {
        constexpr bool EMPTY_PH = (PH > PH_PER_LAYER && ((PH - 1) % PH_PER_LAYER) == 0) || (PH > 0 && ((PH - 1) % PH_PER_LAYER) == 7);
        if (lo <= PH && PH < hi && !EMPTY_PH) { run_phase<PH>(p, c);
#ifdef REP_S
            if constexpr ((PH > 0 && ((PH - 1) % PH_PER_LAYER) == REP_S) || (PH == 0 && REP_S == 9)) { xcd_barrier(bar);
#ifdef REP_NOSTORE
                { const Ctx cc = make_ctx(c); pg8::Gemm g{p.XN, p.WIN_T, M, NPAD_IN, D}; pg8::StaticOrder S; S.init(M, NPAD_IN, cc.G, (int)blockIdx.x);
                  pg8::EpiInprojT<true> E{(bf16*)(p.ws + WS_R2 + 140 * MiB), p.AFB}; pg8::gemm_phase<pg8::EpiInprojT<true>, pg8::StaticOrder, true, true>(cc.lds + RING_OFF, g, S, E); }
#else
                run_phase<PH>(p, c);
#endif
            }
#endif
            if (PH + 1 < hi) xcd_barrier(bar); }
        run_from<PH + 1>(p, c, bar, lo, hi);
    }
}

#ifdef PHASE_PROBE
template <int PH> __global__ void __launch_bounds__(NTHREADS, 2) k_probe(Args args) {
    extern __shared__ __attribute__((aligned(16))) unsigned char lds_raw[];
    run_phase<PH>(args.p, (LAS unsigned char*)lds_raw);
}
template __global__ void k_probe<0>(Args); template __global__ void k_probe<1>(Args); template __global__ void k_probe<2>(Args); template __global__ void k_probe<3>(Args);
template __global__ void k_probe<4>(Args); template __global__ void k_probe<5>(Args); template __global__ void k_probe<6>(Args); template __global__ void k_probe<7>(Args);
template __global__ void k_probe<8>(Args); template __global__ void k_probe<9>(Args); template __global__ void k_probe<12>(Args); template __global__ void k_probe<13>(Args);
#endif

__global__ void __launch_bounds__(NTHREADS, 2) mk_fwd(Args args) {
    extern __shared__ __attribute__((aligned(16))) unsigned char lds_raw[];
    LAS unsigned char* lds = (LAS unsigned char*)lds_raw;
    const Params& p = args.p;
    const int tid = threadIdx.x;
    volatile LAS unsigned* MISC = (volatile LAS unsigned*)(lds + MISC_OFF);
    for (int u = tid; u < (LDS_BYTES - LDSCTL_OFF) / 4; u += NTHREADS) ((LAS unsigned*)(lds + LDSCTL_OFF))[u] = 0u;
    __syncthreads();
    gu32* ctl = (gu32*)(p.ws + WS_CTL);
    XcdBarrier bar = xcd_barrier_post((unsigned*)(ctl + CW_BAR), MISC + 8);
    run_from<0>(p, lds, bar, args.ph_lo, args.ph_hi);
}

#ifndef MK_MULTI
#define MK_MULTI 0
#endif
extern "C" void kernel_launch(void* const* d_in, const int* in_sizes, int n_in, void* d_out, int out_size, void* d_ws, size_t ws_size, hipStream_t stream) {
    static int grid = 0;
    if (grid == 0) {
        if (n_in != 30 || in_sizes[0] != ML * D || out_size != ML * D || ws_size < WS_END) { fprintf(stderr, "kernel_launch: unexpected shapes: n_in %d in0 %d out %d ws %zu (need %zu)\n", n_in, n_in > 0 ? in_sizes[0] : -1, out_size, ws_size, (size_t)WS_END); grid = -1; return; }
        int dev = 0, cus = 0, per_cu = 0;
        if (hipGetDevice(&dev) != hipSuccess || hipDeviceGetAttribute(&cus, hipDeviceAttributeMultiprocessorCount, dev) != hipSuccess) { grid = -1; return; }
        if (hipFuncSetAttribute((const void*)mk_fwd, hipFuncAttributeMaxDynamicSharedMemorySize, LDS_BYTES) != hipSuccess) { fprintf(stderr, "kernel_launch: hipFuncSetAttribute failed\n"); grid = -1; return; }
        if (hipOccupancyMaxActiveBlocksPerMultiprocessor(&per_cu, (const void*)mk_fwd, NTHREADS, LDS_BYTES) != hipSuccess || per_cu < 1) { fprintf(stderr, "kernel_launch: occupancy query reports %d workgroups per CU; nothing launched\n", per_cu); (void)hipGetLastError(); grid = -1; return; }
        (void)hipGetLastError();
        grid = cus;
    }
    if (grid < 0) return;
    if (hipMemsetAsync((char*)d_ws + WS_CTL, 0, CTL_ZERO_BYTES, stream) != hipSuccess) { fprintf(stderr, "kernel_launch: memset failed\n"); return; }
    Args a; memset(&a, 0, sizeof(a));
    Params& p = a.p;
    const float* const* in = (const float* const*)d_in;
    p.x = in[0]; p.c = in[1]; p.ctx = in[2]; p.c_ctx = in[3]; p.norm1 = in[4]; p.norm2 = in[5]; p.w_ada = in[6]; p.b_ada = in[7]; p.w_in = in[8];
    p.qn_a = in[9]; p.kn_a = in[10]; p.rpb_a = in[11]; p.qn_b = in[12]; p.kn_b = in[13]; p.lam_q1 = in[14]; p.lam_k1 = in[15]; p.lam_q2 = in[16]; p.lam_k2 = in[17];
    p.subln_b = in[18]; p.w_a2_f = in[19]; p.b_a_f = in[20]; p.w_a2_b = in[21]; p.b_a_b = in[22]; p.onorm_c = in[23]; p.w_out = in[24]; p.w_g = in[25]; p.w_u = in[26];
    p.conv_w = in[27]; p.conv_b = in[28]; p.w_d = in[29];
    unsigned char* ws = (unsigned char*)d_ws;
    p.out = (float*)d_out; p.ws = ws;
    p.MOD = (float*)(ws + WS_MOD); p.ROPE = (float*)(ws + WS_ROPE); p.HC = (float*)(ws + WS_HC); p.XN = (bf16*)(ws + WS_XN); p.AFB = (bf16*)(ws + WS_AFB);
    p.P = (bf16*)(ws + WS_R1); p.GU = (bf16*)(ws + WS_R1); p.GO = (float*)(ws + WS_GO); p.ALF = (float*)(ws + WS_ALF); p.ALB = (float*)(ws + WS_ALB); p.DT = (float*)(ws + WS_DT); p.US = (float*)(ws + WS_US); p.EA = (bf16*)(ws + WS_EA); p.EU = (bf16*)(ws + WS_EU); p.XN2 = (bf16*)(ws + WS_XN2); p.HB = (bf16*)(ws + WS_HB); p.SS1 = (float*)(ws + WS_SS1); p.SS2 = (float*)(ws + WS_SS2); p.B2IN = (float*)(ws + WS_B2IN); p.B2GU = (float*)(ws + WS_B2GU); p.AD = (float*)(ws + WS_AD); p.ACT = (bf16*)(ws + WS_R2);
    p.WIN_T = (bf16*)(ws + WS_WIN); p.WOUT_T = (bf16*)(ws + WS_WOUT); p.WGU_T = (bf16*)(ws + WS_WGU); p.WD_T = (bf16*)(ws + WS_WD);
#if MK_MULTI
    for (int ph = 0; ph < N_PHASES; ++ph) { a.ph_lo = ph; a.ph_hi = ph + 1; hipLaunchKernelGGL(mk_fwd, dim3(grid), dim3(NTHREADS), LDS_BYTES, stream, a); }
#else
    a.ph_lo = 0; a.ph_hi = N_PHASES;
    hipLaunchKernelGGL(mk_fwd, dim3(grid), dim3(NTHREADS), LDS_BYTES, stream, a);
#endif
    const hipError_t le = hipPeekAtLastError();
    if (le != hipSuccess) fprintf(stderr, "kernel_launch: launch failed: %s\n", hipGetErrorName(le));
}
```

```cpp
#include <hip/hip_runtime.h>
#include <cstdio>
#include <cstdint>
#include <cstring>
#include <cmath>
#define HD __device__ __attribute__((always_inline))
#define NAIVE_GLA_GATES 0
#ifdef HOST_TEST
constexpr int D = HT_D, BATCH = HT_B, SEQ = HT_S, CTX = HT_C;
#else
constexpr int D = 1024, BATCH = 8, SEQ = 4096, CTX = 256;
#endif
constexpr int DEPTH = 2, GRID_W = 64, ROWS = SEQ / GRID_W;
constexpr int NAH = D / 256, DAH = D / 256, GLH = D / 256;
constexpr int NA_W = NAH * 64, DQK_W = DAH * 64, DV_W = DAH * 64, GK_W = GLH * 64, GV_W = GLH * 128;
constexpr int FFN = ((8 * D) / 3 + 127) / 128 * 128;
constexpr int IN_W = 3 * NA_W + 2 * DQK_W + DV_W + 2 * GK_W + 2 * GV_W + 32;
constexpr int PW = IN_W - 32;
constexpr int C_QA = 0, C_KA = NA_W, C_VA = 2 * NA_W, C_QB = 3 * NA_W, C_KB = C_QB + DQK_W, C_VB = C_KB + DQK_W;
constexpr int C_QC = C_VB + DV_W, C_KC = C_QC + GK_W, C_VC = C_KC + GK_W, C_GC = C_VC + GV_W;
constexpr int ML = BATCH * SEQ, MC = BATCH * CTX, M = ML + MC;
constexpr int MO_A = 0, MO_B = NA_W, MO_C = NA_W + DV_W;
constexpr int NT_F = FFN / 128;
constexpr int NT_H0 = (NT_F + 1) / 2;
constexpr int GUP = 256 * NT_H0;
constexpr float EPS = 1e-6f, LOG2E = 1.4426950408889634f;

#define UNR _Pragma("unroll")
typedef unsigned short bf16;
HD inline float bf2f(bf16 v) { unsigned u = (unsigned)v << 16; float f; __builtin_memcpy(&f, &u, 4); return f; }
HD inline bf16 f2bf(float f) { unsigned u; __builtin_memcpy(&u, &f, 4); return (bf16)((u + 0x7fffu + ((u >> 16) & 1u)) >> 16); }

struct alignas(16) U4 { unsigned x, y, z, w; };
HD inline void ld8(const bf16* p, float* o) {
    const U4 v = *(const U4*)p;
    unsigned u;
    u = v.x << 16; __builtin_memcpy(&o[0], &u, 4); u = v.x & 0xffff0000u; __builtin_memcpy(&o[1], &u, 4);
    u = v.y << 16; __builtin_memcpy(&o[2], &u, 4); u = v.y & 0xffff0000u; __builtin_memcpy(&o[3], &u, 4);
    u = v.z << 16; __builtin_memcpy(&o[4], &u, 4); u = v.z & 0xffff0000u; __builtin_memcpy(&o[5], &u, 4);
    u = v.w << 16; __builtin_memcpy(&o[6], &u, 4); u = v.w & 0xffff0000u; __builtin_memcpy(&o[7], &u, 4);
}
struct Params {
    const float *x, *c, *ctx, *c_ctx, *norm1, *norm2, *w_ada, *b_ada, *w_in, *qn_a, *kn_a, *rpb_a, *qn_b, *kn_b;
    const float *lam_q1, *lam_k1, *lam_q2, *lam_k2, *subln_b, *w_a2_f, *b_a_f, *w_a2_b, *b_a_b, *onorm_c, *w_out, *w_g, *w_u, *conv_w, *conv_b, *w_d;
    float* out;
    unsigned char* ws;
    float* MOD;
    float* ROPE;
    float* HC;
    bf16* XN;
    bf16* AFB;
    bf16* P;
    bf16* GU;
    float* GO;
    float* ALF;
    float* ALB;
    float* DT;
    float* US;
    float* AD;
    bf16* EA;
    bf16* EU;
    bf16* HB;
    bf16* XN2;
    float* SS1; float* SS2;
    float* B2IN; float* B2GU;
    bf16* ACT;
    bf16 *WIN_T, *WOUT_T, *WGU_T, *WD_T;
};

HD inline float silu_f(float x) { return x / (1.0f + expf(-x)); }
HD inline float logsigmoid_f(float x) { return fminf(x, 0.0f) - log1pf(expf(-fabsf(x))); }
HD inline int clampi(int v, int lo, int hi) { return v < lo ? lo : (v > hi ? hi : v); }
HD inline int row_batch_slot(int m) { return m < ML ? m / SEQ : BATCH; }
HD inline const float* mod_vec(const Params& p, int l, int m, int which) {
    const int j = m < ML ? m / SEQ : BATCH;
    return p.MOD + ((size_t)(l * (BATCH + 1) + j) * 6 + which) * D;
}
HD inline float* hrow(const Params& p, int m) { return m < ML ? p.out + (size_t)m * D : p.HC + (size_t)(m - ML) * D; }
HD inline const float* xrow(const Params& p, int m) { return m < ML ? p.x + (size_t)m * D : p.ctx + (size_t)(m - ML) * D; }

HD inline void ph_mod(const Params& p, long gtid, long gsize) {
    const long N = (long)DEPTH * (BATCH + 1) * 6 * D;
    for (long i = gtid; i < N; i += gsize) {
        const int n = (int)(i % (6 * D)); const int j = (int)((i / (6 * D)) % (BATCH + 1)); const int l = (int)(i / ((long)6 * D * (BATCH + 1)));
        const float* cv = j < BATCH ? p.c + (size_t)j * D : p.c_ctx;
        const float* w = p.w_ada + (size_t)l * D * 6 * D + n;
        float acc = 0.f;
        for (int k = 0; k < D; ++k) acc += silu_f(cv[k]) * w[(size_t)k * 6 * D];
        p.MOD[i] = acc + p.b_ada[(size_t)l * 6 * D + n];
    }
    for (long i = gtid; i < 64 * 8; i += gsize) {
        const int pos = (int)(i / 8), f = (int)(i % 8);
        const float inv = expf(-((float)f / 8.0f) * logf(10000.0f));
        const float ang = (float)pos * inv;
        p.ROPE[2 * i] = cosf(ang); p.ROPE[2 * i + 1] = sinf(ang);
    }
}

HD inline void ph_norm_naive(const Params& p, int l, int which, bool from_input, int mrows, long gtid, long gsize) {
    for (long m = gtid; m < mrows; m += gsize) {
        const float* h = from_input ? xrow(p, (int)m) : hrow(p, (int)m);
        const float* g = (which ? p.norm2 : p.norm1) + (size_t)l * D;
        const float* sh = mod_vec(p, l, (int)m, which ? 3 : 0); const float* sc = mod_vec(p, l, (int)m, which ? 4 : 1);
        float ss = 0.f; for (int k = 0; k < D; ++k) ss += h[k] * h[k];
        const float rstd = 1.0f / sqrtf(ss / D + EPS);
        bf16* o = p.XN + (size_t)m * D;
        for (int k = 0; k < D; ++k) o[k] = f2bf((h[k] * rstd * g[k]) * (1.0f + sc[k]) + sh[k]);
    }
}

#ifndef NAIVE_GLA_GATES
#define NAIVE_GLA_GATES 1
#endif
constexpr int POST_ITEMS = 2 * NAH + 4 * DAH + GLH + (NAIVE_GLA_GATES ? 2 * GLH : 0);
HD inline void ph_post_naive(const Params& p, int l, long gtid, long gsize) {
    const long N = (long)M * POST_ITEMS;
    for (long i = gtid; i < N; i += gsize) {
        const int m = (int)(i / POST_ITEMS); int it = (int)(i % POST_ITEMS);
        bf16* pr = p.P + (size_t)m * PW;
        if (it < 2 * NAH) {
            const bool isq = it < NAH; const int h = isq ? it : it - NAH;
            bf16* v = pr + (isq ? C_QA : C_KA) + h * 64; const float* g = (isq ? p.qn_a : p.kn_a) + l * 64;
            float x[64], ss = 0.f; UNR for (int d = 0; d < 64; ++d) { x[d] = bf2f(v[d]); ss += x[d] * x[d]; }
            const float r = 1.0f / sqrtf(ss / 64 + EPS) * (isq ? 0.125f * LOG2E : 1.0f);
            UNR for (int d = 0; d < 64; ++d) v[d] = f2bf(x[d] * r * g[d]);
            continue;
        }
        it -= 2 * NAH;
        if (it < 4 * DAH) {
            const bool isq = it < 2 * DAH; const int hc = isq ? it : it - 2 * DAH;
            bf16* v = pr + (isq ? C_QB : C_KB) + hc * 32; const float* g = (isq ? p.qn_b : p.kn_b) + l * 32;
            float x[32], ss = 0.f; UNR for (int d = 0; d < 32; ++d) { x[d] = bf2f(v[d]); ss += x[d] * x[d]; }
            const float r = 1.0f / sqrtf(ss / 32 + EPS);
            UNR for (int d = 0; d < 32; ++d) x[d] = x[d] * r * g[d];
            if (m < ML) {
                const int t = m % SEQ, row = t / GRID_W, col = t % GRID_W;
                UNR for (int f = 0; f < 8; ++f) {
                    const float cr = p.ROPE[(row * 8 + f) * 2], sr = p.ROPE[(row * 8 + f) * 2 + 1];
                    const float a = x[f], b = x[f + 8]; x[f] = a * cr - b * sr; x[f + 8] = b * cr + a * sr;
                    const float cc = p.ROPE[(col * 8 + f) * 2], sn = p.ROPE[(col * 8 + f) * 2 + 1];
                    const float a2 = x[16 + f], b2 = x[24 + f]; x[16 + f] = a2 * cc - b2 * sn; x[24 + f] = b2 * cc + a2 * sn;
                }
            }
            const float s = isq ? 0.17677669529663687f * LOG2E : 1.0f;
            UNR for (int d = 0; d < 32; ++d) v[d] = f2bf(x[d] * s);
            continue;
        }
        it -= 4 * DAH;
        if (it < GLH) {
            bf16* v = pr + C_QC + it * 64;
            UNR for (int d = 0; d < 64; ++d) v[d] = f2bf(bf2f(v[d]) * 0.125f);
            continue;
        }
        it -= GLH;
        {
            const int dir = it / GLH, h = it % GLH;
            const bf16* a = p.AFB + (size_t)m * 32 + dir * 16;
            const float* w2 = (dir ? p.w_a2_b : p.w_a2_f) + (size_t)l * 16 * GK_W + h * 64;
            const float* bb = (dir ? p.b_a_b : p.b_a_f) + (size_t)l * GK_W + h * 64;
            float* o = (dir ? p.ALB : p.ALF) + (size_t)m * GK_W + h * 64;
            float av[16]; UNR for (int r = 0; r < 16; ++r) av[r] = bf2f(a[r]);
            UNR for (int d = 0; d < 64; ++d) {
                float xx = bb[d]; UNR for (int r = 0; r < 16; ++r) xx += av[r] * w2[(size_t)r * GK_W + d];
                o[d] = expf(logsigmoid_f(xx) * (1.0f / 16.0f));
            }
        }
    }
}

HD inline void ph_na_naive(const Params& p, int l, bool with_ctx, long gtid, long gsize) {
    const int mq = with_ctx ? M : ML; const long N = (long)NAH * mq;
    for (long i = gtid; i < N; i += gsize) {
        const int m = (int)(i % mq), h = (int)(i / mq);
        float q[64], o[64]; const bf16* qp = p.P + (size_t)m * PW + C_QA + h * 64;
        UNR for (int d = 0; d < 64; ++d) { q[d] = bf2f(qp[d]); o[d] = 0.f; }
        float mx = -1e30f, ls = 0.f;
        const int b = m < ML ? m / SEQ : (m - ML) / CTX;
        if (m < ML) {
            const int t = m % SEQ, r = t / GRID_W, w = t % GRID_W;
            const int r0 = clampi(r - 4, 0, ROWS - 8), c0 = clampi(w - 8, 0, GRID_W - 16);
            const float* rpb = p.rpb_a + ((size_t)l * NAH + h) * 15 * 31;
            for (int kk = 0; kk < 128; ++kk) {
                const int kr = r0 + (kk >> 4), kc = c0 + (kk & 15); const int km = b * SEQ + kr * GRID_W + kc;
                const bf16* kp = p.P + (size_t)km * PW + C_KA + h * 64; const bf16* vp = p.P + (size_t)km * PW + C_VA + h * 64;
                float s = 0.f; UNR for (int d8 = 0; d8 < 8; ++d8) { float t[8]; ld8(kp + 8 * d8, t); UNR for (int e = 0; e < 8; ++e) s += q[8 * d8 + e] * t[e]; }
                s += rpb[(kr - r + 7) * 31 + (kc - w + 15)] * LOG2E;
                const float mn = fmaxf(mx, s), al = exp2f(mx - mn), pe = exp2f(s - mn);
                ls = ls * al + pe; UNR for (int d8 = 0; d8 < 8; ++d8) { float t[8]; ld8(vp + 8 * d8, t); UNR for (int e = 0; e < 8; ++e) o[8 * d8 + e] = o[8 * d8 + e] * al + pe * t[e]; } mx = mn;
            }
        }
        for (int j = 0; j < CTX; ++j) {
            const int km = ML + b * CTX + j;
            const bf16* kp = p.P + (size_t)km * PW + C_KA + h * 64; const bf16* vp = p.P + (size_t)km * PW + C_VA + h * 64;
            float s = 0.f; UNR for (int d8 = 0; d8 < 8; ++d8) { float t[8]; ld8(kp + 8 * d8, t); UNR for (int e = 0; e < 8; ++e) s += q[8 * d8 + e] * t[e]; }
            const float mn = fmaxf(mx, s), al = exp2f(mx - mn), pe = exp2f(s - mn);
            ls = ls * al + pe; UNR for (int d8 = 0; d8 < 8; ++d8) { float t[8]; ld8(vp + 8 * d8, t); UNR for (int e = 0; e < 8; ++e) o[8 * d8 + e] = o[8 * d8 + e] * al + pe * t[e]; } mx = mn;
        }
        bf16* op = p.XN + (size_t)m * D + MO_A + h * 64; const float il = 1.0f / ls;
        UNR for (int d = 0; d < 64; ++d) op[d] = f2bf(o[d] * il);
    }
}

HD inline float lam_of(const Params& p, int l, float lam_init) {
    float s1 = 0.f, s2 = 0.f;
    for (int i = 0; i < 32; ++i) { s1 += p.lam_q1[l * 32 + i] * p.lam_k1[l * 32 + i]; s2 += p.lam_q2[l * 32 + i] * p.lam_k2[l * 32 + i]; }
    return expf(s1) - expf(s2) + lam_init;
}
HD inline float lam_init_of(int l) { return 0.8f - 0.6f * expf(-0.3f * (float)l); }

HD inline void ph_diff_naive(const Params& p, int l, bool with_ctx, long gtid, long gsize) {
    const int mq = with_ctx ? M : ML; const long N = (long)DAH * mq;
    const float lam_init = lam_init_of(l), lam = lam_of(p, l, lam_init);
    for (long i = gtid; i < N; i += gsize) {
        const int m = (int)(i % mq), h = (int)(i / mq);
        const int b = m < ML ? m / SEQ : (m - ML) / CTX;
        float* dt = p.DT + (size_t)m * DV_W + h * 64;
        float o[64];
        for (int c = 0; c < 2; ++c) {
            float q[32]; const bf16* qp = p.P + (size_t)m * PW + C_QB + h * 64 + c * 32;
            UNR for (int d = 0; d < 32; ++d) q[d] = bf2f(qp[d]);
            UNR for (int d = 0; d < 64; ++d) o[d] = 0.f;
            float mx = -1e30f, ls = 0.f;
            const int nk = (m < ML ? SEQ : 0) + CTX;
            for (int kk = 0; kk < nk; ++kk) {
                const int km = (m < ML) ? (kk < SEQ ? b * SEQ + kk : ML + b * CTX + (kk - SEQ)) : ML + b * CTX + kk;
                const bf16* kp = p.P + (size_t)km * PW + C_KB + h * 64 + c * 32; const bf16* vp = p.P + (size_t)km * PW + C_VB + h * 64;
                float s = 0.f; UNR for (int d8 = 0; d8 < 4; ++d8) { float t[8]; ld8(kp + 8 * d8, t); UNR for (int e = 0; e < 8; ++e) s += q[8 * d8 + e] * t[e]; }
                const float mn = fmaxf(mx, s), al = exp2f(mx - mn), pe = exp2f(s - mn);
                ls = ls * al + pe; UNR for (int d8 = 0; d8 < 8; ++d8) { float t[8]; ld8(vp + 8 * d8, t); UNR for (int e = 0; e < 8; ++e) o[8 * d8 + e] = o[8 * d8 + e] * al + pe * t[e]; } mx = mn;
            }
            const float il = 1.0f / ls;
            if (c == 0) { UNR for (int d = 0; d < 64; ++d) dt[d] = o[d] * il; }
            else { UNR for (int d = 0; d < 64; ++d) o[d] = dt[d] - lam * (o[d] * il); }
        }
        float* res = o;
        float ss = 0.f; UNR for (int d = 0; d < 64; ++d) ss += res[d] * res[d];
        const float r = 1.0f / sqrtf(ss / 64 + EPS) * (1.0f - lam_init);
        bf16* op = p.XN + (size_t)m * D + MO_B + h * 64;
        UNR for (int d = 0; d < 64; ++d) op[d] = f2bf(res[d] * r * p.subln_b[l * 64 + d]);
    }
}

HD inline void ph_gla_naive(const Params& p, long gtid, long gsize) {
    const long N = (long)BATCH * GLH * 128;
    for (long i = gtid; i < N; i += gsize) {
        const int v = (int)(i % 128), h = (int)((i / 128) % GLH), b = (int)(i / (128 * GLH));
        for (int dir = 0; dir < 2; ++dir) {
            float S[64]; UNR for (int d = 0; d < 64; ++d) S[d] = 0.f;
            const float* AL = dir ? p.ALB : p.ALF;
            for (int s = 0; s < CTX + SEQ; ++s) {
                int m;
                if (s < CTX) m = ML + b * CTX + (dir ? CTX - 1 - s : s);
                else m = b * SEQ + (dir ? SEQ - 1 - (s - CTX) : (s - CTX));
                const bf16* pr = p.P + (size_t)m * PW; const float* al = AL + (size_t)m * GK_W + h * 64;
                const float vv = bf2f(pr[C_VC + h * 128 + v]);
                float o = 0.f;
                UNR for (int d8 = 0; d8 < 8; ++d8) { float tk[8], tq[8]; ld8(pr + C_KC + h * 64 + 8 * d8, tk); ld8(pr + C_QC + h * 64 + 8 * d8, tq);
                    UNR for (int e = 0; e < 8; ++e) { const int d = 8 * d8 + e; S[d] = al[d] * S[d] + tk[e] * vv; o += tq[e] * S[d]; } }
                float* go = p.GO + (size_t)m * GV_W + h * 128 + v;
                if (dir == 0) *go = o; else *go += o;
            }
        }
    }
}
HD inline void ph_gla_out_naive(const Params& p, int l, bool with_ctx, long gtid, long gsize) {
    const int mq = with_ctx ? M : ML; const long N = (long)GLH * mq;
    for (long i = gtid; i < N; i += gsize) {
        const int m = (int)(i % mq), h = (int)(i / mq);
        const float* go = p.GO + (size_t)m * GV_W + h * 128; const bf16* gc = p.P + (size_t)m * PW + C_GC + h * 128;
        float ss = 0.f; for (int v = 0; v < 128; ++v) ss += go[v] * go[v];
        const float r = 1.0f / sqrtf(ss / 128 + EPS);
        bf16* op = p.XN + (size_t)m * D + MO_C + h * 128;
        for (int v = 0; v < 128; ++v) op[v] = f2bf(go[v] * r * p.onorm_c[l * 128 + v] * silu_f(bf2f(gc[v])));
    }
}

HD inline void ph_act_naive(const Params& p, int l, int half, int mrows, long gtid, long gsize) {
    const int t0 = half ? NT_H0 : 0, nt = half ? NT_F - NT_H0 : NT_H0; const int nf = nt * 128;
    const long N = (long)mrows * nf;
    for (long i = gtid; i < N; i += gsize) {
        const int m = (int)(i / nf), fl = (int)(i % nf); const int j = fl / 128, ii = fl % 128; const int f = (t0 + j) * 128 + ii;
        int pos, len; if (m < ML) { pos = m % SEQ; len = SEQ; } else { pos = (m - ML) % CTX; len = CTX; }
        const bf16* g = p.GU + (size_t)m * GUP + j * 256 + ii;
        const float* cw = p.conv_w + (size_t)l * 3 * FFN;
        float a = p.conv_b[(size_t)l * FFN + f] + cw[FFN + f] * bf2f(g[0]);
        if (pos > 0) a += cw[f] * bf2f(g[-(long)GUP]);
        if (pos < len - 1) a += cw[2 * FFN + f] * bf2f(g[GUP]);
        p.ACT[(size_t)m * FFN + f] = f2bf(silu_f(a) * bf2f(g[128]));
    }
}
namespace pg8 {
#define PG8_LAS __attribute__((address_space(3)))
typedef unsigned short bf16_t;
typedef short bf16x8 __attribute__((ext_vector_type(8)));
typedef float f32x4 __attribute__((ext_vector_type(4)));
typedef unsigned u32x4 __attribute__((ext_vector_type(4)));
constexpr int BM = 256, BK = 64, HALF = 128, HTB = HALF * BK * 2  , STAGE_BYTES = 8 * HTB, NXCD = 8, WGM = 8;

__host__ __device__ __forceinline__ int lds_byte(int r, int c) { const int st = (r >> 4) * 2 + (c >> 5), rr = r & 15, cc = c & 31, ob = rr * 64 + cc * 2; return st * 1024 + (ob ^ (((ob >> 9) & 1) << 5)); }
__host__ __device__ __forceinline__ void stage_rc(int b, int& R, int& C) { const int st = b / 1024, sb = b % 1024, swz = sb ^ (((sb >> 9) & 1) << 5); R = (st >> 1) * 16 + swz / 64; C = (st & 1) * 32 + (swz % 64) / 2; }
__host__ __device__ __forceinline__ int perm32(int rho) { const int n = rho >> 4, i = rho & 15; return 8 * (i >> 2) + 4 * n + (i & 3); }

struct Unit { int pm, pn; int k0, nk, sp, ti; };
struct Gemm { const bf16_t* A; const bf16_t* Bt; int M, N, K; };

struct StaticOrder {
    int nM, nN, nwg, G, c;
    __host__ __device__ void init(int M, int N, int G_, int c_) { nM = M / BM; nN = N / BM; nwg = nM * nN; G = G_; c = c_; }
    __host__ __device__ bool next(int i, Unit& u) const {
        const long L = (long)i * G + c; if (L >= nwg) return false;
        int wgid = (int)L; { const int q = nwg / NXCD, r = nwg % NXCD, xcd = wgid % NXCD, off = wgid / NXCD; wgid = (xcd < r ? xcd * (q + 1) : r * (q + 1) + (xcd - r) * q) + off; }
        const int nig = WGM * nN, gid = wgid / nig, fm = gid * WGM, gsz = (nM - fm) < WGM ? (nM - fm) : WGM;
        u.pm = fm + ((wgid % nig) % gsz); u.pn = (wgid % nig) / gsz; return true;
    }
    __device__ __forceinline__ void a_ready(const Unit&) const {}
    __device__ __forceinline__ void done(const Unit&) const {}
    static constexpr bool SPLITK = false;
};
template <int NS_> struct SplitTailOrder {
    static constexpr bool SPLITK = true; static constexpr int NS = NS_;
    StaticOrder so; int nfull, ntail, nkt; bool on; float* part; unsigned* cnt; volatile PG8_LAS unsigned* flag;
    __device__ void init(int M, int N, int K, int G_, int c_, float* part_, unsigned* cnt_, volatile PG8_LAS unsigned* flag_) {
        so.init(M, N, G_, c_); nkt = K / BK; ntail = so.nwg % G_; nfull = so.nwg - ntail; part = part_; cnt = cnt_; flag = flag_;
        on = ntail > 0 && ntail * NS <= G_ && (nkt / 2) >= NS; }
    __device__ bool next(int i, Unit& u) const {
        const long L = (long)i * so.G + so.c; u.k0 = 0; u.nk = nkt; u.sp = -1; u.ti = 0;
        if (!on || L < nfull) return so.next(i, u);
        const int j = (int)(L - nfull); if (j >= ntail * NS) return false;
        const int tix = j % ntail, s = j / ntail; StaticOrder t = so; t.c = 0; t.G = 1; (void)t.next(nfull + tix, u);
        const int pairs = nkt / 2, base = pairs / NS, rem = pairs % NS;
        u.k0 = 2 * (s * base + (s < rem ? s : rem)); u.nk = 2 * (base + (s < rem ? 1 : 0)); u.sp = s; u.ti = tix; return true;
    }
    __device__ __forceinline__ void a_ready(const Unit&) const {}
    __device__ __forceinline__ void done(const Unit&) const {}
};

__device__ __forceinline__ unsigned cvt_pk_bf16(float lo, float hi) { unsigned r; asm volatile("v_cvt_pk_bf16_f32 %0, %1, %2" : "=v"(r) : "v"(lo), "v"(hi)); return r; }
struct NoPre {};
template <class T, class = void> struct PreOf { typedef NoPre type;
    template <class U> static __device__ __forceinline__ NoPre get(const T&, const U&, int, int, int, int) { return NoPre{}; }
    template <class A, class U> static __device__ __forceinline__ void call(const T& E, A& acc, const U& u, int wr, int wc, int fr, int fq, const NoPre&) { E(acc, u, wr, wc, fr, fq); } };
template <class T> struct PreOf<T, decltype((void)sizeof(typename T::Pre))> { typedef typename T::Pre type;
    template <class U> static __device__ __forceinline__ type get(const T& E, const U& u, int wr, int wc, int fr, int fq) { return E.pre(u, wr, wc, fr, fq); }
    template <class A, class U> static __device__ __forceinline__ void call(const T& E, A& acc, const U& u, int wr, int wc, int fr, int fq, const type& p) { E(acc, u, wr, wc, fr, fq, p); } };
template <class Epi, class Sched, bool ALIGN_EPI = false, bool SP2 = false>
__device__ __forceinline__ void gemm_phase(PG8_LAS unsigned char* lds, const Gemm g, const Sched& S, const Epi& E) {
    const int tid = threadIdx.x, wid = __builtin_amdgcn_readfirstlane(tid >> 6), lane = tid & 63, wr = wid >> 2, wc = wid & 3, fr = lane & 15, fq = lane >> 4;
    const int K = g.K, nt = K / BK;
    unsigned voffA[2], voffB[2];
#pragma unroll
    for (int i = 0; i < 2; ++i) { int R, C; stage_rc(tid * 16 + i * 8192, R, C); const int Rb = Epi::PERM ? ((R & ~31) + perm32(R & 31)) : R;
        voffA[i] = (unsigned)(R * K + C) * 2u; voffB[i] = (unsigned)(Rb * K + C) * 2u; }
    const size_t kstep = (size_t)(BK * 2);
    const size_t hstep = (size_t)HALF * K * 2;
    const size_t tstep = 2 * hstep;
    const unsigned ldsw = (unsigned)wid * 1024u;
    const int aoff = lds_byte(wr * 64 + fr, fq * 8), boff = lds_byte(wc * 32 + fr, fq * 8);
#define PG8_SA(b, h) (((b) * 2 + (h)) * HTB)
#define PG8_SB(b, h) ((4 + (b) * 2 + (h)) * HTB)
#define PG8_STAGE(bufoff, gbase, voff) do { _Pragma("unroll") for (int _i = 0; _i < 2; ++_i) \
        __builtin_amdgcn_global_load_lds((const unsigned*)((const char*)(gbase) + (voff)[_i]), (PG8_LAS unsigned*)(lds + (bufoff) + ldsw + _i * 8192), 16, 0, 0); } while (0)
#define PG8_LDA(dst, b, h) do { _Pragma("unroll") for (int m = 0; m < 4; ++m) _Pragma("unroll") for (int k = 0; k < 2; ++k) dst[m][k] = *(const PG8_LAS bf16x8*)(lds + PG8_SA(b, h) + aoff + m * 2048 + k * 1024); } while (0)
#define PG8_LDB(dst, b, h) do { _Pragma("unroll") for (int n = 0; n < 2; ++n) _Pragma("unroll") for (int k = 0; k < 2; ++k) dst[n][k] = *(const PG8_LAS bf16x8*)(lds + PG8_SB(b, h) + boff + n * 2048 + k * 1024); } while (0)
#define PG8_MMA(ai, bj, At, Bt) do { __builtin_amdgcn_s_setprio(1); _Pragma("unroll") for (int m = 0; m < 4; ++m) _Pragma("unroll") for (int n = 0; n < 2; ++n) _Pragma("unroll") for (int k = 0; k < 2; ++k) \
        acc[ai][bj][m][n] = __builtin_amdgcn_mfma_f32_16x16x32_bf16(Bt[n][k], At[m][k], acc[ai][bj][m][n], 0, 0, 0); __builtin_amdgcn_s_setprio(0); } while (0)
#define PG8_WAIT_V(n) asm volatile("s_waitcnt vmcnt(" #n ")" ::: "memory")
#define PG8_WAIT_L(n) asm volatile("s_waitcnt lgkmcnt(" #n ")" ::: "memory")
#define PG8_BAR __builtin_amdgcn_s_barrier()
#define PG8_SCHED __builtin_amdgcn_sched_barrier(0)
    Unit cur, nxt; int ui = 0;
    if (!S.next(0, cur)) return;
    f32x4 acc[2][2][4][2];
#pragma unroll
    for (int a = 0; a < 2; ++a)
#pragma unroll
        for (int b = 0; b < 2; ++b)
#pragma unroll
            for (int m = 0; m < 4; ++m)
#pragma unroll
                for (int n = 0; n < 2; ++n) acc[a][b][m][n] = (f32x4){0.f, 0.f, 0.f, 0.f};
    bf16x8 At[4][2], B0[2][2], B1[2][2];
    const char* cA = (const char*)g.A + (size_t)cur.pm * tstep; const char* cB = (const char*)g.Bt + (size_t)cur.pn * tstep;
    if constexpr (Sched::SPLITK) { cA += (size_t)cur.k0 * kstep; cB += (size_t)cur.k0 * kstep; }
    S.a_ready(cur);
    if constexpr (SP2) {
        PG8_STAGE(PG8_SB(0, 0), cB, voffB); PG8_STAGE(PG8_SB(0, 1), cB + hstep, voffB); PG8_STAGE(PG8_SA(0, 0), cA, voffA); PG8_STAGE(PG8_SA(0, 1), cA + hstep, voffA);
        if (wr == 1) PG8_BAR;
        PG8_WAIT_V(2); PG8_BAR;
        PG8_STAGE(PG8_SB(1, 0), cB + kstep, voffB); PG8_STAGE(PG8_SA(1, 0), cA + kstep, voffA); PG8_STAGE(PG8_SB(1, 1), cB + hstep + kstep, voffB);
        PG8_WAIT_V(6); PG8_BAR;
    } else {
        PG8_STAGE(PG8_SB(0, 0), cB, voffB); PG8_STAGE(PG8_SA(0, 0), cA, voffA); PG8_STAGE(PG8_SB(0, 1), cB + hstep, voffB); PG8_STAGE(PG8_SA(0, 1), cA + hstep, voffA);
        if (wr == 1) PG8_BAR;
        PG8_WAIT_V(4); PG8_BAR;
        PG8_STAGE(PG8_SB(1, 0), cB + kstep, voffB); PG8_STAGE(PG8_SA(1, 0), cA + kstep, voffA); PG8_STAGE(PG8_SB(1, 1), cB + hstep + kstep, voffB);
        PG8_WAIT_V(6); PG8_BAR;
    }
    for (;;) {
        const bool has_next = S.next(ui + 1, nxt);
        const char* nA = has_next ? (const char*)g.A + (size_t)nxt.pm * tstep : cA; const char* nB = has_next ? (const char*)g.Bt + (size_t)nxt.pn * tstep : cB;
        if constexpr (Sched::SPLITK) { if (has_next) { nA += (size_t)nxt.k0 * kstep; nB += (size_t)nxt.k0 * kstep; } }
        const int unt = Sched::SPLITK ? cur.nk : nt;
        for (int t = 0; t < unt; t += 2) {
            const bool last = (t == unt - 2);
            const char* a1 = cA + (size_t)(t + 1) * kstep;
            const char* a2 = last ? nA : cA + (size_t)(t + 2) * kstep; const char* b2 = last ? nB : cB + (size_t)(t + 2) * kstep;
            const char* a3 = a2 + kstep; const char* b3 = b2 + kstep;
            if (last && has_next) S.a_ready(nxt);
            if constexpr (SP2) {
            PG8_LDB(B0, 0, 0); PG8_LDB(B1, 0, 1); PG8_SCHED; PG8_LDA(At, 0, 0); PG8_STAGE(PG8_SA(1, 1), a1 + hstep, voffA);
            PG8_WAIT_V(8); PG8_WAIT_L(0); PG8_BAR; PG8_MMA(0, 0, At, B0); PG8_MMA(0, 1, At, B1); PG8_BAR; PG8_SCHED;
            PG8_LDA(At, 0, 1); PG8_STAGE(PG8_SB(0, 0), b2, voffB); PG8_STAGE(PG8_SB(0, 1), b2 + hstep, voffB); PG8_STAGE(PG8_SA(0, 0), a2, voffA);
            PG8_WAIT_V(8); PG8_WAIT_L(0); PG8_BAR; PG8_MMA(1, 0, At, B0); PG8_MMA(1, 1, At, B1); PG8_BAR; PG8_SCHED;
            PG8_LDB(B0, 1, 0); PG8_LDB(B1, 1, 1); PG8_SCHED; PG8_LDA(At, 1, 0); PG8_STAGE(PG8_SA(0, 1), a2 + hstep, voffA);
            PG8_WAIT_V(8); PG8_WAIT_L(0); PG8_BAR; PG8_MMA(0, 0, At, B0); PG8_MMA(0, 1, At, B1); PG8_BAR; PG8_SCHED;
            PG8_LDA(At, 1, 1); PG8_STAGE(PG8_SB(1, 0), b3, voffB); PG8_STAGE(PG8_SB(1, 1), b3 + hstep, voffB); PG8_STAGE(PG8_SA(1, 0), a3, voffA);
            PG8_WAIT_V(8); PG8_WAIT_L(0); PG8_BAR; PG8_MMA(1, 0, At, B0); PG8_MMA(1, 1, At, B1); PG8_BAR; PG8_SCHED;
            } else {
            PG8_LDB(B0, 0, 0); PG8_SCHED; PG8_LDA(At, 0, 0); PG8_STAGE(PG8_SA(1, 1), a1 + hstep, voffA);
            PG8_WAIT_L(8); PG8_BAR; PG8_WAIT_L(0); PG8_MMA(0, 0, At, B0); PG8_BAR; PG8_SCHED;
            PG8_LDB(B1, 0, 1); PG8_STAGE(PG8_SB(0, 0), b2, voffB);
            PG8_BAR; PG8_WAIT_L(0); PG8_MMA(0, 1, At, B1); PG8_BAR;
            PG8_LDA(At, 0, 1); PG8_STAGE(PG8_SA(0, 0), a2, voffA);
            PG8_BAR; PG8_WAIT_L(0); PG8_MMA(1, 0, At, B0); PG8_BAR; PG8_SCHED;
            PG8_STAGE(PG8_SB(0, 1), b2 + hstep, voffB);
            PG8_WAIT_V(6); PG8_BAR; PG8_MMA(1, 1, At, B1); PG8_BAR;
            PG8_LDB(B0, 1, 0); PG8_SCHED; PG8_LDA(At, 1, 0); PG8_STAGE(PG8_SA(0, 1), a2 + hstep, voffA);
            PG8_WAIT_L(8); PG8_BAR; PG8_WAIT_L(0); PG8_MMA(0, 0, At, B0); PG8_BAR; PG8_SCHED;
            PG8_LDB(B1, 1, 1); PG8_STAGE(PG8_SB(1, 0), b3, voffB);
            PG8_BAR; PG8_WAIT_L(0); PG8_MMA(0, 1, At, B1); PG8_BAR;
            PG8_LDA(At, 1, 1); PG8_STAGE(PG8_SA(1, 0), a3, voffA);
            PG8_BAR; PG8_WAIT_L(0); PG8_MMA(1, 0, At, B0); PG8_BAR; PG8_SCHED;
            PG8_STAGE(PG8_SB(1, 1), b3 + hstep, voffB);
            PG8_WAIT_V(6); PG8_BAR; PG8_MMA(1, 1, At, B1); PG8_BAR;
            }
        }
        const typename PreOf<Epi>::type epre = PreOf<Epi>::get(E, cur, wr, wc, fr, fq);
        if constexpr (ALIGN_EPI) { if (wr == 0) PG8_BAR; }
        bool do_epi = true;
        if constexpr (Sched::SPLITK) { if (cur.sp >= 0) {
            static_assert(ALIGN_EPI && !Epi::AFTER_DRAIN, "split-K needs aligned register epilogues");
            const __amdgpu_buffer_rsrc_t prs = __builtin_amdgcn_make_buffer_rsrc(S.part, 0, (int)(64u * Sched::NS * 262144u), 0x00020000);
            const unsigned poff = ((unsigned)(cur.ti * Sched::NS + cur.sp) * 65536u + (unsigned)tid * 4u) * 4u;
#pragma unroll
            for (int a = 0; a < 2; ++a)
#pragma unroll
                for (int b = 0; b < 2; ++b)
#pragma unroll
                    for (int m = 0; m < 4; ++m)
#pragma unroll
                        for (int n = 0; n < 2; ++n) __builtin_amdgcn_raw_buffer_store_b128(__builtin_bit_cast(u32x4, acc[a][b][m][n]), prs, poff + (unsigned)((((a * 2 + b) * 4 + m) * 2 + n) * 8192), 0,   16);
            PG8_WAIT_V(0); PG8_BAR;
            if (tid == 0) {
                const unsigned old = __hip_atomic_fetch_add(S.cnt + cur.ti, 1u, __ATOMIC_RELAXED, __HIP_MEMORY_SCOPE_AGENT);
                if (old == (unsigned)(Sched::NS - 1)) { __builtin_amdgcn_fence(__ATOMIC_ACQUIRE, "agent"); PG8_WAIT_V(0); }
                *S.flag = old; PG8_WAIT_L(0); }
            PG8_BAR;
            do_epi = (*S.flag == (unsigned)(Sched::NS - 1));
            if (do_epi) {
                const float* qq = S.part + (size_t)(cur.ti * Sched::NS) * 65536 + tid * 4;
#pragma unroll
                for (int a = 0; a < 2; ++a)
#pragma unroll
                    for (int b = 0; b < 2; ++b)
#pragma unroll
                        for (int m = 0; m < 4; ++m)
#pragma unroll
                            for (int n = 0; n < 2; ++n) { const float* q1 = qq + (((a * 2 + b) * 4 + m) * 2 + n) * 2048; f32x4 sum = *(const f32x4*)q1;
#pragma unroll
                                for (int s = 1; s < Sched::NS; ++s) sum += *(const f32x4*)(q1 + (size_t)s * 65536);
                                acc[a][b][m][n] = sum; }
            }
        } }
        if constexpr (!Epi::AFTER_DRAIN) { if (do_epi) PreOf<Epi>::call(E, acc, cur, wr, wc, fr, fq, epre); S.done(cur); }
        if (!has_next) break;
#pragma unroll
        for (int a = 0; a < 2; ++a)
#pragma unroll
            for (int b = 0; b < 2; ++b)
#pragma unroll
                for (int m = 0; m < 4; ++m)
#pragma unroll
                    for (int n = 0; n < 2; ++n) acc[a][b][m][n] = (f32x4){0.f, 0.f, 0.f, 0.f};
        cur = nxt; cA = nA; cB = nB; ++ui;
        if constexpr (ALIGN_EPI) { if (wr == 1) PG8_BAR; }
    }
    PG8_WAIT_V(0);
    if constexpr (!ALIGN_EPI) { if (wr == 0) PG8_BAR; }
    PG8_BAR;
    if constexpr (Epi::AFTER_DRAIN) { E.fused(acc, cur, wr, wc, fr, fq, lds, wid, lane); S.done(cur); }
#undef PG8_SA
#undef PG8_SB
#undef PG8_STAGE
#undef PG8_LDA
#undef PG8_LDB
#undef PG8_MMA
#undef PG8_WAIT_V
#undef PG8_WAIT_L
#undef PG8_BAR
#undef PG8_SCHED
}
}

#ifndef PG8_SP2
#define PG8_SP2 true
#endif
#define GAS __attribute__((address_space(1)))
#define LAS __attribute__((address_space(3)))
typedef unsigned v4u __attribute__((ext_vector_type(4)));
typedef float f32x4 __attribute__((ext_vector_type(4)));
typedef short bf16x8 __attribute__((ext_vector_type(8)));
typedef GAS unsigned gu32;
typedef GAS unsigned long long gu64;
#define RLX_AGENT __ATOMIC_RELAXED, __HIP_MEMORY_SCOPE_AGENT
#define LDS_WAIT() asm volatile("s_waitcnt lgkmcnt(0)" ::: "memory")
#define VM_WAIT() asm volatile("s_waitcnt vmcnt(0)" ::: "memory")
__device__ __forceinline__ unsigned long long rt() { return __builtin_amdgcn_s_memrealtime(); }
__device__ __forceinline__ unsigned pk2(float lo, float hi) { return (unsigned)f2bf(lo) | ((unsigned)f2bf(hi) << 16); }
#define XB_TMO      128
#define XB_XCNT(j)  (256  + 64 * (j))
#define XB_XSUB(j)  (1280 + 64 * (j))
#define XB_XGEN(j)  (2304 + 64 * (j))
#define XB_TOP      3328
#define XB_TOPGEN   3392
#define XCD_BAR_WORDS 3456
#define XB_SPIN_CAP (1u << 18)

__device__ __forceinline__ unsigned xb_ld(unsigned* p)              { return __hip_atomic_load(p, __ATOMIC_RELAXED, __HIP_MEMORY_SCOPE_AGENT); }
__device__ __forceinline__ unsigned xb_add(unsigned* p, unsigned v) { return __hip_atomic_fetch_add(p, v, __ATOMIC_RELAXED, __HIP_MEMORY_SCOPE_AGENT); }
__device__ __forceinline__ unsigned xb_xcc_id() { return (unsigned)__builtin_amdgcn_s_getreg((3 << 11) | 20) & 0xFu; }
#define XB_SPIN(cond, bar) do { unsigned _sp = 0; while (cond) { __builtin_amdgcn_s_sleep(1); \
    if ((++_sp & 255u) == 0u) { if (xb_ld(&(bar)[XB_TMO])) break; if (_sp > XB_SPIN_CAP) { atomicAdd(&(bar)[XB_TMO], 1u); break; } } } } while (0)

struct XcdBarrier {
    unsigned* bar; unsigned x;
    volatile LAS unsigned* st;
};

__device__ __forceinline__ XcdBarrier xcd_barrier_post(unsigned* bar, volatile LAS unsigned* st) {
    XcdBarrier b; b.bar = bar; b.x = xb_xcc_id(); b.st = st;
    if (threadIdx.x == 0) (void)xb_add(&bar[XB_XCNT(b.x)], 1u);
    return b;
}
__device__ __forceinline__ void xcd_barrier_complete(unsigned* bar, unsigned x, unsigned& nloc, unsigned& nx) {
    const unsigned G = gridDim.x * gridDim.y * gridDim.z;
    unsigned sum, cnt, mine, sp = 0u;
    for (;;) {
        sum = 0u; cnt = 0u; mine = 0u;
#pragma unroll
        for (unsigned j = 0; j < 16; ++j) { const unsigned c = xb_ld(&bar[XB_XCNT(j)]); sum += c; cnt += (c > 0u) ? 1u : 0u; mine = (j == x) ? c : mine; }
        if (sum == G) break;
        __builtin_amdgcn_s_sleep(1);
        if ((++sp & 255u) == 0u) { if (xb_ld(&bar[XB_TMO])) break; if (sp > XB_SPIN_CAP) { atomicAdd(&bar[XB_TMO], 1u); break; } }
    }
    nloc = mine > 0u ? mine : 1u; nx = cnt > 0u ? cnt : 1u;
}

__device__ __forceinline__ void xcd_barrier(const XcdBarrier& b) {
    asm volatile("s_waitcnt vmcnt(0)" ::: "memory");
    __syncthreads();
    if (threadIdx.x == 0) {
        unsigned* bar = b.bar;
        __builtin_amdgcn_s_waitcnt(0);
        unsigned nloc = b.st[0], nx = b.st[1];
        if (nloc == 0u) { xcd_barrier_complete(bar, b.x, nloc, nx); b.st[0] = nloc; b.st[1] = nx; }
        const unsigned old = xb_add(&bar[XB_XSUB(b.x)], 1u);
        const unsigned gen = old / nloc;
        if (old + 1u == (gen + 1u) * nloc) {
            __builtin_amdgcn_fence(__ATOMIC_RELEASE, "agent");
            asm volatile("s_waitcnt vmcnt(0)" ::: "memory");
            const unsigned og = xb_add(&bar[XB_TOP], 1u);
            const unsigned tg = og / nx;
            if (og + 1u == (tg + 1u) * nx) xb_add(&bar[XB_TOPGEN], 1u);
            else XB_SPIN(xb_ld(&bar[XB_TOPGEN]) == tg, bar);
            __builtin_amdgcn_fence(__ATOMIC_ACQUIRE, "agent");
            xb_add(&bar[XB_XGEN(b.x)], 1u);
            asm volatile("s_waitcnt vmcnt(0)" ::: "memory");
        } else {
            XB_SPIN(xb_ld(&bar[XB_XGEN(b.x)]) == gen, bar);
            __builtin_amdgcn_fence(__ATOMIC_ACQUIRE, "agent");
            asm volatile("s_waitcnt vmcnt(0)" ::: "memory");
        }
    }
    __syncthreads();
}
#ifdef HOST_TEST
#define LASQ
#define MFMA32(a, b, c) emu_mfma_32x32x16((a), (b), (c))
#define TR16(p) emu_ds_read_tr16_b64((const void*)(p))
#define RFL(x) (x)
#define EXP2(x) exp2f(x)
#define LOG2(x) log2f(x)
#define DEVFN inline
#define LAUNDER(x)
#define SETPRIO(x)
#define ROR16(x, n) emu_ror16((x), (n))
#define SCHEDBAR()
#define __any(x) emu_any(x)
namespace pg8 { struct Unit { int pm, pn; }; constexpr int BM = 256, HALF = 128; }
static inline unsigned cvtpk(float lo, float hi) { return (unsigned)f2bf(lo) | ((unsigned)f2bf(hi) << 16); }
#else
#define LASQ __attribute__((address_space(3)))
#define MFMA32(a, b, c) __builtin_amdgcn_mfma_f32_32x32x16_bf16((a), (b), (c), 0, 0, 0)
typedef short v4i16_t __attribute__((ext_vector_type(4)));
typedef short s16x4 __attribute__((ext_vector_type(4)));
typedef float f32x16 __attribute__((ext_vector_type(16)));
typedef unsigned u32x2 __attribute__((ext_vector_type(2)));
typedef unsigned u32x4 __attribute__((ext_vector_type(4)));
#define TR16(p) __builtin_bit_cast(s16x4, __builtin_amdgcn_ds_read_tr16_b64_v4i16((LASQ v4i16_t*)(p)))
#define RFL(x) __builtin_amdgcn_readfirstlane(x)
#define EXP2(x) __builtin_amdgcn_exp2f(x)
#define LOG2(x) __builtin_amdgcn_logf(x)
#define DEVFN __device__ __forceinline__
#define LAUNDER(x) asm volatile("" : "+v"(x))
#define SETPRIO(x) __builtin_amdgcn_s_setprio(x)
#define ROR16(x, n) __builtin_bit_cast(float, __builtin_amdgcn_update_dpp(0, __builtin_bit_cast(int, (float)(x)), 0x120 + (n), 0xf, 0xf, false))
#define SCHEDBAR() __builtin_amdgcn_sched_barrier(0)
typedef float f32x2_t __attribute__((ext_vector_type(2))); typedef __bf16 bf16x2_t __attribute__((ext_vector_type(2)));
__device__ __forceinline__ unsigned cvtpk(float lo, float hi) { f32x2_t v = {lo, hi}; bf16x2_t b = __builtin_convertvector(v, bf16x2_t); return __builtin_bit_cast(unsigned, b); }
#endif
typedef LASQ unsigned char* ldsp_t;
#ifdef HOST_TEST
#define RCP(x) (1.0f / (x))
#define RSQ(x) (1.0f / sqrtf(x))
#else
#define RCP(x) __builtin_amdgcn_rcpf(x)
#define RSQ(x) __builtin_amdgcn_rsqf(x)
#endif
DEVFN float silu_fast(float x) { return x * RCP(1.0f + EXP2(-x * LOG2E)); }

DEVFN bf16x8 pack8(const f32x16& p, int b) {
    u32x4 w; w.x = cvtpk(p[b], p[b + 1]); w.y = cvtpk(p[b + 2], p[b + 3]); w.z = cvtpk(p[b + 4], p[b + 5]); w.w = cvtpk(p[b + 6], p[b + 7]);
    return __builtin_bit_cast(bf16x8, w);
}
DEVFN bf16x8 cat44(s16x4 a, s16x4 b) { return (bf16x8){a[0], a[1], a[2], a[3], b[0], b[1], b[2], b[3]}; }
DEVFN void unpack4(u32x2 w, float* o) { unsigned u; u = w.x << 16; __builtin_memcpy(&o[0], &u, 4); u = w.x & 0xffff0000u; __builtin_memcpy(&o[1], &u, 4); u = w.y << 16; __builtin_memcpy(&o[2], &u, 4); u = w.y & 0xffff0000u; __builtin_memcpy(&o[3], &u, 4); }
DEVFN float wave_sum64(float v) { UNR for (int o = 1; o < 64; o <<= 1) v += __shfl_xor(v, o); return v; }
DEVFN float max16(const f32x16& p) { float a = fmaxf(fmaxf(p[0], p[1]), fmaxf(p[2], p[3])), b = fmaxf(fmaxf(p[4], p[5]), fmaxf(p[6], p[7])), c = fmaxf(fmaxf(p[8], p[9]), fmaxf(p[10], p[11])), d = fmaxf(fmaxf(p[12], p[13]), fmaxf(p[14], p[15])); return fmaxf(fmaxf(a, b), fmaxf(c, d)); }
DEVFN float sum16(const f32x16& p) { return ((p[0] + p[1]) + (p[2] + p[3])) + ((p[4] + p[5]) + (p[6] + p[7])) + (((p[8] + p[9]) + (p[10] + p[11])) + ((p[12] + p[13]) + (p[14] + p[15]))); }

constexpr int AT_KP = 144, AT_VP = 192, AT_SUB = 64 * AT_KP + 64 * AT_VP;
#ifndef AT_THR_V
#define AT_THR_V 3.0f
#endif
#ifndef AT_BIG_V
#define AT_BIG_V 4096.0f
#endif
#ifndef AT_FORCE_SLOW
#define AT_FORCE_SLOW false
#endif
constexpr float AT_BIG = AT_BIG_V, AT_TINY = 1e-20f;
constexpr float AT_THR = AT_THR_V;

template <int MODE> DEVFN int attn_tile_row(int ub, bool uctxq, int ug4, int j) {
    if (uctxq) return ML + ub * CTX + 64 * j;
    if (MODE == 0) return j < SEQ / 64 ? ub * SEQ + 64 * j : ML + ub * CTX + 64 * (j - SEQ / 64);
    const int kr0 = clampi(ug4 - 4, 0, ROWS - 8), kr1 = clampi(ug4 + 3 - 4, 0, ROWS - 8) + 8, nwin = kr1 - kr0;
    return j < nwin ? ub * SEQ + (kr0 + j) * GRID_W : ML + ub * CTX + 64 * (j - nwin);
}
struct AU { int b, h, q0, ntiles, g4; bool ctxq; };
template <int MODE, int TPI> DEVFN void attn_unit(const Params& p, int l, int ub, int uh, int uq0, int untiles, bool uctxq, int ug4, ldsp_t lds, float lam, float lam_init) {
    constexpr int NC = MODE == 0 ? 2 : 1, KS = MODE == 0 ? 2 : 4;
    constexpr int CQ = MODE == 0 ? C_QB : C_QA, CK = MODE == 0 ? C_KB : C_KA, CV = MODE == 0 ? C_VB : C_VA, MO = MODE == 0 ? MO_B : MO_A;
    constexpr int SLOT = TPI * AT_SUB;
    int tid = threadIdx.x; LAUNDER(tid); const int lane = tid & 63, wid = RFL(tid >> 6), r32 = lane & 31, hh = lane >> 5;
    const int qrow = uq0 + wid * 32 + r32;
    bf16x8 qf[NC][KS];
    { const bf16* qp = p.P + (size_t)qrow * PW + CQ + uh * 64 + 8 * hh;
      UNR for (int c = 0; c < NC; ++c) UNR for (int ks = 0; ks < KS; ++ks) qf[c][ks] = *(const bf16x8*)(qp + c * 32 + 16 * ks); }
    int na_r = 0, na_w = 0, na_r0 = 0, na_c0 = 0, na_kr0 = 0, na_nwin = 0;
    if (MODE == 1 && !uctxq) { na_r = ug4 + (wid >> 1); na_w = 32 * (wid & 1) + r32; na_r0 = clampi(na_r - 4, 0, ROWS - 8); na_c0 = clampi(na_w - 8, 0, GRID_W - 16);
        na_kr0 = clampi(ug4 - 4, 0, ROWS - 8); na_nwin = clampi(ug4 + 3 - 4, 0, ROWS - 8) + 8 - na_kr0; }
    LASQ float* rpbl = (LASQ float*)(lds + 2 * SLOT);
    if (MODE == 1) { for (int i = tid; i < 15 * 31; i += 512) rpbl[i] = p.rpb_a[((size_t)l * NAH + uh) * 465 + i] * LOG2E; }
    float m_run[NC], l_run[NC]; f32x16 o[NC][2];
    UNR for (int c = 0; c < NC; ++c) { m_run[c] = 0.f; l_run[c] = 0.f; UNR for (int t = 0; t < 2; ++t) UNR for (int i = 0; i < 16; ++i) o[c][t][i] = 0.f; }
    bool first = true;
    const int srow = tid >> 3, spc = tid & 7;
    u32x4 kreg[TPI], vreg[TPI];
    const int nit = (untiles + TPI - 1) / TPI;
    UNR for (int s = 0; s < TPI; ++s) { const int jt = s < untiles ? s : untiles - 1; const bf16* g = p.P + (size_t)(attn_tile_row<MODE>(ub, uctxq, ug4, jt) + srow) * PW + uh * 64 + 8 * spc; kreg[s] = *(const u32x4*)(g + CK); vreg[s] = *(const u32x4*)(g + CV); }
    UNR for (int s = 0; s < TPI; ++s) { *(LASQ u32x4*)(lds + s * AT_SUB + srow * AT_KP + 16 * spc) = kreg[s]; *(LASQ u32x4*)(lds + s * AT_SUB + 64 * AT_KP + srow * AT_VP + 16 * spc) = vreg[s]; }
    __syncthreads();
    int cur = 0;
    for (int it = 0; it < nit; ++it) {
        const bool more = it + 1 < nit;
        UNR for (int s = 0; s < TPI; ++s) {
            if (more && s == TPI - 1) { UNR for (int s2 = 0; s2 < TPI; ++s2) { int jt = (it + 1) * TPI + s2; jt = jt < untiles ? jt : untiles - 1;
                const bf16* g = p.P + (size_t)(attn_tile_row<MODE>(ub, uctxq, ug4, jt) + srow) * PW + uh * 64 + 8 * spc; kreg[s2] = *(const u32x4*)(g + CK); vreg[s2] = *(const u32x4*)(g + CV); } }
            const int j = it * TPI + s;
            const ldsp_t kb = lds + cur * SLOT + s * AT_SUB, vb = kb + 64 * AT_KP;
            bool active = j < untiles; int kr = 0;
            if (MODE == 1 && !uctxq && j < na_nwin) { kr = na_kr0 + j; active = kr >= na_r0 && kr < na_r0 + 8; }
            if (active) {
                bf16x8 pb[NC][4];
                UNR for (int c = 0; c < NC; ++c) {
                    f32x16 s0, s1; { const float nm = -m_run[c]; UNR for (int i = 0; i < 16; ++i) { s0[i] = nm; s1[i] = nm; } }
                    UNR for (int ks = 0; ks < KS; ++ks) {
                        const bf16x8 k0 = *(const LASQ bf16x8*)(kb + r32 * AT_KP + (c * 32 + 16 * ks + 8 * hh) * 2);
                        const bf16x8 k1 = *(const LASQ bf16x8*)(kb + (32 + r32) * AT_KP + (c * 32 + 16 * ks + 8 * hh) * 2);
                        s0 = MFMA32(k0, qf[c][ks], s0); s1 = MFMA32(k1, qf[c][ks], s1);
                    }
                    if (MODE == 1 && !uctxq && j < na_nwin) {
                        const LASQ float* rb = rpbl + (kr - na_r + 7) * 31 + 15 - na_w;
                        UNR for (int i = 0; i < 16; ++i) { const int kc = (i & 3) + 8 * (i >> 2) + 4 * hh;
                            s0[i] = (kc >= na_c0 && kc < na_c0 + 16) ? s0[i] + rb[kc] : -1e30f;
                            s1[i] = (kc + 32 >= na_c0 && kc + 32 < na_c0 + 16) ? s1[i] + rb[kc + 32] : -1e30f; }
                    }
                    float rm = fmaxf(max16(s0), max16(s1)); rm = fmaxf(rm, __shfl_xor(rm, 32));
                    if (first || __any(rm > AT_THR)) {
                        const float dl = first ? rm : fmaxf(rm, 0.f); const float al = EXP2(-dl);
                        m_run[c] += dl; l_run[c] *= al;
                        UNR for (int t = 0; t < 2; ++t) UNR for (int i = 0; i < 16; ++i) o[c][t][i] *= al;
                        UNR for (int i = 0; i < 16; ++i) { s0[i] -= dl; s1[i] -= dl; }
                    }
                    UNR for (int i = 0; i < 16; ++i) { s0[i] = EXP2(s0[i]); s1[i] = EXP2(s1[i]); }
                    l_run[c] += sum16(s0) + sum16(s1);
                    pb[c][0] = pack8(s0, 0); pb[c][1] = pack8(s0, 8); pb[c][2] = pack8(s1, 0); pb[c][3] = pack8(s1, 8);
                }
                { const int gi = lane & 15; const ldsp_t vp = vb + (4 * hh + (gi >> 2)) * AT_VP + (16 * ((lane >> 4) & 1) + 4 * (gi & 3)) * 2;
                  UNR for (int t = 0; t < 2; ++t) { bf16x8 vf[4];
                      UNR for (int g = 0; g < 4; ++g) vf[g] = cat44(TR16(vp + 16 * g * AT_VP + t * 64), TR16(vp + (16 * g + 8) * AT_VP + t * 64));
                      UNR for (int g = 0; g < 4; ++g) UNR for (int c = 0; c < NC; ++c) o[c][t] = MFMA32(vf[g], pb[c][g], o[c][t]); } }
                first = false;
            }
        }
        if (more) { const ldsp_t nk = lds + (cur ^ 1) * SLOT;
            UNR for (int s = 0; s < TPI; ++s) { *(LASQ u32x4*)(nk + s * AT_SUB + srow * AT_KP + 16 * spc) = kreg[s]; *(LASQ u32x4*)(nk + s * AT_SUB + 64 * AT_KP + srow * AT_VP + 16 * spc) = vreg[s]; } }
        __syncthreads();
        cur ^= 1;
    }
    float res[2][16];
    if (MODE == 0) {
        const float L0 = l_run[0] + __shfl_xor(l_run[0], 32), L1 = l_run[NC - 1] + __shfl_xor(l_run[NC - 1], 32);
        const float i0 = 1.0f / L0, i1 = lam / L1; float ss = 0.f;
        UNR for (int t = 0; t < 2; ++t) UNR for (int i = 0; i < 16; ++i) { res[t][i] = o[0][t][i] * i0 - o[NC - 1][t][i] * i1; ss += res[t][i] * res[t][i]; }
        ss += __shfl_xor(ss, 32);
        const float r = 1.0f / sqrtf(ss / 64 + EPS) * (1.0f - lam_init);
        UNR for (int t = 0; t < 2; ++t) UNR for (int i = 0; i < 16; ++i) res[t][i] *= r * p.subln_b[l * 64 + 32 * t + (i & 3) + 8 * (i >> 2) + 4 * hh];
    } else {
        const float L0 = l_run[0] + __shfl_xor(l_run[0], 32), i0 = 1.0f / L0;
        UNR for (int t = 0; t < 2; ++t) UNR for (int i = 0; i < 16; ++i) res[t][i] = o[0][t][i] * i0;
    }
    bf16* op = p.XN + (size_t)qrow * D + MO + uh * 64 + 4 * hh;
    UNR for (int t = 0; t < 2; ++t) UNR for (int g = 0; g < 4; ++g) { u32x2 w; w.x = cvtpk(res[t][4 * g], res[t][4 * g + 1]); w.y = cvtpk(res[t][4 * g + 2], res[t][4 * g + 3]); *(u32x2*)(op + 32 * t + 8 * g) = w; }
}

template <int MODE> struct AttnState {
    static constexpr int NC = MODE == 0 ? 2 : 1, KS = MODE == 0 ? 2 : 4;
    bf16x8 qf[NC][KS]; float m_run[NC], l_run[NC]; f32x16 o[NC][2]; bool slow;
    int na_r, na_w, na_r0, na_c0, na_kr0, na_nwin;
};
template <int MODE> DEVFN bool attn_active(const AttnState<MODE>& A, bool uctxq, int untiles, int t) {
    if (t >= untiles) return false;
    if (MODE == 1 && !uctxq && t < A.na_nwin) { const int kr = A.na_kr0 + t; return kr >= A.na_r0 && kr < A.na_r0 + 8; }
    return true;
}
template <int MODE, int ABL = 0> DEVFN void attn_kload(int c, ldsp_t kb, int r32, int hh, bf16x8 (&kf)[2 * AttnState<MODE>::KS]) {
    if (ABL & 64) { UNR for (int i = 0; i < 2 * AttnState<MODE>::KS; ++i) kf[i] = (bf16x8){(short)r32, 1, 2, 3, 4, 5, (short)c, (short)i}; return; }
    UNR for (int ks = 0; ks < AttnState<MODE>::KS; ++ks) {
        kf[2 * ks] = *(const LASQ bf16x8*)(kb + r32 * AT_KP + (c * 32 + 16 * ks + 8 * hh) * 2);
        kf[2 * ks + 1] = *(const LASQ bf16x8*)(kb + (32 + r32) * AT_KP + (c * 32 + 16 * ks + 8 * hh) * 2); }
}
template <int MODE, int ABL = 0> DEVFN void attn_qk(const AttnState<MODE>& A, int c, const bf16x8 (&kf)[2 * AttnState<MODE>::KS], f32x16& s0, f32x16& s1, bool slow) {
    const float nm = slow ? -A.m_run[c] : 0.f; UNR for (int i = 0; i < 16; ++i) { s0[i] = nm; s1[i] = nm; }
    UNR for (int ks = 0; ks < AttnState<MODE>::KS; ++ks) {
        if ((ABL & 4) || ((ABL & 128) && (threadIdx.x >= 256))) { s0[0] += __builtin_bit_cast(float, (int)kf[2 * ks][0]); s1[0] += __builtin_bit_cast(float, (int)kf[2 * ks + 1][0]); } else { s0 = MFMA32(kf[2 * ks], A.qf[c][ks], s0); s1 = MFMA32(kf[2 * ks + 1], A.qf[c][ks], s1); }
    }
}
template <int MODE, int ABL = 0> DEVFN void attn_softmax(AttnState<MODE>& A, int c, bool uctxq, int t, const LASQ float* rpbl, int hh, f32x16& s0, f32x16& s1, bf16x8 (&pb)[4], f32x16& n0, f32x16& n1, bool next_issued) {
    if (MODE == 1 && !uctxq && t < A.na_nwin) {
        const int kr = A.na_kr0 + t; const LASQ float* rb = rpbl + (kr - A.na_r + 7) * 31 + 15 - A.na_w;
        UNR for (int i = 0; i < 16; ++i) { const int kc = (i & 3) + 8 * (i >> 2) + 4 * hh;
            s0[i] = (kc >= A.na_c0 && kc < A.na_c0 + 16) ? s0[i] + rb[kc] : -1e30f;
            s1[i] = (kc + 32 >= A.na_c0 && kc + 32 < A.na_c0 + 16) ? s1[i] + rb[kc + 32] : -1e30f; }
    }
    if (A.slow) {
    float rm = fmaxf(max16(s0), max16(s1)); rm = fmaxf(rm, __shfl_xor(rm, 32));
    if (__any(rm > AT_THR)) {
        const float dl = fmaxf(rm, 0.f); const float al = EXP2(-dl);
        A.m_run[c] += dl; A.l_run[c] *= al;
        UNR for (int tt = 0; tt < 2; ++tt) UNR for (int i = 0; i < 16; ++i) A.o[c][tt][i] *= al;
        UNR for (int i = 0; i < 16; ++i) { s0[i] -= dl; s1[i] -= dl; }
        if (AttnState<MODE>::NC == 1 && next_issued) { UNR for (int i = 0; i < 16; ++i) { n0[i] -= dl; n1[i] -= dl; } }
    }
    }
    if (!(ABL & 1) && !((ABL & 128) && (threadIdx.x < 256))) { UNR for (int i = 0; i < 16; ++i) { s0[i] = EXP2(s0[i]); s1[i] = EXP2(s1[i]); } }
    const float ts = sum16(s0) + sum16(s1);
    A.l_run[c] += ts;
    if (!A.slow) { if (__any(ts > AT_BIG || !(A.l_run[c] > AT_TINY))) A.slow = true; }
    pb[0] = pack8(s0, 0); pb[1] = pack8(s0, 8); pb[2] = pack8(s1, 0); pb[3] = pack8(s1, 8);
}
template <int ABL = 0> DEVFN void attn_vload(ldsp_t vb, int lane, int hh, int tt, bf16x8 (&vf)[4]) {
    if (ABL & 32) { UNR for (int g = 0; g < 4; ++g) vf[g] = (bf16x8){(short)lane, 1, 2, 3, 4, 5, 6, (short)g}; return; }
    const int gi = lane & 15; const ldsp_t vp = vb + (4 * hh + (gi >> 2)) * AT_VP + (16 * ((lane >> 4) & 1) + 4 * (gi & 3)) * 2 + tt * 64;
    UNR for (int g = 0; g < 4; ++g) vf[g] = cat44(TR16(vp + 16 * g * AT_VP), TR16(vp + (16 * g + 8) * AT_VP));
}
template <int MODE, int ABL = 0> DEVFN void attn_pv(AttnState<MODE>& A, int c, int tt, const bf16x8 (&vf)[4], const bf16x8 (&pb)[4]) {
    UNR for (int g = 0; g < 4; ++g) { if ((ABL & 2) || ((ABL & 128) && (threadIdx.x >= 256))) A.o[c][tt][0] += (float)(vf[g][0] + pb[g][0]); else A.o[c][tt] = MFMA32(vf[g], pb[g], A.o[c][tt]); }
}

template <int MODE, int DEAD = 0> DEVFN float attn_fast_p(const AttnState<MODE>& A, bool uctxq, int t, const LASQ float* rpbl, int hh, const f32x16& s0, const f32x16& s1, bf16x8 (&pb)[4]) {
    const bool na_win = DEAD != 0 || (MODE == 1 && !uctxq && t < A.na_nwin);
    const LASQ float* rb = rpbl; if (na_win) rb = rpbl + (A.na_kr0 + t - A.na_r + 7) * 31 + 15 - A.na_w;
    float ts = 0.f;
    UNR for (int g = 0; g < 4; ++g) { float e[8];
        if ((DEAD == 1 && g == 3) || (DEAD == 2 && g == 0)) { pb[g] = (bf16x8){0, 0, 0, 0, 0, 0, 0, 0}; continue; }
        UNR for (int j = 0; j < 8; ++j) { const int i = 8 * (g & 1) + j; float x = g < 2 ? s0[i] : s1[i];
            if ((DEAD == 1 && g == 2 && j >= 4) || (DEAD == 2 && g == 1 && j < 4)) { e[j] = 0.f; continue; }
            if (na_win) { const int kc = (i & 3) + 8 * (i >> 2) + 4 * hh + (g < 2 ? 0 : 32); x = (kc >= A.na_c0 && kc < A.na_c0 + 16) ? x + rb[kc] : -1e30f; }
            e[j] = EXP2(x); }
        ts += ((e[0] + e[1]) + (e[2] + e[3])) + ((e[4] + e[5]) + (e[6] + e[7]));
        u32x4 w; w.x = cvtpk(e[0], e[1]); w.y = cvtpk(e[2], e[3]); w.z = cvtpk(e[4], e[5]); w.w = cvtpk(e[6], e[7]); pb[g] = __builtin_bit_cast(bf16x8, w); }
    return ts;
}
template <int DEAD = 0> DEVFN void attn_vload8(ldsp_t vb, int lane, int hh, bf16x8 (&vf)[2][4]) {
    const int gi = lane & 15; const ldsp_t vp = vb + (4 * hh + (gi >> 2)) * AT_VP + (16 * ((lane >> 4) & 1) + 4 * (gi & 3)) * 2;
    UNR for (int g = 0; g < 4; ++g) { if ((DEAD == 1 && g == 3) || (DEAD == 2 && g == 0)) continue; vf[0][g] = cat44(TR16(vp + 16 * g * AT_VP), TR16(vp + (16 * g + 8) * AT_VP)); vf[1][g] = cat44(TR16(vp + 16 * g * AT_VP + 64), TR16(vp + (16 * g + 8) * AT_VP + 64)); }
}
template <int MODE, bool DO_QK, int ABL = 0, int DEAD = 0> DEVFN void attn_fast_stepA(AttnState<MODE>& A, int c, int cn, bool uctxq, int t, const LASQ float* rpbl, int lane, int r32, int hh,
                                                           ldsp_t vb, ldsp_t kbn, const f32x16& s0, const f32x16& s1, f32x16& n0, f32x16& n1, bf16x8 (&vf)[2][4]) {
    constexpr int KS = AttnState<MODE>::KS;
    bf16x8 kf[2 * KS]; bf16x8 pb[4];
    attn_vload8<DEAD>(vb, lane, hh, vf);
    if (DO_QK) attn_kload<MODE, ABL>(cn, kbn, r32, hh, kf);
    const float ts = attn_fast_p<MODE, DEAD>(A, uctxq, t, rpbl, hh, s0, s1, pb);
    UNR for (int g = 0; g < 4; ++g) { if ((DEAD == 1 && g == 3) || (DEAD == 2 && g == 0)) continue; A.o[c][0] = MFMA32(vf[0][g], pb[g], A.o[c][0]); A.o[c][1] = MFMA32(vf[1][g], pb[g], A.o[c][1]); }
    if (DO_QK) { UNR for (int i = 0; i < 16; ++i) { n0[i] = 0.f; n1[i] = 0.f; }
        UNR for (int ks = 0; ks < KS; ++ks) { n0 = MFMA32(kf[2 * ks], A.qf[cn][ks], n0); n1 = MFMA32(kf[2 * ks + 1], A.qf[cn][ks], n1); } }
    A.l_run[c] += ts;
    if (__any(ts > AT_BIG || !(A.l_run[c] > AT_TINY))) A.slow = true;
}
template <int MODE, bool DO_QK, int ABL = 0> DEVFN void attn_fast_stepB(AttnState<MODE>& A, int c, int cn, int r32, int hh, ldsp_t kbn, const f32x16& s0, const f32x16& s1, f32x16& n0, f32x16& n1, const bf16x8 (&vf)[2][4]) {
    constexpr int KS = AttnState<MODE>::KS;
    bf16x8 kf[2 * KS];
    if (DO_QK) attn_kload<MODE, ABL>(cn, kbn, r32, hh, kf);
    float ts = 0.f;
    UNR for (int g = 0; g < 4; ++g) { float e[8];
        UNR for (int j = 0; j < 8; ++j) { const int i = 8 * (g & 1) + j; e[j] = EXP2(g < 2 ? s0[i] : s1[i]); }
        ts += ((e[0] + e[1]) + (e[2] + e[3])) + ((e[4] + e[5]) + (e[6] + e[7]));
        u32x4 w; w.x = cvtpk(e[0], e[1]); w.y = cvtpk(e[2], e[3]); w.z = cvtpk(e[4], e[5]); w.w = cvtpk(e[6], e[7]); const bf16x8 pbg = __builtin_bit_cast(bf16x8, w);
        A.o[c][0] = MFMA32(vf[0][g], pbg, A.o[c][0]); A.o[c][1] = MFMA32(vf[1][g], pbg, A.o[c][1]); }
    if (DO_QK) { UNR for (int i = 0; i < 16; ++i) { n0[i] = 0.f; n1[i] = 0.f; }
        UNR for (int ks = 0; ks < KS; ++ks) { n0 = MFMA32(kf[2 * ks], A.qf[cn][ks], n0); n1 = MFMA32(kf[2 * ks + 1], A.qf[cn][ks], n1); } }
    A.l_run[c] += ts;
    if (__any(ts > AT_BIG || !(A.l_run[c] > AT_TINY))) A.slow = true;
}

template <int MODE, int ABL = 0> DEVFN void attn_unit2(const Params& p, int l, int ub, int uh, int uq0, int untiles, bool uctxq, int ug4, ldsp_t lds, float lam, float lam_init) {
    constexpr int NC = AttnState<MODE>::NC, KS = AttnState<MODE>::KS;
    constexpr int CQ = MODE == 0 ? C_QB : C_QA, CK = MODE == 0 ? C_KB : C_KA, CV = MODE == 0 ? C_VB : C_VA, MO = MODE == 0 ? MO_B : MO_A;
    int tid = threadIdx.x; LAUNDER(tid); const int lane = tid & 63, wid = RFL(tid >> 6), r32 = lane & 31, hh = lane >> 5;
    const bool late = (wid & 1) != 0;
    const int qrow = uq0 + wid * 32 + r32;
    AttnState<MODE> A;
    { const bf16* qp = p.P + (size_t)qrow * PW + CQ + uh * 64 + 8 * hh;
      UNR for (int c = 0; c < NC; ++c) UNR for (int ks = 0; ks < KS; ++ks) A.qf[c][ks] = *(const bf16x8*)(qp + c * 32 + 16 * ks); }
    A.na_r = A.na_w = A.na_r0 = A.na_c0 = A.na_kr0 = A.na_nwin = 0;
    if (MODE == 1 && !uctxq) { A.na_r = ug4 + (wid >> 1); A.na_w = 32 * (wid & 1) + r32; A.na_r0 = clampi(A.na_r - 4, 0, ROWS - 8); A.na_c0 = clampi(A.na_w - 8, 0, GRID_W - 16);
        A.na_kr0 = clampi(ug4 - 4, 0, ROWS - 8); A.na_nwin = clampi(ug4 + 3 - 4, 0, ROWS - 8) + 8 - A.na_kr0; }
    LASQ float* rpbl = (LASQ float*)(lds + 4 * AT_SUB);
    if (MODE == 1) { for (int i = tid; i < 15 * 31; i += 512) rpbl[i] = p.rpb_a[((size_t)l * NAH + uh) * 465 + i] * LOG2E; }
    UNR for (int c = 0; c < NC; ++c) { A.m_run[c] = 0.f; A.l_run[c] = 0.f; UNR for (int t = 0; t < 2; ++t) UNR for (int i = 0; i < 16; ++i) A.o[c][t][i] = 0.f; }
    A.slow = AT_FORCE_SLOW;
    const int srow = tid >> 3, spc = tid & 7;
    u32x4 kregA, vregA;
#define kregB kregA
#define vregB vregA
#define AT_GLOAD(t, KR, VR) do { const int jt_ = (t) < untiles ? (t) : untiles - 1; const bf16* g_ = p.P + (size_t)(attn_tile_row<MODE>(ub, uctxq, ug4, jt_) + srow) * PW + uh * 64 + 8 * spc; KR = *(const u32x4*)(g_ + CK); VR = *(const u32x4*)(g_ + CV); } while (0)
#define AT_LWRITE(t, KR, VR) do { const ldsp_t d_ = lds + ((t) & 3) * AT_SUB; *(LASQ u32x4*)(d_ + srow * AT_KP + 16 * spc) = KR; *(LASQ u32x4*)(d_ + 64 * AT_KP + srow * AT_VP + 16 * spc) = VR; } while (0)
    { u32x4 k0_, v0_, k1_, v1_; AT_GLOAD(0, k0_, v0_); AT_GLOAD(1, k1_, v1_); AT_GLOAD(2, kregA, vregA); AT_LWRITE(0, k0_, v0_); AT_LWRITE(1, k1_, v1_); }
    __syncthreads();
    f32x16 x0, x1, y0, y1;
    bf16x8 kf[2 * KS];
    if (attn_active<MODE>(A, uctxq, untiles, 0)) { attn_kload<MODE>(0, lds, r32, hh, kf); attn_qk<MODE, ABL>(A, 0, kf, x0, x1, A.slow); }
#define AT_TILE_START(t) do { if (!(ABL & 8)) { AT_LWRITE((t) + 2, kregA, vregA); AT_GLOAD((t) + 3, kregA, vregA); } if (!late && !(ABL & 16)) __syncthreads(); } while (0)
#define AT_VB(t) (lds + ((t) & 3) * AT_SUB + 64 * AT_KP)
#define AT_KB(t) (lds + ((t) & 3) * AT_SUB)
    int t = 0; bf16x8 vfT[2][4];
    if (!ABL) {
        if (MODE == 0) {
            for (; t + 1 < untiles && !A.slow; ++t) {
                AT_TILE_START(t);
                attn_fast_stepA<MODE, true, ABL>(A, 0, NC - 1, uctxq, t, rpbl, lane, r32, hh, AT_VB(t), AT_KB(t), x0, x1, y0, y1, vfT);
                if (late) __syncthreads();
                attn_fast_stepB<MODE, true, ABL>(A, NC - 1, 0, r32, hh, AT_KB(t + 1), y0, y1, x0, x1, vfT);
            }
            if (!A.slow && t + 1 == untiles) {
                AT_TILE_START(t);
                attn_fast_stepA<MODE, true, ABL>(A, 0, NC - 1, uctxq, t, rpbl, lane, r32, hh, AT_VB(t), AT_KB(t), x0, x1, y0, y1, vfT);
                if (late) __syncthreads();
                attn_fast_stepB<MODE, false, ABL>(A, NC - 1, 0, r32, hh, AT_KB(t), y0, y1, x0, x1, vfT);
                ++t;
            }
        } else {
#define AT_NA_STEP(tt, sc0, sc1, sn0, sn1) do { AT_TILE_START(tt); const bool act_ = attn_active<MODE>(A, uctxq, untiles, (tt)), nact_ = attn_active<MODE>(A, uctxq, untiles, (tt) + 1); \
                if (act_) { const int dd_ = (!uctxq && (tt) < A.na_nwin) ? 1 + (wid & 1) : 0; \
                    if (nact_) { if (dd_ == 0) attn_fast_stepA<MODE, true, 0, 0>(A, 0, 0, uctxq, (tt), rpbl, lane, r32, hh, AT_VB(tt), AT_KB((tt) + 1), sc0, sc1, sn0, sn1, vfT); \
                                 else if (dd_ == 1) attn_fast_stepA<MODE, true, 0, 1>(A, 0, 0, uctxq, (tt), rpbl, lane, r32, hh, AT_VB(tt), AT_KB((tt) + 1), sc0, sc1, sn0, sn1, vfT); \
                                 else attn_fast_stepA<MODE, true, 0, 2>(A, 0, 0, uctxq, (tt), rpbl, lane, r32, hh, AT_VB(tt), AT_KB((tt) + 1), sc0, sc1, sn0, sn1, vfT); } \
                    else { if (dd_ == 0) attn_fast_stepA<MODE, false, 0, 0>(A, 0, 0, uctxq, (tt), rpbl, lane, r32, hh, AT_VB(tt), AT_KB(tt), sc0, sc1, sn0, sn1, vfT); \
                           else if (dd_ == 1) attn_fast_stepA<MODE, false, 0, 1>(A, 0, 0, uctxq, (tt), rpbl, lane, r32, hh, AT_VB(tt), AT_KB(tt), sc0, sc1, sn0, sn1, vfT); \
                           else attn_fast_stepA<MODE, false, 0, 2>(A, 0, 0, uctxq, (tt), rpbl, lane, r32, hh, AT_VB(tt), AT_KB(tt), sc0, sc1, sn0, sn1, vfT); } } \
                else if (nact_) { attn_kload<MODE>(0, AT_KB((tt) + 1), r32, hh, kf); attn_qk<MODE, 0>(A, 0, kf, sn0, sn1, false); } \
                if (late) __syncthreads(); } while (0)
            for (; t + 1 < untiles && !A.slow; t += 2) { AT_NA_STEP(t, x0, x1, y0, y1); AT_NA_STEP(t + 1, y0, y1, x0, x1); }
            if (!A.slow && t + 1 == untiles) { AT_NA_STEP(t, x0, x1, y0, y1); ++t; }
#undef AT_NA_STEP
        }
    }
#define AT_STEP(t, c, sc0, sc1, sn0, sn1) do { \
        const int t_ = (t); const int tn_ = (c) + 1 < NC ? t_ : t_ + 1; const int cn_ = (c) + 1 < NC ? (c) + 1 : 0; \
        if ((c) == 0) AT_TILE_START(t_); \
        const bool nact_ = attn_active<MODE>(A, uctxq, untiles, tn_); \
        const bool act_ = attn_active<MODE>(A, uctxq, untiles, t_); \
        if (nact_) { attn_kload<MODE, ABL>(cn_, AT_KB(tn_), r32, hh, kf); attn_qk<MODE, ABL>(A, cn_, kf, sn0, sn1, true); } \
        bf16x8 pb_[4]; bf16x8 vfa_[4], vfb_[4]; \
        if (act_) attn_vload<ABL>(AT_VB(t_), lane, hh, 0, vfa_); \
        if (act_) attn_softmax<MODE, ABL>(A, (c), uctxq, t_, rpbl, hh, sc0, sc1, pb_, sn0, sn1, nact_); \
        if ((c) == 0 && late && !(ABL & 16)) __syncthreads(); \
        if (act_) { attn_vload<ABL>(AT_VB(t_), lane, hh, 1, vfb_); attn_pv<MODE, ABL>(A, (c), 0, vfa_, pb_); attn_pv<MODE, ABL>(A, (c), 1, vfb_, pb_); } \
    } while (0)
    if (t < untiles) {
        A.slow = true;
        if (NC == 2) { for (; t < untiles; ++t) { AT_STEP(t, 0, x0, x1, y0, y1); AT_STEP(t, 1, y0, y1, x0, x1); } }
        else { if (t & 1) { AT_STEP(t, 0, y0, y1, x0, x1); ++t; }
               for (; t < untiles; t += 2) { AT_STEP(t, 0, x0, x1, y0, y1); if (t + 1 < untiles) AT_STEP(t + 1, 0, y0, y1, x0, x1); } }
    }
#undef AT_TILE_START
#undef AT_VB
#undef AT_KB
#undef AT_STEP
#undef AT_GLOAD
#undef AT_LWRITE
    __syncthreads();
    float res[2][16];
    if (MODE == 0) {
        const float L0 = A.l_run[0] + __shfl_xor(A.l_run[0], 32), L1 = A.l_run[NC - 1] + __shfl_xor(A.l_run[NC - 1], 32);
        const float i0 = 1.0f / L0, i1 = lam / L1; float ss = 0.f;
        UNR for (int t = 0; t < 2; ++t) UNR for (int i = 0; i < 16; ++i) { res[t][i] = A.o[0][t][i] * i0 - A.o[NC - 1][t][i] * i1; ss += res[t][i] * res[t][i]; }
        ss += __shfl_xor(ss, 32);
        const float r = 1.0f / sqrtf(ss / 64 + EPS) * (1.0f - lam_init);
        UNR for (int t = 0; t < 2; ++t) UNR for (int i = 0; i < 16; ++i) res[t][i] *= r * p.subln_b[l * 64 + 32 * t + (i & 3) + 8 * (i >> 2) + 4 * hh];
    } else {
        const float L0 = A.l_run[0] + __shfl_xor(A.l_run[0], 32), i0 = 1.0f / L0;
        UNR for (int t = 0; t < 2; ++t) UNR for (int i = 0; i < 16; ++i) res[t][i] = A.o[0][t][i] * i0;
    }
    bf16* op = p.XN + (size_t)qrow * D + MO + uh * 64 + 4 * hh;
    UNR for (int t = 0; t < 2; ++t) UNR for (int g = 0; g < 4; ++g) { u32x2 w; w.x = cvtpk(res[t][4 * g], res[t][4 * g + 1]); w.y = cvtpk(res[t][4 * g + 2], res[t][4 * g + 3]);
        if (ABL) { if (w.x == 0x12345678u && w.y == 0x9abcdef0u) *(u32x2*)(op + 32 * t + 8 * g) = w; } else *(u32x2*)(op + 32 * t + 8 * g) = w; }
}

template <int ABL = 0> DEVFN void ph_diff_fast(const Params& p, int l, bool with_ctx, ldsp_t lds, int bid, int nblk) {
    const float lam_init = lam_init_of(l), lam = lam_of(p, l, lam_init);
    const int nlat = BATCH * DAH * (SEQ / 256), nctx = with_ctx ? BATCH * DAH * (CTX / 256) : 0;
    for (int i0 = bid; i0 < nlat + nctx; i0 += nblk) {
        AU u; u.g4 = 0; int i = i0;
        if (i0 < nlat && nblk % 8 == 0 && nlat % nblk == 0) {
            const int rnd = i0 / nblk, b_ = i0 % nblk, per = nblk / 8; i = rnd * nblk + (b_ % 8) * per + b_ / 8; }
        if (i < nlat) { const int qb = i % (SEQ / 256), bh = i / (SEQ / 256); u.b = bh / DAH; u.h = bh % DAH; u.q0 = u.b * SEQ + 256 * qb; u.ntiles = SEQ / 64 + CTX / 64; u.ctxq = false; }
        else { const int k = i - nlat; const int qb = k % (CTX / 256), bh = k / (CTX / 256); u.b = bh / DAH; u.h = bh % DAH; u.q0 = ML + u.b * CTX + 256 * qb; u.ntiles = CTX / 64; u.ctxq = true; }
        attn_unit2<0, ABL>(p, l, u.b, u.h, u.q0, u.ntiles, u.ctxq, u.g4, lds, lam, lam_init);
    }
}
DEVFN void ph_na_fast(const Params& p, int l, bool with_ctx, ldsp_t lds, int bid, int nblk) {
    const int nlat = BATCH * NAH * (ROWS / 4), nctx = with_ctx ? BATCH * NAH * (CTX / 256) : 0;
    for (int i = bid; i < nlat + nctx; i += nblk) {
        AU u;
        if (i < nlat) { const int g = i % (ROWS / 4), bh = i / (ROWS / 4); u.b = bh / NAH; u.h = bh % NAH; u.g4 = 4 * g; u.q0 = u.b * SEQ + 256 * g; u.ctxq = false;
            const int kr0 = clampi(u.g4 - 4, 0, ROWS - 8), kr1 = clampi(u.g4 + 3 - 4, 0, ROWS - 8) + 8; u.ntiles = (kr1 - kr0) + CTX / 64; }
        else { const int k = i - nlat; const int qb = k % (CTX / 256), bh = k / (CTX / 256); u.b = bh / NAH; u.h = bh % NAH; u.g4 = 0; u.q0 = ML + u.b * CTX + 256 * qb; u.ntiles = CTX / 64; u.ctxq = true; }
        attn_unit2<1>(p, l, u.b, u.h, u.q0, u.ntiles, u.ctxq, u.g4, lds, 0.f, 0.f);
    }
}

constexpr int NCC = CTX / 64, NLC = SEQ / 64, NCH = NCC + NLC;
constexpr int GL_VP = 320, GL_KP = 144, GL_TP = 192;
constexpr int GL_G = 0, GL_W = 32768, GL_T = GL_W + 8704, GL_V = GL_T + 2048, GL_OP = GL_V + 64 * GL_VP, GL_RED = GL_OP + 6 * 64 * GL_KP, GL_LDS = GL_RED + 1024;
static_assert(GL_LDS <= 131072 && 2 * 64 * GL_TP <= 6 * 64 * GL_KP, "GLA LDS map");
DEVFN int gla_chunk_row(int b, int c) { return c < NCC ? ML + b * CTX + 64 * c : b * SEQ + 64 * (c - NCC); }
DEVFN int gla_scan_chunk(int dir, int step) { return dir == 0 ? step : (step < NCC ? NCC - 1 - step : NCC + (NLC - 1 - (step - NCC))); }

struct GlaRegs { u32x4 af, v0, v1, k, q; };
struct GlaW { bf16x8 hi, lo; float bias; };
DEVFN void gla_unit_decode(int unit, int ncu, int c_lo, int& b, int& h, int& c) { h = unit % GLH; const int r = unit / GLH; c = c_lo + r % ncu; b = r / ncu; }
DEVFN void gla_load(const Params& p, GlaRegs& R, int h, int m0, int tid, bool want_q) {
    { const int lane = tid & 63, wid = tid >> 6, dir = wid >> 2, st = (wid >> 1) & 1; R.af = *(const u32x4*)(p.AFB + (size_t)(m0 + 32 * st + (lane & 31)) * 32 + dir * 16 + 8 * (lane >> 5)); }
    { const int row = tid >> 4, pc = tid & 15; R.v0 = *(const u32x4*)(p.P + (size_t)(m0 + row) * PW + C_VC + h * 128 + 8 * pc); R.v1 = *(const u32x4*)(p.P + (size_t)(m0 + 32 + row) * PW + C_VC + h * 128 + 8 * pc); }
    { const int row = tid >> 3, d8 = (tid & 7) * 8; const bf16* pr = p.P + (size_t)(m0 + row) * PW + h * 64 + d8; R.k = *(const u32x4*)(pr + C_KC); if (want_q) R.q = *(const u32x4*)(pr + C_QC); }
}
DEVFN void unpack8(const u32x4& w, float* o) { unsigned u; u = w.x << 16; __builtin_memcpy(&o[0], &u, 4); u = w.x & 0xffff0000u; __builtin_memcpy(&o[1], &u, 4); u = w.y << 16; __builtin_memcpy(&o[2], &u, 4); u = w.y & 0xffff0000u; __builtin_memcpy(&o[3], &u, 4);
    u = w.z << 16; __builtin_memcpy(&o[4], &u, 4); u = w.z & 0xffff0000u; __builtin_memcpy(&o[5], &u, 4); u = w.w << 16; __builtin_memcpy(&o[6], &u, 4); u = w.w & 0xffff0000u; __builtin_memcpy(&o[7], &u, 4); }
DEVFN void gla_load_w(const Params& p, int l, int h, GlaW& W, int tid) {
    const int lane = tid & 63, wid = tid >> 6, dir = wid >> 2, dt = wid & 1, d = h * 64 + 32 * dt + (lane & 31), hh = lane >> 5;
    const float* w2 = (dir ? p.w_a2_b : p.w_a2_f) + (size_t)l * 16 * GK_W + d; float hi[8], lo[8];
    UNR for (int j = 0; j < 8; ++j) { const float w = w2[(size_t)(8 * hh + j) * GK_W]; hi[j] = bf2f(f2bf(w)); lo[j] = w - hi[j]; }
    u32x4 a, b2; a.x = cvtpk(hi[0], hi[1]); a.y = cvtpk(hi[2], hi[3]); a.z = cvtpk(hi[4], hi[5]); a.w = cvtpk(hi[6], hi[7]); b2.x = cvtpk(lo[0], lo[1]); b2.y = cvtpk(lo[2], lo[3]); b2.z = cvtpk(lo[4], lo[5]); b2.w = cvtpk(lo[6], lo[7]);
    W.hi = __builtin_bit_cast(bf16x8, a); W.lo = __builtin_bit_cast(bf16x8, b2); W.bias = (dir ? p.b_a_b : p.b_a_f)[(size_t)l * GK_W + d];
}
DEVFN void gla_prep(const GlaRegs& R, const GlaW& W, ldsp_t lds, int tid) {
    LASQ float* G = (LASQ float*)(lds + GL_G); LASQ float* T = (LASQ float*)(lds + GL_T);
    { const int row = tid >> 4, pc = tid & 15; *(LASQ u32x4*)(lds + GL_V + row * GL_VP + 16 * pc) = R.v0; *(LASQ u32x4*)(lds + GL_V + (32 + row) * GL_VP + 16 * pc) = R.v1; }
    { const int lane = tid & 63, wid = tid >> 6, dir = wid >> 2, st = (wid >> 1) & 1, dt = wid & 1, hh = lane >> 5;
      f32x16 x; UNR for (int i = 0; i < 16; ++i) x[i] = W.bias;
      const bf16x8 a = __builtin_bit_cast(bf16x8, R.af);
      x = MFMA32(a, W.hi, x); x = MFMA32(a, W.lo, x);
      float g[16], pf[16], gt[4], pt[4], off[4];
      UNR for (int i = 0; i < 16; ++i) g[i] = (fminf(x[i], 0.f) - 0.6931471805599453f * LOG2(1.0f + EXP2(-fabsf(x[i]) * LOG2E))) * (1.0f / 16.0f);
      UNR for (int j = 0; j < 4; ++j) {
          if (dir == 0) { pf[4 * j] = g[4 * j]; pf[4 * j + 1] = pf[4 * j] + g[4 * j + 1]; pf[4 * j + 2] = pf[4 * j + 1] + g[4 * j + 2]; pf[4 * j + 3] = pf[4 * j + 2] + g[4 * j + 3]; gt[j] = pf[4 * j + 3]; }
          else { pf[4 * j + 3] = g[4 * j + 3]; pf[4 * j + 2] = pf[4 * j + 3] + g[4 * j + 2]; pf[4 * j + 1] = pf[4 * j + 2] + g[4 * j + 1]; pf[4 * j] = pf[4 * j + 1] + g[4 * j]; gt[j] = pf[4 * j]; } }
      UNR for (int j = 0; j < 4; ++j) pt[j] = __shfl_xor(gt[j], 32);
      float run = 0.f;
      if (dir == 0) { UNR for (int j = 0; j < 4; ++j) { off[j] = run + (hh ? pt[j] : 0.f); run += gt[j] + pt[j]; } }
      else { UNR for (int j = 3; j >= 0; --j) { off[j] = run + (hh ? 0.f : pt[j]); run += gt[j] + pt[j]; } }
      UNR for (int i = 0; i < 16; ++i) { const int s = 32 * st + (i & 3) + 8 * (i >> 2) + 4 * hh; G[(dir * 64 + s) * 64 + 32 * dt + (lane & 31)] = pf[i] + off[i >> 2]; }
      if (hh == 0) T[(dir * 2 + st) * 64 + 32 * dt + (lane & 31)] = run; }
    __syncthreads();
}
DEVFN void gla_off8(ldsp_t lds, int dir, int row, int d8, float* o) {
    const LASQ float* T = (const LASQ float*)(lds + GL_T); const bool need = dir == 0 ? row >= 32 : row < 32;
    UNR for (int e = 0; e < 8; ++e) o[e] = need ? T[(dir * 2 + dir) * 64 + d8 + e] : 0.f;
}

DEVFN void ph_gla_A(const Params& p, int l, ldsp_t lds, int bid, int nblk) {
    int tid = threadIdx.x; LAUNDER(tid); const int lane = tid & 63, wid = RFL(tid >> 6), r32 = lane & 31, hh = lane >> 5, gi = lane & 15;
    const LASQ float* G = (const LASQ float*)(lds + GL_G);
    const int nunits = BATCH * GLH * NCH; int cur_h = -1;
    GlaRegs R; GlaW GW; int b, h, c;
    if (bid < nunits) { gla_unit_decode(bid, NCH, 0, b, h, c); gla_load(p, R, h, gla_chunk_row(b, c), tid, false); }
    for (int unit = bid; unit < nunits; unit += nblk) {
        gla_unit_decode(unit, NCH, 0, b, h, c); const int bh = b * GLH + h;
        if (h != cur_h) { gla_load_w(p, l, h, GW, tid); cur_h = h; }
        gla_prep(R, GW, lds, tid);
        { const int row = tid >> 3, d8 = (tid & 7) * 8; float k8[8]; unpack8(R.k, k8);
          UNR for (int dir = 0; dir < 2; ++dir) { const LASQ float* bl = G + (dir * 64 + (dir ? 0 : 63)) * 64 + d8; const LASQ float* bs = G + (dir * 64 + row) * 64 + d8; float o8[8], ol[8], os[8];
              gla_off8(lds, dir, dir ? 0 : 63, d8, ol); gla_off8(lds, dir, row, d8, os);
              UNR for (int e = 0; e < 8; ++e) o8[e] = k8[e] * EXP2(((bl[e] + ol[e]) - (bs[e] + os[e])) * LOG2E);
              u32x4 w; w.x = cvtpk(o8[0], o8[1]); w.y = cvtpk(o8[2], o8[3]); w.z = cvtpk(o8[4], o8[5]); w.w = cvtpk(o8[6], o8[7]);
              *(LASQ u32x4*)(lds + GL_OP + dir * 64 * GL_TP + row * GL_TP + d8 * 2) = w; } }
        if (tid < 128) { const int dir = tid >> 6, d = tid & 63; const LASQ float* T_ = (const LASQ float*)(lds + GL_T);
            p.AD[((size_t)(bh * 2 + dir) * NCH + c) * 64 + d] = EXP2((G[(dir * 64 + (dir ? 0 : 63)) * 64 + d] + T_[(dir * 2 + dir) * 64 + d]) * LOG2E); }
        if (unit + nblk < nunits) { int b2, h2, c2; gla_unit_decode(unit + nblk, NCH, 0, b2, h2, c2); gla_load(p, R, h2, gla_chunk_row(b2, c2), tid, false); }
        __syncthreads();
        const int vt = wid >> 1, dt = wid & 1;
        UNR for (int dir = 0; dir < 2; ++dir) {
            f32x16 u; UNR for (int i = 0; i < 16; ++i) u[i] = 0.f;
            const ldsp_t vp = lds + GL_V + (8 * hh + (gi >> 2)) * GL_VP + (32 * vt + 16 * ((lane >> 4) & 1) + 4 * (gi & 3)) * 2;
            const ldsp_t kp = lds + GL_OP + dir * 64 * GL_TP + (8 * hh + (gi >> 2)) * GL_TP + (32 * dt + 16 * ((lane >> 4) & 1) + 4 * (gi & 3)) * 2;
            UNR for (int ks = 0; ks < 4; ++ks) { const bf16x8 va = cat44(TR16(vp + 16 * ks * GL_VP), TR16(vp + (16 * ks + 4) * GL_VP)); const bf16x8 kb = cat44(TR16(kp + 16 * ks * GL_TP), TR16(kp + (16 * ks + 4) * GL_TP));
                u = MFMA32(va, kb, u); }
            bf16* ub = (bf16*)(p.US + ((size_t)(bh * 2 + dir) * NCH + c) * 8192) + 32 * dt + r32;
            UNR for (int i = 0; i < 16; ++i) ub[(size_t)(32 * vt + (i & 3) + 8 * (i >> 2) + 4 * hh) * 64] = f2bf(u[i]);
        }
        __syncthreads();
    }
}

DEVFN void ph_gla_B(const Params& p, int bid, int nblk) {
    int tid = threadIdx.x; LAUNDER(tid);
    constexpr int PD = (NCH % 17 == 0) ? 17 : 4;
    static_assert(NCH % PD == 0, "scan pipelining");
    for (int unit = bid; unit < BATCH * GLH * 2 * 4; unit += nblk) {
        const int vq = unit & 3, dir = (unit >> 2) & 1, bh = unit >> 3;
        f32x4 S = {0.f, 0.f, 0.f, 0.f};
        u32x2 Un[PD]; f32x4 an[PD];
#define UBASE(step) ((size_t)(bh * 2 + dir) * NCH + gla_scan_chunk(dir, (step)))
        UNR for (int k = 0; k < PD; ++k) { const size_t blk = UBASE(k); Un[k] = *(const u32x2*)((const bf16*)(p.US + blk * 8192) + vq * 2048 + 4 * tid); an[k] = *(const f32x4*)(p.AD + blk * 64 + 4 * (tid & 15)); }
        for (int step = 0; step < NCH; step += PD) {
            UNR for (int k = 0; k < PD; ++k) {
                const size_t blk = UBASE(step + k); float U[4]; unpack4(Un[k], U); const f32x4 a = an[k];
                if (step + k + PD < NCH) { const size_t nb = UBASE(step + k + PD); Un[k] = *(const u32x2*)((const bf16*)(p.US + nb * 8192) + vq * 2048 + 4 * tid); an[k] = *(const f32x4*)(p.AD + nb * 64 + 4 * (tid & 15)); }
                u32x2 w; w.x = cvtpk(S[0], S[1]); w.y = cvtpk(S[2], S[3]);
                *(u32x2*)((bf16*)(p.US + blk * 8192) + 8192 + vq * 2048 + 4 * tid) = w;
                UNR for (int e = 0; e < 4; ++e) S[e] = a[e] * S[e] + U[e];
            }
        }
#undef UBASE
    }
}

DEVFN void ph_gla_C(const Params& p, int l, bool with_ctx, ldsp_t lds, int bid, int nblk) {
    int tid = threadIdx.x; LAUNDER(tid); const int lane = tid & 63, wid = RFL(tid >> 6), r32 = lane & 31, hh = lane >> 5, gi = lane & 15;
    const LASQ float* G = (const LASQ float*)(lds + GL_G); LASQ float* RED = (LASQ float*)(lds + GL_RED);
    const int c_lo = with_ctx ? 0 : NCC, ncu = NCH - c_lo; const int nunits = BATCH * GLH * ncu; int cur_h = -1;
    GlaRegs R; GlaW GW; int b, h, c;
    float onw[16]; { const int vt_ = wid >> 1; UNR for (int i = 0; i < 16; ++i) onw[i] = p.onorm_c[l * 128 + 32 * vt_ + 8 * (i >> 2) + 4 * hh + (i & 3)]; }
    if (bid < nunits) { gla_unit_decode(bid, ncu, c_lo, b, h, c); gla_load(p, R, h, gla_chunk_row(b, c), tid, true); }
    for (int unit = bid; unit < nunits; unit += nblk) {
        gla_unit_decode(unit, ncu, c_lo, b, h, c); const int bh = b * GLH + h; const int m0 = gla_chunk_row(b, c);
        if (h != cur_h) { gla_load_w(p, l, h, GW, tid); cur_h = h; }
        bf16x8 sfr[2][4]; u32x2 gcw[4];
        { const int vt_ = wid >> 1, tt_ = wid & 1;
          UNR for (int dir = 0; dir < 2; ++dir) { const bf16* sb = (const bf16*)(p.US + ((size_t)(bh * 2 + dir) * NCH + c) * 8192) + 8192 + vt_ * 2048 + r32 * 64 + 8 * hh;
              UNR for (int ks = 0; ks < 4; ++ks) sfr[dir][ks] = *(const bf16x8*)(sb + 16 * ks); }
          const bf16* gp_ = p.P + (size_t)(m0 + 32 * tt_ + r32) * PW + C_GC + h * 128 + 32 * vt_ + 4 * hh;
          UNR for (int g = 0; g < 4; ++g) gcw[g] = *(const u32x2*)(gp_ + 8 * g); }
        gla_prep(R, GW, lds, tid);
        { const int row = tid >> 3, d8 = (tid & 7) * 8; float q8[8], k8[8]; unpack8(R.q, q8); unpack8(R.k, k8);
          UNR for (int dir = 0; dir < 2; ++dir) { const LASQ float* rf = G + (dir * 64 + (dir ? 32 : 31)) * 64 + d8; const LASQ float* bsr = G + (dir * 64 + row) * 64 + d8; float t8[8], bs[8]; u32x4 w;
              gla_off8(lds, dir, row, d8, bs); UNR for (int e = 0; e < 8; ++e) bs[e] += bsr[e];
              const ldsp_t ob = lds + GL_OP + dir * 3 * 64 * GL_KP + row * GL_KP + d8 * 2;
              UNR for (int e = 0; e < 8; ++e) t8[e] = q8[e] * EXP2((bs[e] - rf[e]) * LOG2E);
              w.x = cvtpk(t8[0], t8[1]); w.y = cvtpk(t8[2], t8[3]); w.z = cvtpk(t8[4], t8[5]); w.w = cvtpk(t8[6], t8[7]); *(LASQ u32x4*)(ob) = w;
              UNR for (int e = 0; e < 8; ++e) t8[e] = q8[e] * EXP2(bs[e] * LOG2E);
              w.x = cvtpk(t8[0], t8[1]); w.y = cvtpk(t8[2], t8[3]); w.z = cvtpk(t8[4], t8[5]); w.w = cvtpk(t8[6], t8[7]); *(LASQ u32x4*)(ob + 64 * GL_KP) = w;
              UNR for (int e = 0; e < 8; ++e) t8[e] = k8[e] * EXP2((rf[e] - bs[e]) * LOG2E);
              w.x = cvtpk(t8[0], t8[1]); w.y = cvtpk(t8[2], t8[3]); w.z = cvtpk(t8[4], t8[5]); w.w = cvtpk(t8[6], t8[7]); *(LASQ u32x4*)(ob + 2 * 64 * GL_KP) = w; } }
        if (unit + nblk < nunits) { int b2, h2, c2; gla_unit_decode(unit + nblk, ncu, c_lo, b2, h2, c2); gla_load(p, R, h2, gla_chunk_row(b2, c2), tid, true); }
        __syncthreads();
        const int tt = wid & 1, vt = wid >> 1; const int t_in = 32 * tt + r32;
        f32x16 o; UNR for (int i = 0; i < 16; ++i) o[i] = 0.f;
        UNR for (int dir = 0; dir < 2; ++dir) {
            const ldsp_t QT = lds + GL_OP + dir * 3 * 64 * GL_KP, QS = QT + 64 * GL_KP, KT = QT + 2 * 64 * GL_KP;
            f32x16 a0, a1; UNR for (int i = 0; i < 16; ++i) { a0[i] = 0.f; a1[i] = 0.f; }
            UNR for (int ks = 0; ks < 4; ++ks) { const int co = (16 * ks + 8 * hh) * 2;
                const bf16x8 k0 = *(const LASQ bf16x8*)(KT + r32 * GL_KP + co), k1 = *(const LASQ bf16x8*)(KT + (32 + r32) * GL_KP + co), qf = *(const LASQ bf16x8*)(QT + t_in * GL_KP + co);
                a0 = MFMA32(k0, qf, a0); a1 = MFMA32(k1, qf, a1); }
            UNR for (int i = 0; i < 16; ++i) { const int s = (i & 3) + 8 * (i >> 2) + 4 * hh;
                a0[i] = (dir == 0 ? s <= t_in : s >= t_in) ? a0[i] : 0.f; a1[i] = (dir == 0 ? s + 32 <= t_in : s + 32 >= t_in) ? a1[i] : 0.f; }
            const ldsp_t vp = lds + GL_V + (4 * hh + (gi >> 2)) * GL_VP + (32 * vt + 16 * ((lane >> 4) & 1) + 4 * (gi & 3)) * 2;
            UNR for (int g = 0; g < 4; ++g) { const bf16x8 vf = cat44(TR16(vp + 16 * g * GL_VP), TR16(vp + (16 * g + 8) * GL_VP));
                const bf16x8 pb = g == 0 ? pack8(a0, 0) : g == 1 ? pack8(a0, 8) : g == 2 ? pack8(a1, 0) : pack8(a1, 8); o = MFMA32(vf, pb, o); }
            UNR for (int ks = 0; ks < 4; ++ks) { const bf16x8 sf = sfr[dir][ks], qsf = *(const LASQ bf16x8*)(QS + t_in * GL_KP + (16 * ks + 8 * hh) * 2); o = MFMA32(sf, qsf, o); }
        }
        float ss = 0.f; UNR for (int i = 0; i < 16; ++i) ss += o[i] * o[i];
        ss += __shfl_xor(ss, 32);
        if (hh == 0) RED[wid * 32 + r32] = ss;
        __syncthreads();
        ss = RED[tt * 32 + r32] + RED[(tt + 2) * 32 + r32] + RED[(tt + 4) * 32 + r32] + RED[(tt + 6) * 32 + r32];
        const float rs = 1.0f / sqrtf(ss / 128 + EPS);
        const int m = m0 + t_in; const bf16* gp = p.P + (size_t)m * PW + C_GC + h * 128 + 32 * vt + 4 * hh; bf16* op = p.XN + (size_t)m * D + MO_C + h * 128 + 32 * vt + 4 * hh;
        UNR for (int g = 0; g < 4; ++g) { const u32x2 gw = gcw[g]; float gv[4]; unsigned uu;
            uu = gw.x << 16; __builtin_memcpy(&gv[0], &uu, 4); uu = gw.x & 0xffff0000u; __builtin_memcpy(&gv[1], &uu, 4); uu = gw.y << 16; __builtin_memcpy(&gv[2], &uu, 4); uu = gw.y & 0xffff0000u; __builtin_memcpy(&gv[3], &uu, 4);
            float r4[4]; UNR for (int e = 0; e < 4; ++e) r4[e] = o[4 * g + e] * rs * onw[4 * g + e] * silu_fast(gv[e]);
            u32x2 w; w.x = cvtpk(r4[0], r4[1]); w.y = cvtpk(r4[2], r4[3]); *(u32x2*)(op + 8 * g) = w; }
        __syncthreads();
    }
}


DEVFN void ph_norm_fast(const Params& p, int l, int which, bool from_input, int mrows, int gw, int NGW, int lane) {
    static_assert(D % 256 == 0, "norm layout"); constexpr int NJ = D / 256;
    const float* g = (which ? p.norm2 : p.norm1) + (size_t)l * D;
    const int R = (mrows + NGW - 1) / NGW, m_lo = gw * R, m_hi = m_lo + R < mrows ? m_lo + R : mrows;
    f32x4 gg[NJ], s1[NJ], s0[NJ], v[NJ], vn[NJ]; int cur_slot = -1;
    UNR for (int j = 0; j < NJ; ++j) gg[j] = *(const f32x4*)(g + 256 * j + 4 * lane);
    if (m_lo < m_hi) { const float* h = from_input ? xrow(p, m_lo) : hrow(p, m_lo); UNR for (int j = 0; j < NJ; ++j) v[j] = *(const f32x4*)(h + 256 * j + 4 * lane); }
    for (int m = m_lo; m < m_hi; ++m) {
        if (m + 1 < m_hi) { const float* hn = from_input ? xrow(p, m + 1) : hrow(p, m + 1); UNR for (int j = 0; j < NJ; ++j) vn[j] = *(const f32x4*)(hn + 256 * j + 4 * lane); }
        const int slot = m < ML ? m / SEQ : BATCH;
        if (slot != cur_slot) { cur_slot = slot; const float* sh = mod_vec(p, l, m, which ? 3 : 0); const float* sc = mod_vec(p, l, m, which ? 4 : 1);
            UNR for (int j = 0; j < NJ; ++j) { s1[j] = *(const f32x4*)(sc + 256 * j + 4 * lane); s0[j] = *(const f32x4*)(sh + 256 * j + 4 * lane); } }
        float ss = 0.f;
        UNR for (int j = 0; j < NJ; ++j) ss += (v[j][0] * v[j][0] + v[j][1] * v[j][1]) + (v[j][2] * v[j][2] + v[j][3] * v[j][3]);
        const float rstd = 1.0f / sqrtf(wave_sum64(ss) / D + EPS);
        bf16* o = p.XN + (size_t)m * D;
        UNR for (int j = 0; j < NJ; ++j) { const int k = 256 * j + 4 * lane;
            float r[4]; UNR for (int e = 0; e < 4; ++e) r[e] = (v[j][e] * rstd * gg[j][e]) * (1.0f + s1[j][e]) + s0[j][e];
            u32x2 w; w.x = cvtpk(r[0], r[1]); w.y = cvtpk(r[2], r[3]); *(u32x2*)(o + k) = w; }
        UNR for (int j = 0; j < NJ; ++j) v[j] = vn[j];
    }
}

DEVFN void ph_post_fast(const Params& p, int l, int gw, int NGW, int lane) {
    if constexpr (NA_W == 256 && DQK_W == 256 && GK_W == 256) {
    const int c4 = 4 * lane;
    for (int m = gw; m < M; m += NGW) {
        bf16* pr = p.P + (size_t)m * PW;
        float x[4];
        UNR for (int seg = 0; seg < 2; ++seg) {
            bf16* v = pr + (seg ? C_KA : C_QA) + c4; unpack4(*(const u32x2*)v, x);
            float ss = (x[0] * x[0] + x[1] * x[1]) + (x[2] * x[2] + x[3] * x[3]);
            ss += __shfl_xor(ss, 1); ss += __shfl_xor(ss, 2); ss += __shfl_xor(ss, 4); ss += __shfl_xor(ss, 8);
            const float r = 1.0f / sqrtf(ss / 64 + EPS) * (seg ? 1.0f : 0.125f * LOG2E); const float* g = (seg ? p.kn_a : p.qn_a) + l * 64 + (c4 & 63);
            u32x2 w; w.x = cvtpk(x[0] * r * g[0], x[1] * r * g[1]); w.y = cvtpk(x[2] * r * g[2], x[3] * r * g[3]); *(u32x2*)v = w;
        }
        UNR for (int seg = 0; seg < 2; ++seg) {
            bf16* v = pr + (seg ? C_KB : C_QB) + c4; unpack4(*(const u32x2*)v, x);
            float ss = (x[0] * x[0] + x[1] * x[1]) + (x[2] * x[2] + x[3] * x[3]);
            ss += __shfl_xor(ss, 1); ss += __shfl_xor(ss, 2); ss += __shfl_xor(ss, 4);
            const float r = 1.0f / sqrtf(ss / 32 + EPS); const float* g = (seg ? p.kn_b : p.qn_b) + l * 32 + (c4 & 31);
            UNR for (int e = 0; e < 4; ++e) x[e] = x[e] * r * g[e];
            float px[4]; UNR for (int e = 0; e < 4; ++e) px[e] = __shfl_xor(x[e], 2);
            if (m < ML) { const int t = m % SEQ, pos = (lane & 4) ? t % GRID_W : t / GRID_W; const bool isx2 = (lane >> 1) & 1; const float* rt = p.ROPE + (pos * 8 + 4 * (lane & 1)) * 2;
                UNR for (int e = 0; e < 4; ++e) { const float cs = rt[2 * e], sn = rt[2 * e + 1]; x[e] = isx2 ? x[e] * cs + px[e] * sn : x[e] * cs - px[e] * sn; } }
            const float s = seg ? 1.0f : 0.17677669529663687f * LOG2E;
            u32x2 w; w.x = cvtpk(x[0] * s, x[1] * s); w.y = cvtpk(x[2] * s, x[3] * s); *(u32x2*)v = w;
        }
        { bf16* v = pr + C_QC + c4; unpack4(*(const u32x2*)v, x); u32x2 w; w.x = cvtpk(x[0] * 0.125f, x[1] * 0.125f); w.y = cvtpk(x[2] * 0.125f, x[3] * 0.125f); *(u32x2*)v = w; }
    }
    }
}

DEVFN void ph_mod_fast(const Params& p, ldsp_t lds, int bid, int nblk, unsigned* arrive_cnt = nullptr, int n_prod = 0) {
    int tid = threadIdx.x; LAUNDER(tid); const int lane = tid & 63, wid = RFL(tid >> 6);
    constexpr int NR = BATCH + 1, KW = D / 8, NU = DEPTH * (6 * D / 64);
    LASQ float* SL = (LASQ float*)lds; LASQ float* RED = SL + NR * D;
    if (bid < NU) { for (int i = tid; i < NR * D; i += 512) { const int j = i / D, k = i % D; SL[i] = silu_f(j < BATCH ? p.c[(size_t)j * D + k] : p.c_ctx[k]); } }
    __syncthreads();
    for (int unit = bid; unit < NU; unit += nblk) {
        const int l = unit / (6 * D / 64), n0 = 64 * (unit % (6 * D / 64));
        const float* w = p.w_ada + ((size_t)l * D + KW * wid) * 6 * D + n0 + lane;
        float acc[NR]; UNR for (int j = 0; j < NR; ++j) acc[j] = 0.f;
        for (int k = 0; k < KW; k += 4) { float wv[4]; UNR for (int e = 0; e < 4; ++e) wv[e] = w[(size_t)(k + e) * 6 * D];
            UNR for (int e = 0; e < 4; ++e) UNR for (int j = 0; j < NR; ++j) acc[j] += SL[j * D + KW * wid + k + e] * wv[e]; }
        UNR for (int j = 0; j < NR; ++j) RED[(wid * NR + j) * 64 + lane] = acc[j];
        __syncthreads();
        for (int i = tid; i < NR * 64; i += 512) { const int j = i / 64, ln = i % 64; float s = p.b_ada[(size_t)l * 6 * D + n0 + ln]; UNR for (int ww = 0; ww < 8; ++ww) s += RED[(ww * NR + j) * 64 + ln];
            p.MOD[((size_t)l * NR + j) * 6 * D + n0 + ln] = s; }
#ifndef HOST_TEST
        if (unit < n_prod) asm volatile("s_waitcnt vmcnt(0)" ::: "memory");
#endif
        __syncthreads();
#ifndef HOST_TEST
        if (unit < n_prod && tid == 0) { __builtin_amdgcn_fence(__ATOMIC_RELEASE, "agent"); asm volatile("s_waitcnt vmcnt(0)" ::: "memory"); (void)xb_add(arrive_cnt, 1u); }
#endif
    }
}
DEVFN void ph_rope_table(const Params& p, long gtid, long gsize) {
    for (long i = gtid; i < 64 * 8; i += gsize) { const int pos = (int)(i / 8), f = (int)(i % 8); const float inv = expf(-((float)f / 8.0f) * logf(10000.0f)); const float ang = (float)pos * inv;
        p.ROPE[2 * i] = cosf(ang); p.ROPE[2 * i + 1] = sinf(ang); }
}

#ifdef HOST_TEST
#define ATOMIC_ADDF(p, v) (*(p) += (v))
#else
#define ATOMIC_ADDF(p, v) atomicAdd((p), (v))
#endif
namespace pg8 {
struct EpiGU {
    static constexpr bool PERM = true, AFTER_DRAIN = false;
    bf16* ACT; bf16* EA; bf16* EU; const float* cw; const float* cb;
    const float* SS; const float* b2;
    struct Pre { f32x4 w0[2], w1[2], w2[2], bb[2], ba[2], bu[2]; float ssv[2][4]; };
    DEVFN Pre pre(const Unit& u, int wr, int wc, int fr, int fq) const {
        Pre P; const int f0 = 128 * u.pn + 32 * wc + 8 * fq; const int slot = u.pm * BM < ML ? (u.pm * BM) / SEQ : BATCH;
        const float* bp = b2 + (size_t)slot * 2 * FFN + 256 * u.pn + 32 * wc + 8 * fq;
        UNR for (int q = 0; q < 2; ++q) { P.w0[q] = *(const f32x4*)(cw + f0 + 4 * q); P.w1[q] = *(const f32x4*)(cw + FFN + f0 + 4 * q); P.w2[q] = *(const f32x4*)(cw + 2 * FFN + f0 + 4 * q);
            P.bb[q] = *(const f32x4*)(cb + f0 + 4 * q); P.ba[q] = *(const f32x4*)(bp + 4 * q); P.bu[q] = *(const f32x4*)(bp + 128 + 4 * q); }
        UNR for (int ai = 0; ai < 2; ++ai) UNR for (int m = 0; m < 4; ++m) P.ssv[ai][m] = SS[u.pm * BM + ai * HALF + wr * 64 + 16 * m + fr];
        return P;
    }
    DEVFN void operator()(const f32x4 (&acc)[2][2][4][2], const Unit& u, int wr, int wc, int fr, int fq, const Pre& P) const {
        const int f0 = 128 * u.pn + 32 * wc + 8 * fq; const int lane = fq * 16 + fr;
        const int src_prev = (lane & ~15) | ((fr + 15) & 15), src_next = (lane & ~15) | ((fr + 1) & 15);
        float w0[8], w1[8], w2[8], bb[8], ba[8], bu[8];
        UNR for (int e = 0; e < 8; ++e) { w0[e] = P.w0[e >> 2][e & 3]; w1[e] = P.w1[e >> 2][e & 3]; w2[e] = P.w2[e >> 2][e & 3]; bb[e] = P.bb[e >> 2][e & 3]; ba[e] = P.ba[e >> 2][e & 3]; bu[e] = P.bu[e >> 2][e & 3]; }
        UNR for (int ai = 0; ai < 2; ++ai) {
            const int rowb = u.pm * BM + ai * HALF + wr * 64;
            float rs[4]; UNR for (int m = 0; m < 4; ++m) rs[m] = RSQ(P.ssv[ai][m] * (1.0f / D) + EPS);
#define GU_A(m_, n_, e_) (rs[m_] * acc[ai][0][m_][n_][e_] + ba[4 * (n_) + (e_)])
#define GU_U(m_, n_, e_) (rs[m_] * acc[ai][1][m_][n_][e_] + bu[4 * (n_) + (e_)])
            UNR for (int m = 0; m < 4; ++m) {
                const int row = rowb + 16 * m + fr; float act[8], av[8], uv[8];
                UNR for (int n = 0; n < 2; ++n) UNR for (int e = 0; e < 4; ++e) {
                    const float cur = GU_A(m, n, e);
                    const float sp = (fr == 15 && m > 0) ? GU_A(m > 0 ? m - 1 : 0, n, e) : cur;
                    const float sn = (fr == 0 && m < 3) ? GU_A(m < 3 ? m + 1 : 3, n, e) : cur;
                    const float prev = ROR16(sp, 1), next = ROR16(sn, 15);
                    const float a = bb[4 * n + e] + w0[4 * n + e] * prev + w1[4 * n + e] * cur + w2[4 * n + e] * next;
                    av[4 * n + e] = cur; uv[4 * n + e] = GU_U(m, n, e);
                    act[4 * n + e] = silu_fast(a) * uv[4 * n + e];
                }
                const bool e0 = (m == 0 && fr == 0), e63 = (m == 3 && fr == 15), e1 = (m == 0 && fr == 1), e62 = (m == 3 && fr == 14);
                { u32x4 w; w.x = cvtpk(act[0], act[1]); w.y = cvtpk(act[2], act[3]); w.z = cvtpk(act[4], act[5]); w.w = cvtpk(act[6], act[7]); *(u32x4*)(ACT + (size_t)row * FFN + f0) = w; }
                if (e0 || e1 || e62 || e63) { u32x4 w; w.x = cvtpk(av[0], av[1]); w.y = cvtpk(av[2], av[3]); w.z = cvtpk(av[4], av[5]); w.w = cvtpk(av[6], av[7]);
                    *(u32x4*)(EA + ((size_t)(rowb / 64) * 4 + (e0 ? 0 : e1 ? 1 : e62 ? 2 : 3)) * FFN + f0) = w; }
                if (e0 || e63) { u32x4 w; w.x = cvtpk(uv[0], uv[1]); w.y = cvtpk(uv[2], uv[3]); w.z = cvtpk(uv[4], uv[5]); w.w = cvtpk(uv[6], uv[7]);
                    *(u32x4*)(EU + ((size_t)(rowb / 64) * 2 + (e0 ? 0 : 1)) * FFN + f0) = w; }
            }
#undef GU_A
#undef GU_U
        }
    }
};
template <bool OUT_BF16, bool BASE_BF16, bool FUSE> struct EpiResidT {
    static constexpr bool PERM = true, AFTER_DRAIN = false;
    const float* base_lat; const float* base_ctx; float* out_lat; float* out_ctx; const float* gate;
    bf16* XNo; const float* nw; const float* scb; float* SS;
    const bf16* baseb; bf16* outb;
    struct Pre { f32x4 gv[2][2], gm[2][2]; };
    DEVFN Pre pre(const Unit& u, int wr, int wc, int fr, int fq) const {
        Pre P; const int slot = u.pm * BM < ML ? (u.pm * BM) / SEQ : BATCH; const float* g = gate + (size_t)slot * 6 * D; const int col0 = u.pn * BM + wc * 32 + 8 * fq;
        UNR for (int bj = 0; bj < 2; ++bj) UNR for (int n = 0; n < 2; ++n) { const int c = col0 + bj * HALF + 4 * n; P.gv[bj][n] = *(const f32x4*)(g + c);
            if (FUSE) { const float* sc = scb + (size_t)slot * 6 * D; const f32x4 w = *(const f32x4*)(nw + c), s1 = *(const f32x4*)(sc + c); P.gm[bj][n] = w * (1.0f + s1); } else P.gm[bj][n] = P.gv[bj][n]; }
        return P;
    }
    DEVFN void operator()(const f32x4 (&acc)[2][2][4][2], const Unit& u, int wr, int wc, int fr, int fq, const Pre& P) const {
        const bool lat = u.pm * BM < ML;
        const int lrow0 = (lat ? u.pm * BM : u.pm * BM - ML) + wr * 64 + fr, grow0 = u.pm * BM + wr * 64 + fr;
        const float* bs = lat ? base_lat : base_ctx; float* os = lat ? out_lat : out_ctx;
        const int col0 = u.pn * BM + wc * 32 + 8 * fq;
        f32x4 gv[2][2], gm[2][2];
        UNR for (int bj = 0; bj < 2; ++bj) UNR for (int n = 0; n < 2; ++n) { gv[bj][n] = P.gv[bj][n]; gm[bj][n] = P.gm[bj][n]; }
        UNR for (int ai = 0; ai < 2; ++ai) UNR for (int m = 0; m < 4; ++m) {
            const size_t off = (size_t)(lrow0 + ai * HALF + m * 16) * D + col0, goff = (size_t)(grow0 + ai * HALF + m * 16) * D + col0; float ss = 0.f;
            UNR for (int bj = 0; bj < 2; ++bj) { const int cc = bj * HALF;
                f32x4 b0, b1;
                if (BASE_BF16) { float t8[8]; const u32x4 bw = *(const u32x4*)(baseb + goff + cc); unpack8(bw, t8); b0 = (f32x4){t8[0], t8[1], t8[2], t8[3]}; b1 = (f32x4){t8[4], t8[5], t8[6], t8[7]}; }
                else { b0 = *(const f32x4*)(bs + off + cc); b1 = *(const f32x4*)(bs + off + cc + 4); }
                const f32x4 o0 = b0 + gv[bj][0] * acc[ai][bj][m][0], o1 = b1 + gv[bj][1] * acc[ai][bj][m][1];
                if (OUT_BF16) { u32x4 w1; w1.x = cvtpk(o0[0], o0[1]); w1.y = cvtpk(o0[2], o0[3]); w1.z = cvtpk(o1[0], o1[1]); w1.w = cvtpk(o1[2], o1[3]); *(u32x4*)(outb + goff + cc) = w1; }
                else { *(f32x4*)(os + off + cc) = o0; *(f32x4*)(os + off + cc + 4) = o1; }
                if (FUSE) { ss += ((o0[0] * o0[0] + o0[1] * o0[1]) + (o0[2] * o0[2] + o0[3] * o0[3])) + ((o1[0] * o1[0] + o1[1] * o1[1]) + (o1[2] * o1[2] + o1[3] * o1[3]));
                    const f32x4 x0 = o0 * gm[bj][0], x1 = o1 * gm[bj][1]; u32x4 w2; w2.x = cvtpk(x0[0], x0[1]); w2.y = cvtpk(x0[2], x0[3]); w2.z = cvtpk(x1[0], x1[1]); w2.w = cvtpk(x1[2], x1[3]); *(u32x4*)(XNo + goff + cc) = w2; } }
            if (FUSE) { ss += __shfl_xor(ss, 16); ss += __shfl_xor(ss, 32); if (fq == 0) ATOMIC_ADDF(SS + grow0 + ai * HALF + m * 16, ss); }
        }
    }
};
typedef EpiResidT<false, false, true> EpiResidN;
struct EpiInprojN {
    static constexpr bool PERM = true, AFTER_DRAIN = false;
    bf16* P; bf16* AFB; const float* SS; const float* b2; int ldb;
    DEVFN void operator()(const f32x4 (&acc)[2][2][4][2], const Unit& u, int wr, int wc, int fr, int fq) const {
        const int row0 = u.pm * BM + wr * 64 + fr; const int col0 = u.pn * BM + wc * 32 + 8 * fq;
        const int slot = u.pm * BM < ML ? (u.pm * BM) / SEQ : BATCH;
        f32x4 bv[2][2]; UNR for (int bj = 0; bj < 2; ++bj) UNR for (int n = 0; n < 2; ++n) bv[bj][n] = *(const f32x4*)(b2 + (size_t)slot * ldb + col0 + bj * HALF + 4 * n);
        UNR for (int ai = 0; ai < 2; ++ai) UNR for (int m = 0; m < 4; ++m) { const size_t row = (size_t)(row0 + ai * HALF + m * 16); const float rs = 1.0f / sqrtf(SS[row] * (1.0f / D) + EPS);
            UNR for (int bj = 0; bj < 2; ++bj) { const f32x4 v0 = acc[ai][bj][m][0] * rs + bv[bj][0], v1 = acc[ai][bj][m][1] * rs + bv[bj][1]; const int col = col0 + bj * HALF;
                u32x4 w; w.x = cvtpk(v0[0], v0[1]); w.y = cvtpk(v0[2], v0[3]); w.z = cvtpk(v1[0], v1[1]); w.w = cvtpk(v1[2], v1[3]);
                if (col < PW) *(u32x4*)(P + row * PW + col) = w;
                else if (col < PW + 32) *(u32x4*)(AFB + row * 32 + (col - PW)) = w; } }
    }
};
}
namespace pg8 {
template <bool NORMIN> struct EpiInprojPost {
    static constexpr bool PERM = true, AFTER_DRAIN = false;
    bf16* P; bf16* AFB; const float* SS; const float* b2; int ldb;
    const float* qn_a; const float* kn_a; const float* qn_b; const float* kn_b; const float* rope;
    struct Pre { f32x4 bias[2][2]; float ssv[2][4]; };
    DEVFN Pre pre(const Unit& u, int wr, int wc, int fr, int fq) const {
        Pre PR; const int slot = u.pm * BM < ML ? (u.pm * BM) / SEQ : BATCH; const int vcol0 = wc * 32 + 8 * fq;
        UNR for (int bj = 0; bj < 2; ++bj) UNR for (int q = 0; q < 2; ++q) PR.bias[bj][q] = NORMIN ? *(const f32x4*)(b2 + (size_t)slot * ldb + u.pn * BM + bj * HALF + vcol0 + 4 * q) : (f32x4){0.f, 0.f, 0.f, 0.f};
        UNR for (int ai = 0; ai < 2; ++ai) UNR for (int m = 0; m < 4; ++m) PR.ssv[ai][m] = NORMIN ? SS[u.pm * BM + wr * 64 + fr + ai * HALF + m * 16] : 0.f;
        return PR;
    }
    DEVFN void operator()(const f32x4 (&acc)[2][2][4][2], const Unit& u, int wr, int wc, int fr, int fq, const Pre& PR) const {
        const int row0 = u.pm * BM + wr * 64 + fr; const int pn = u.pn; const int vcol0 = wc * 32 + 8 * fq;
        const bool lat = u.pm * BM < ML;
        float bias[2][8];
        if (NORMIN) { UNR for (int bj = 0; bj < 2; ++bj) UNR for (int e = 0; e < 8; ++e) bias[bj][e] = PR.bias[bj][e >> 2][e & 3]; }
        UNR for (int ai = 0; ai < 2; ++ai) UNR for (int m = 0; m < 4; ++m) {
            const int row = row0 + ai * HALF + m * 16; float v[2][8];
            { float rs = 1.f; if (NORMIN) rs = RSQ(PR.ssv[ai][m] * (1.0f / D) + EPS);
              UNR for (int bj = 0; bj < 2; ++bj) UNR for (int e = 0; e < 8; ++e) { const float a = acc[ai][bj][m][e >> 2][e & 3]; v[bj][e] = NORMIN ? a * rs + bias[bj][e] : a; } }
            if (pn <= 1) {
                float ss = 0.f; UNR for (int bj = 0; bj < 2; ++bj) UNR for (int e = 0; e < 8; ++e) ss += v[bj][e] * v[bj][e];
                ss += __shfl_xor(ss, 16); ss += __shfl_xor(ss, 32);
                const float r = RSQ(ss * (1.0f / 64) + EPS) * (pn == 0 ? 0.125f * LOG2E : 1.0f); const float* g = (pn == 0 ? qn_a : kn_a);
                UNR for (int bj = 0; bj < 2; ++bj) { u32x4 w; float o[8]; UNR for (int e = 0; e < 8; ++e) o[e] = v[bj][e] * r * g[32 * bj + 8 * fq + e];
                    w.x = cvtpk(o[0], o[1]); w.y = cvtpk(o[2], o[3]); w.z = cvtpk(o[4], o[5]); w.w = cvtpk(o[6], o[7]);
                    *(u32x4*)(P + (size_t)row * PW + pn * BM + 64 * wc + 32 * bj + 8 * fq) = w; }
            } else if (pn == 3 || pn == 4) {
                const float* g = (pn == 3 ? qn_b : kn_b); int t = 0, prow = 0, pcol = 0; if (lat) { t = row % SEQ; prow = t / GRID_W; pcol = t % GRID_W; }
                UNR for (int bj = 0; bj < 2; ++bj) {
                    float ss = 0.f; UNR for (int e = 0; e < 8; ++e) ss += v[bj][e] * v[bj][e];
                    ss += __shfl_xor(ss, 16); ss += __shfl_xor(ss, 32);
                    const float r = RSQ(ss * (1.0f / 32) + EPS); float o[8], po[8];
                    UNR for (int e = 0; e < 8; ++e) o[e] = v[bj][e] * r * g[8 * fq + e];
                    UNR for (int e = 0; e < 8; ++e) po[e] = __shfl_xor(o[e], 16);
                    if (lat) { const float* rt = rope + ((fq & 2) ? pcol : prow) * 16; const bool isx2 = fq & 1;
                        UNR for (int e = 0; e < 8; ++e) { const float cs = rt[2 * e], sn = rt[2 * e + 1]; o[e] = isx2 ? o[e] * cs + po[e] * sn : o[e] * cs - po[e] * sn; } }
                    const float sc = pn == 3 ? 0.17677669529663687f * LOG2E : 1.0f; u32x4 w;
                    w.x = cvtpk(o[0] * sc, o[1] * sc); w.y = cvtpk(o[2] * sc, o[3] * sc); w.z = cvtpk(o[4] * sc, o[5] * sc); w.w = cvtpk(o[6] * sc, o[7] * sc);
                    *(u32x4*)(P + (size_t)row * PW + pn * BM + bj * HALF + vcol0) = w; }
            } else {
                const float sc = pn == 6 ? 0.125f : 1.0f;
                UNR for (int bj = 0; bj < 2; ++bj) { const int col = pn * BM + bj * HALF + vcol0; u32x4 w;
                    w.x = cvtpk(v[bj][0] * sc, v[bj][1] * sc); w.y = cvtpk(v[bj][2] * sc, v[bj][3] * sc); w.z = cvtpk(v[bj][4] * sc, v[bj][5] * sc); w.w = cvtpk(v[bj][6] * sc, v[bj][7] * sc);
                    if (col < PW) *(u32x4*)(P + (size_t)row * PW + col) = w;
                    else if (col < PW + 32) *(u32x4*)(AFB + (size_t)row * 32 + (col - PW)) = w; }
            }
        }
    }
};
}
DEVFN void ph_bias2(const bf16* Bt, int N, const float* shb, float* out, int gw, int NGW, int lane) {
    static_assert(D % 512 == 0, "bias2 layout"); constexpr int NJ = D / 512, SP = 3;
    for (int s0 = 0; s0 <= BATCH; s0 += SP) {
        f32x4 sv[SP][NJ][2];
        UNR for (int s = 0; s < SP; ++s) { const int sl = s0 + s <= BATCH ? s0 + s : BATCH; const float* sh = shb + (size_t)sl * 6 * D;
            UNR for (int j = 0; j < NJ; ++j) UNR for (int q = 0; q < 2; ++q) sv[s][j][q] = *(const f32x4*)(sh + 512 * j + 8 * lane + 4 * q); }
        for (int n = gw; n < N; n += NGW) {
            float w[NJ][8]; UNR for (int j = 0; j < NJ; ++j) ld8(Bt + (size_t)n * D + 512 * j + 8 * lane, w[j]);
            float a[SP]; UNR for (int s = 0; s < SP; ++s) { a[s] = 0.f; UNR for (int j = 0; j < NJ; ++j) UNR for (int e = 0; e < 8; ++e) a[s] += w[j][e] * sv[s][j][e >> 2][e & 3]; }
            UNR for (int s = 0; s < SP; ++s) a[s] = wave_sum64(a[s]);
            if (lane == 0) { UNR for (int s = 0; s < SP; ++s) if (s0 + s <= BATCH) out[(size_t)(s0 + s) * N + n] = a[s]; }
        }
    }
}
DEVFN void ffn_fix_rowtile(const Params& p, int l, int pm, int tid) {
    if (tid >= FFN / 8) return;
    const float* cw = p.conv_w + (size_t)l * 3 * FFN; const float* cb = p.conv_b + (size_t)l * FFN; const int f0 = 8 * tid;
    float wb[8], w0[8], w1[8], w2[8];
    UNR for (int q = 0; q < 2; ++q) { const f32x4 vb = *(const f32x4*)(cb + f0 + 4 * q), v0 = *(const f32x4*)(cw + f0 + 4 * q), v1 = *(const f32x4*)(cw + FFN + f0 + 4 * q), v2 = *(const f32x4*)(cw + 2 * FFN + f0 + 4 * q);
        UNR for (int e = 0; e < 4; ++e) { wb[4 * q + e] = vb[e]; w0[4 * q + e] = v0[e]; w1[4 * q + e] = v1[e]; w2[4 * q + e] = v2[e]; } }
    {
        U4 curw[8], uuw[8], prvw[8], nxtw[8];
        UNR for (int k = 0; k < 8; ++k) { const int kb = 4 * pm + (k >> 1), edge = k & 1; const int row = 64 * kb + (edge ? 63 : 0);
            int pos, len; if (row < ML) { pos = row & (SEQ - 1); len = SEQ; } else { pos = (row - ML) & (CTX - 1); len = CTX; }
            const unsigned ea0 = (unsigned)kb * 4u * (unsigned)FFN + (unsigned)f0;
            curw[k] = *(const U4*)(p.EA + ea0 + (edge ? 3u : 0u) * (unsigned)FFN); uuw[k] = *(const U4*)(p.EU + ((unsigned)kb * 2u + (unsigned)edge) * (unsigned)FFN + (unsigned)f0);
            prvw[k] = curw[k]; nxtw[k] = curw[k];
            if (edge == 0) { if (pos > 0) prvw[k] = *(const U4*)(p.EA + ea0 - (unsigned)FFN); nxtw[k] = *(const U4*)(p.EA + ea0 + (unsigned)FFN); }
            else { prvw[k] = *(const U4*)(p.EA + ea0 + 2u * (unsigned)FFN); if (pos < len - 1) nxtw[k] = *(const U4*)(p.EA + ea0 + 4u * (unsigned)FFN); } }
        UNR for (int k = 0; k < 8; ++k) { const int kb = 4 * pm + (k >> 1), edge = k & 1; const int row = 64 * kb + (edge ? 63 : 0);
            int pos, len; if (row < ML) { pos = row & (SEQ - 1); len = SEQ; } else { pos = (row - ML) & (CTX - 1); len = CTX; }
            const bool hp = edge == 1 || pos > 0, hn = edge == 0 || pos < len - 1;
            float cur[8], prv[8], nxt[8], uu[8], act[8]; ld8((const bf16*)&curw[k], cur); ld8((const bf16*)&uuw[k], uu); ld8((const bf16*)&prvw[k], prv); ld8((const bf16*)&nxtw[k], nxt);
            UNR for (int e = 0; e < 8; ++e) { float a = wb[e] + w1[e] * cur[e]; if (hp) a += w0[e] * prv[e]; if (hn) a += w2[e] * nxt[e]; act[e] = silu_fast(a) * uu[e]; }
            u32x4 w; w.x = cvtpk(act[0], act[1]); w.y = cvtpk(act[2], act[3]); w.z = cvtpk(act[4], act[5]); w.w = cvtpk(act[6], act[7]); *(u32x4*)(p.ACT + (unsigned)row * (unsigned)FFN + (unsigned)f0) = w; }
    }
}
DEVFN void ph_ffn_fix(const Params& p, int l, int mrows, long gtid, long gsize) {
    const float* cw = p.conv_w + (size_t)l * 3 * FFN; const float* cb = p.conv_b + (size_t)l * FFN;
    const long N = (long)(mrows / 64) * 2 * (FFN / 8);
    for (long i = gtid; i < N; i += gsize) {
        const int f0 = (int)(i % (FFN / 8)) * 8, edge = (int)((i / (FFN / 8)) & 1), kb = (int)(i / (2 * (FFN / 8)));
        const int row = 64 * kb + (edge ? 63 : 0); int pos, len; if (row < ML) { pos = row % SEQ; len = SEQ; } else { pos = (row - ML) % CTX; len = CTX; }
        float cur[8], prv[8], nxt[8], uu[8];
        ld8(p.EA + ((size_t)kb * 4 + (edge ? 3 : 0)) * FFN + f0, cur); ld8(p.EU + ((size_t)kb * 2 + edge) * FFN + f0, uu);
        if (edge == 0) { if (pos > 0) ld8(p.EA + ((size_t)(kb - 1) * 4 + 3) * FFN + f0, prv); ld8(p.EA + ((size_t)kb * 4 + 1) * FFN + f0, nxt); }
        else { ld8(p.EA + ((size_t)kb * 4 + 2) * FFN + f0, prv); if (pos < len - 1) ld8(p.EA + ((size_t)(kb + 1) * 4 + 0) * FFN + f0, nxt); }
        const bool hp = edge == 1 || pos > 0, hn = edge == 0 || pos < len - 1; float act[8];
        float wb[8], w0[8], w1[8], w2[8];
        UNR for (int q = 0; q < 2; ++q) { const f32x4 vb = *(const f32x4*)(cb + f0 + 4 * q), v0 = *(const f32x4*)(cw + f0 + 4 * q), v1 = *(const f32x4*)(cw + FFN + f0 + 4 * q), v2 = *(const f32x4*)(cw + 2 * FFN + f0 + 4 * q);
            UNR for (int e = 0; e < 4; ++e) { wb[4 * q + e] = vb[e]; w0[4 * q + e] = v0[e]; w1[4 * q + e] = v1[e]; w2[4 * q + e] = v2[e]; } }
        UNR for (int e = 0; e < 8; ++e) { float a = wb[e] + w1[e] * cur[e]; if (hp) a += w0[e] * prv[e]; if (hn) a += w2[e] * nxt[e]; act[e] = silu_fast(a) * uu[e]; }
        u32x4 w; w.x = cvtpk(act[0], act[1]); w.y = cvtpk(act[2], act[3]); w.z = cvtpk(act[4], act[5]); w.w = cvtpk(act[6], act[7]); *(u32x4*)(p.ACT + (size_t)row * FFN + f0) = w;
    }
}
namespace pg8 {
template <bool NOSTORE = false> struct EpiInprojT {
    static constexpr bool PERM = true, AFTER_DRAIN = false;
    bf16_t* P; bf16_t* AFB;
    __device__ __forceinline__ void operator()(const f32x4 (&acc)[2][2][4][2], const Unit& u, int wr, int wc, int fr, int fq) const {
        const int row0 = u.pm * BM + wr * 64 + fr; const int col0 = u.pn * BM + wc * 32 + 8 * fq;
#pragma unroll
        for (int ai = 0; ai < 2; ++ai)
#pragma unroll
            for (int m = 0; m < 4; ++m) { const size_t row = (size_t)(row0 + ai * HALF + m * 16);
#pragma unroll
                for (int bj = 0; bj < 2; ++bj) { const f32x4 v0 = acc[ai][bj][m][0], v1 = acc[ai][bj][m][1]; const int col = col0 + bj * HALF;
                    u32x4 w; w.x = cvt_pk_bf16(v0[0], v0[1]); w.y = cvt_pk_bf16(v0[2], v0[3]); w.z = cvt_pk_bf16(v1[0], v1[1]); w.w = cvt_pk_bf16(v1[2], v1[3]);
                    if (NOSTORE) { *(u32x4*)(P + (row & 63) * PW + (col & 1023)) = w; }
                    else if (col < PW) *(u32x4*)(P + row * PW + col) = w;
                    else if (col < PW + 32) *(u32x4*)(AFB + row * 32 + (col - PW)) = w; } }
    }
};
typedef EpiInprojT<false> EpiInproj;
struct EpiBf16Plain {
    static constexpr bool PERM = true, AFTER_DRAIN = false;
    bf16_t* O; int ldc;
    __device__ __forceinline__ void operator()(const f32x4 (&acc)[2][2][4][2], const Unit& u, int wr, int wc, int fr, int fq) const {
        const int row0 = u.pm * BM + wr * 64 + fr; const int col0 = u.pn * BM + wc * 32 + 8 * fq;
#pragma unroll
        for (int ai = 0; ai < 2; ++ai)
#pragma unroll
            for (int m = 0; m < 4; ++m) { bf16_t* rowp = O + (size_t)(row0 + ai * HALF + m * 16) * ldc + col0;
#pragma unroll
                for (int bj = 0; bj < 2; ++bj) { const f32x4 v0 = acc[ai][bj][m][0], v1 = acc[ai][bj][m][1];
                    u32x4 w; w.x = cvt_pk_bf16(v0[0], v0[1]); w.y = cvt_pk_bf16(v0[2], v0[3]); w.z = cvt_pk_bf16(v1[0], v1[1]); w.w = cvt_pk_bf16(v1[2], v1[3]);
                    *(u32x4*)(rowp + bj * HALF) = w; } }
    }
};
struct EpiResid {
    static constexpr bool PERM = false, AFTER_DRAIN = false;
    const float* base_lat; const float* base_ctx; float* out_lat; float* out_ctx; const float* gate;
    __device__ __forceinline__ void operator()(const f32x4 (&acc)[2][2][4][2], const Unit& u, int wr, int wc, int fr, int fq) const {
        const bool lat = u.pm * BM < ML;
        const int slot = lat ? (u.pm * BM) / SEQ : BATCH;
        const int lrow0 = (lat ? u.pm * BM : u.pm * BM - ML) + wr * 64 + fr;
        const float* bs = lat ? base_lat : base_ctx; float* os = lat ? out_lat : out_ctx;
        const float* g = gate + (size_t)slot * 6 * D;
        const int col0 = u.pn * BM + wc * 32 + 4 * fq;
        f32x4 gv[2][2];
#pragma unroll
        for (int bj = 0; bj < 2; ++bj)
#pragma unroll
            for (int n = 0; n < 2; ++n) gv[bj][n] = *(const f32x4*)(g + col0 + bj * HALF + n * 16);
#pragma unroll
        for (int ai = 0; ai < 2; ++ai)
#pragma unroll
            for (int m = 0; m < 4; ++m) { const size_t off = (size_t)(lrow0 + ai * HALF + m * 16) * D + col0;
#pragma unroll
                for (int bj = 0; bj < 2; ++bj)
#pragma unroll
                    for (int n = 0; n < 2; ++n) { const f32x4 b = *(const f32x4*)(bs + off + bj * HALF + n * 16);
                        *(f32x4*)(os + off + bj * HALF + n * 16) = b + gv[bj][n] * acc[ai][bj][m][n]; } }
    }
};
}

constexpr size_t MiB = 1u << 20;
constexpr size_t WS_CTL = 0, CTL_ZERO_BYTES = 1 * MiB;
constexpr size_t WS_MOD = 1 * MiB, WS_ROPE = 2 * MiB;
constexpr size_t WS_WIN = 3 * MiB, WS_WOUT = 10 * MiB, WS_WGU = 12 * MiB, WS_WD = 23 * MiB;
constexpr size_t WS_HC = 29 * MiB, WS_XN = 37 * MiB, WS_AFB = 105 * MiB, WS_R1 = 108 * MiB, WS_R2 = 312 * MiB;
constexpr size_t WS_GO = WS_R2, WS_ALF = WS_R2 + 68 * MiB, WS_ALB = WS_R2 + 102 * MiB, WS_DT = WS_R2 + 136 * MiB, WS_US = WS_R2, WS_AD = WS_R2 + 136 * MiB, WS_EA = WS_R1, WS_EU = WS_R1 + 16 * MiB, WS_XN2 = WS_R1 + 40 * MiB, WS_HB = WS_R1 + 112 * MiB, WS_SS1 = WS_ROPE + 256 * 1024, WS_SS2 = WS_ROPE + 400 * 1024, WS_B2IN = WS_ROPE + 544 * 1024, WS_B2GU = WS_ROPE + 672 * 1024, WS_END = 499 * MiB;
constexpr int NPAD_IN = (IN_W + 255) / 256 * 256;
static_assert(WS_WIN + (size_t)NPAD_IN * D * 2 <= WS_WOUT && WS_WOUT + (size_t)D * D * 2 <= WS_WGU && WS_WGU + (size_t)2 * FFN * D * 2 <= WS_WD && WS_WD + (size_t)D * FFN * 2 <= WS_HC, "weights map");
static_assert(WS_HC + (size_t)MC * D * 4 <= WS_XN && WS_XN + (size_t)M * D * 2 <= WS_AFB && WS_AFB + (size_t)M * 32 * 2 <= WS_R1, "ws map 1");
static_assert(WS_R1 + (size_t)M * PW * 2 <= WS_R2 && WS_R1 + (size_t)M * GUP * 2 <= WS_R2 && WS_R2 + (size_t)M * FFN * 2 <= WS_END, "ws map 2");
static_assert(WS_ALB + (size_t)M * GK_W * 4 <= WS_DT && WS_DT + (size_t)M * DV_W * 4 <= WS_END, "ws map 4");
static_assert(WS_XN2 + (size_t)M * D * 2 <= WS_HB && WS_HB + (size_t)M * D * 2 <= WS_R2, "ws map 8");
static_assert(WS_XN2 + (size_t)M * D * 2 <= WS_R2 && WS_EU + (size_t)(M / 64) * 2 * FFN * 2 <= WS_XN2 && (size_t)M * 4 <= 144 * 1024 && (size_t)9 * NPAD_IN * 4 <= 128 * 1024 && WS_B2GU + (size_t)9 * 2 * FFN * 4 <= WS_WIN, "ws map 7");
static_assert(WS_EA + (size_t)(M / 64) * 4 * FFN * 2 <= WS_EU && WS_EU + (size_t)(M / 64) * 2 * FFN * 2 <= WS_R2, "ws map 6");
static_assert(WS_US + (size_t)BATCH * GLH * 2 * NCH * 32768 <= WS_AD && WS_AD + (size_t)BATCH * GLH * 2 * NCH * 256 <= WS_END, "ws map 5");
static_assert(WS_GO + (size_t)M * GV_W * 4 <= WS_ALF && WS_ALF + (size_t)M * GK_W * 4 <= WS_ALB && WS_ALB + (size_t)M * GK_W * 4 <= WS_END, "ws map 3");
constexpr int CW_BAR = 4096, CW_SPLIT = 16384;
#ifndef SPLITK
#define SPLITK 4
#endif
static_assert(WS_R2 + (size_t)64 * SPLITK * 262144 <= WS_END && WS_XN2 + (size_t)64 * SPLITK * 262144 <= WS_HB, "split-K partials");
constexpr int RING_OFF = 0, RING_BYTES = 131072;
constexpr int LDSCTL_OFF = RING_BYTES, MISC_OFF = LDSCTL_OFF + 320;
constexpr int LDS_BYTES = 147456;
constexpr int NWAVES = 8, NTHREADS = 512;

__device__ __forceinline__ void transpose_item(const float* W, int ldw, bf16* WT, int ldt, int k0, int n0, int dst_row0, LAS float* scr, int lane) {
    float tmp[32];
#pragma unroll
    for (int i = 0; i < 32; ++i) { const int kk = 2 * i + (lane >> 5); tmp[i] = W[(size_t)(k0 + kk) * ldw + n0 + (lane & 31)]; }
#pragma unroll
    for (int i = 0; i < 32; ++i) { const int kk = 2 * i + (lane >> 5); scr[kk * 33 + (lane & 31)] = tmp[i]; }
    LDS_WAIT(); asm volatile("" ::: "memory");
    const int c = lane & 7;
#pragma unroll
    for (int j = 0; j < 4; ++j) { const int n = (lane >> 3) + 8 * j; const LAS float* s = scr + (8 * c) * 33 + n;
        v4u o; o.x = pk2(s[0 * 33], s[1 * 33]); o.y = pk2(s[2 * 33], s[3 * 33]); o.z = pk2(s[4 * 33], s[5 * 33]); o.w = pk2(s[6 * 33], s[7 * 33]);
        *(GAS v4u*)(WT + (size_t)(dst_row0 + n) * ldt + k0 + 8 * c) = o; }
    LDS_WAIT(); asm volatile("" ::: "memory");
}
__device__ __forceinline__ void ph_weights(const Params& p, int l, LAS unsigned char* lds, int gw, int NGW, int wave, int lane, int mask = 15) {
    LAS float* scr = (LAS float*)(lds + RING_OFF + wave * 16384);
    constexpr int NB_IN = IN_W / 32, I_IN = (D / 64) * NB_IN, I_OUT = (D / 64) * (D / 32), I_G = (D / 64) * (FFN / 32), I_D = (FFN / 64) * (D / 32);
    constexpr int NITEMS = I_IN + I_OUT + 2 * I_G + I_D;
    static_assert(IN_W % 32 == 0 && FFN % 64 == 0, "transpose items");
    for (int it = gw; it < NITEMS; it += NGW) {
        int r = it;
        if (r < I_IN) { if (!(mask & 1)) continue; const int kb = r / NB_IN, nb = r % NB_IN; const int n0 = 32 * nb;
            const int dst = n0 < 512 ? (n0 & ~255) + 128 * ((n0 >> 5) & 1) + 32 * ((n0 >> 6) & 3) : n0;
            transpose_item(p.w_in + (size_t)l * D * IN_W, IN_W, p.WIN_T, D, 64 * kb, n0, dst, scr, lane); continue; } r -= I_IN;
        if (r < I_OUT) { if (!(mask & 2)) continue; const int kb = r / (D / 32), nb = r % (D / 32); transpose_item(p.w_out + (size_t)l * D * D, D, p.WOUT_T, D, 64 * kb, 32 * nb, 32 * nb, scr, lane); continue; } r -= I_OUT;
        if (r < 2 * I_G) { if (!(mask & 4)) continue; const int s = r / I_G; r -= s * I_G; const int kb = r / (FFN / 32), nb = r % (FFN / 32); const int n0 = 32 * nb;
            transpose_item((s ? p.w_u : p.w_g) + (size_t)l * D * FFN, FFN, p.WGU_T, D, 64 * kb, n0, 256 * (n0 / 128) + 128 * s + (n0 % 128), scr, lane); continue; } r -= 2 * I_G;
        if (mask & 8) { const int kb = r / (D / 32), nb = r % (D / 32); transpose_item(p.w_d + (size_t)l * FFN * D, D, p.WD_T, FFN, 64 * kb, 32 * nb, 32 * nb, scr, lane); }
    }
    if (mask & 1) { const int tot = (NPAD_IN - IN_W) * D / 8; v4u z = {0u, 0u, 0u, 0u};
      for (int i = gw * 64 + lane; i < tot; i += NGW * 64) *(GAS v4u*)(p.WIN_T + (size_t)IN_W * D + (size_t)i * 8) = z; }
}

#ifndef NOGLA
#define NOGLA 0
#endif
struct Args { Params p; int ph_lo, ph_hi; };
constexpr int PH_PER_LAYER = 9, N_PHASES = 1 + DEPTH * PH_PER_LAYER;

struct Ctx { LAS unsigned char* lds; long gtid, gsize; int gw, NGW, wave, lane, G; };
__device__ __forceinline__ Ctx make_ctx(LAS unsigned char* lds) {
    int tid = threadIdx.x; asm volatile("" : "+v"(tid));
    Ctx c; c.lds = lds; c.lane = tid & 63; c.wave = __builtin_amdgcn_readfirstlane(tid >> 6); c.G = gridDim.x;
    c.gtid = (long)blockIdx.x * NTHREADS + tid; c.gsize = (long)c.G * NTHREADS; c.gw = blockIdx.x * NWAVES + c.wave; c.NGW = c.G * NWAVES; return c; }

template <int PH> __device__ __forceinline__ void run_phase(const Params& p, LAS unsigned char* lds_) {
    const Ctx c = make_ctx(lds_);
    if constexpr (PH == 0) {
        unsigned* ctlw = (unsigned*)(p.ws + WS_CTL); constexpr int NPROD = 2 * D / 64;
        ph_mod_fast(p, c.lds, (int)blockIdx.x, c.G, ctlw + CW_SPLIT + 192, NPROD); ph_rope_table(p, c.gtid, c.gsize);
        __syncthreads();
        ph_weights(p, 0, c.lds, c.gw, c.NGW, c.wave, c.lane);
        if (c.wave == 0 && c.lane == 0) { XB_SPIN(xb_ld(ctlw + CW_SPLIT + 192) < (unsigned)NPROD, ctlw + CW_BAR); __builtin_amdgcn_fence(__ATOMIC_ACQUIRE, "agent"); asm volatile("s_waitcnt vmcnt(0)" ::: "memory"); }
        __syncthreads();
        ph_norm_fast(p, 0, 0, true, M, c.gw, c.NGW, c.lane);
    } else {
        constexpr int l = (PH - 1) / PH_PER_LAYER, s = (PH - 1) % PH_PER_LAYER;
        constexpr bool wc = l < DEPTH - 1; constexpr int mrows = wc ? M : ML;
        const float* modl = p.MOD + (size_t)l * (BATCH + 1) * 6 * D;
        if constexpr (s == 0) {
        }
        if constexpr (s == 1) { pg8::Gemm g{p.XN, p.WIN_T, M, NPAD_IN, D}; pg8::StaticOrder S; S.init(M, NPAD_IN, c.G, (int)blockIdx.x);
            if constexpr (l == 0) { pg8::EpiInprojPost<false> E{p.P, p.AFB, p.SS1, p.B2IN, NPAD_IN, p.qn_a + l * 64, p.kn_a + l * 64, p.qn_b + l * 32, p.kn_b + l * 32, p.ROPE};
                pg8::gemm_phase<pg8::EpiInprojPost<false>, pg8::StaticOrder, true, true>(c.lds + RING_OFF, g, S, E); }
            else { pg8::EpiInprojPost<true> E{p.P, p.AFB, p.SS1, p.B2IN, NPAD_IN, p.qn_a + l * 64, p.kn_a + l * 64, p.qn_b + l * 32, p.kn_b + l * 32, p.ROPE};
                pg8::gemm_phase<pg8::EpiInprojPost<true>, pg8::StaticOrder, true, true>(c.lds + RING_OFF, g, S, E); } }
        if constexpr (s == 2) { for (long i = c.gtid; i < M; i += c.gsize) { p.SS2[i] = 0.f; if (l == 0) p.SS1[i] = 0.f; }
            { if constexpr (l > 0) ph_weights(p, l, c.lds, c.gw, c.NGW, c.wave, c.lane, 8); ph_bias2(p.WGU_T, 2 * FFN, modl + 3 * D, p.B2GU, c.gw, c.NGW, c.lane); __syncthreads(); }
            ph_gla_A(p, l, c.lds, (int)blockIdx.x, c.G);
#ifdef REP_A
            __syncthreads(); ph_gla_A(p, l, c.lds, (int)blockIdx.x, c.G); __syncthreads();
#endif
            ph_na_fast(p, l, wc, c.lds, (int)blockIdx.x, c.G);
#ifdef REP_NA
            __syncthreads(); ph_na_fast(p, l, wc, c.lds, (int)blockIdx.x, c.G);
#endif
            }
        if constexpr (s == 3) { ph_gla_B(p, (int)blockIdx.x, c.G);
#ifdef REP_B
            __syncthreads(); ph_gla_B(p, (int)blockIdx.x, c.G); __syncthreads(); ph_gla_B(p, (int)blockIdx.x, c.G);
#endif
            ph_diff_fast(p, l, wc, c.lds, (int)blockIdx.x, c.G);
#ifdef REP_DIFF
            __syncthreads(); ph_diff_fast<REP_DIFF>(p, l, wc, c.lds, (int)blockIdx.x, c.G);
#endif
        }
        if constexpr (s == 4) ph_gla_C(p, l, wc, c.lds, (int)blockIdx.x, c.G);
        if constexpr (s == 5) { pg8::Gemm g{p.XN, p.WOUT_T, mrows, D, D};
                      typedef pg8::EpiResidT<true, (l > 0), true> EpiO;
                      EpiO E{p.x, p.ctx, p.out, p.HC, modl + 2 * D, p.XN2, p.norm2 + (size_t)l * D, modl + 4 * D, p.SS2, (const bf16*)p.out, p.HB};
                      constexpr int ntl = ((mrows / 256) * (D / 256)) % 256;
                      if constexpr (ntl > 0 && ntl * SPLITK <= 256) { pg8::SplitTailOrder<SPLITK> S; S.init(mrows, D, D, c.G, (int)blockIdx.x, (float*)(p.ws + WS_R2), (unsigned*)(p.ws + WS_CTL) + CW_SPLIT, (volatile LAS unsigned*)(c.lds + MISC_OFF) + 12);
                          pg8::gemm_phase<EpiO, pg8::SplitTailOrder<SPLITK>, true, true>(c.lds + RING_OFF, g, S, E); }
                      else { pg8::StaticOrder S; S.init(mrows, D, c.G, (int)blockIdx.x); pg8::gemm_phase<EpiO, pg8::StaticOrder, true, true>(c.lds + RING_OFF, g, S, E); }
                      if constexpr (l + 1 < DEPTH) { constexpr int nfull = (ntl > 0 && ntl * SPLITK <= 256) ? ntl * SPLITK : ntl;
                          __syncthreads(); if ((int)blockIdx.x >= nfull && c.G == 256) ph_weights(p, l + 1, c.lds, ((int)blockIdx.x - nfull) * NWAVES + c.wave, (c.G - nfull) * NWAVES, c.wave, c.lane, 1);
                          else if (c.G != 256) ph_weights(p, l + 1, c.lds, c.gw, c.NGW, c.wave, c.lane, 1); } }
        if constexpr (s == 6) { pg8::Gemm g{p.XN2, p.WGU_T, mrows, 2 * FFN, D}; pg8::StaticOrder S; S.init(mrows, 2 * FFN, c.G, (int)blockIdx.x);
                      pg8::EpiGU E{p.ACT, p.EA, p.EU, p.conv_w + (size_t)l * 3 * FFN, p.conv_b + (size_t)l * FFN, p.SS2, p.B2GU};
                      pg8::gemm_phase<pg8::EpiGU, pg8::StaticOrder, true, true>(c.lds + RING_OFF, g, S, E); }
        if constexpr (s == 7) {
#ifdef OLD_FIX_PHASE
            ph_ffn_fix(p, l, mrows, c.gtid, c.gsize);
#endif
#ifdef CAL_VALU
            if constexpr (l == 0) { float a[16]; _Pragma("unroll") for (int i = 0; i < 16; ++i) a[i] = (float)(c.lane + i);
                for (int it = 0; it < CAL_VALU; ++it) { _Pragma("unroll") for (int i = 0; i < 16; ++i) a[i] = __builtin_fmaf(a[i], 1.0001f, 0.5f); asm volatile("" : "+v"(a[0]), "+v"(a[1]), "+v"(a[2]), "+v"(a[3])); }
                float sacc = 0.f; _Pragma("unroll") for (int i = 0; i < 16; ++i) sacc += a[i]; if (sacc == 1.2345f) p.SS2[0] = sacc; }
#endif
#ifdef CAL_MFMA
            if constexpr (l == 0) { f32x16 acc0, acc1; _Pragma("unroll") for (int i = 0; i < 16; ++i) { acc0[i] = 0.f; acc1[i] = 0.f; }
                bf16x8 av = {(short)c.lane, 1, 2, 3, 4, 5, 6, 7}, bv = {1, 2, 3, 4, 5, 6, 7, (short)c.lane};
                for (int it = 0; it < CAL_MFMA; ++it) { _Pragma("unroll") for (int i = 0; i < 4; ++i) { acc0 = MFMA32(av, bv, acc0); acc1 = MFMA32(bv, av, acc1); } }
                if (acc0[0] + acc1[3] == 1.2345f) p.SS2[0] = acc0[0]; }
#endif
        }
#define FIX_MY_TILES(SCHED) do { int last_pm_ = -1; pg8::Unit uu_; for (int i_ = 0; (SCHED).next(i_, uu_); ++i_) if (uu_.pm != last_pm_) { ffn_fix_rowtile(p, l, uu_.pm, c.wave * 64 + c.lane); last_pm_ = uu_.pm; } \
            asm volatile("s_waitcnt vmcnt(0)" ::: "memory"); __syncthreads(); } while (0)
        if constexpr (s == 8) { pg8::Gemm g{p.ACT, p.WD_T, mrows, D, FFN}; pg8::StaticOrder S; S.init(mrows, D, c.G, (int)blockIdx.x);
                      if constexpr (l + 1 < DEPTH) { const float* modn = p.MOD + (size_t)(l + 1) * (BATCH + 1) * 6 * D;
                          typedef pg8::EpiResidT<true, true, true> EpiD;
                          EpiD E{p.out, p.HC, p.out, p.HC, modl + 5 * D, p.XN, p.norm1 + (size_t)(l + 1) * D, modn + 1 * D, p.SS1, p.HB, (bf16*)p.out};
                          constexpr int ntl = ((mrows / 256) * (D / 256)) % 256;
                          if constexpr (ntl > 0 && ntl * SPLITK <= 256) { pg8::SplitTailOrder<SPLITK> S2; S2.init(mrows, D, FFN, c.G, (int)blockIdx.x, (float*)(p.ws + WS_XN2), (unsigned*)(p.ws + WS_CTL) + CW_SPLIT + 64, (volatile LAS unsigned*)(c.lds + MISC_OFF) + 12);
                              FIX_MY_TILES(S2); pg8::gemm_phase<EpiD, pg8::SplitTailOrder<SPLITK>, true, true>(c.lds + RING_OFF, g, S2, E); }
                          else { FIX_MY_TILES(S); pg8::gemm_phase<EpiD, pg8::StaticOrder, true, true>(c.lds + RING_OFF, g, S, E); }
                          constexpr int nfull = (ntl > 0 && ntl * SPLITK <= 256) ? ntl * SPLITK : ntl;
                          __syncthreads(); if ((int)blockIdx.x >= nfull && c.G == 256) { ph_weights(p, l + 1, c.lds, ((int)blockIdx.x - nfull) * NWAVES + c.wave, (c.G - nfull) * NWAVES, c.wave, c.lane, 6);
                              ph_bias2(p.WIN_T, NPAD_IN, modn + 0 * D, p.B2IN, ((int)blockIdx.x - nfull) * NWAVES + c.wave, (c.G - nfull) * NWAVES, c.lane); }
                          else if (c.G != 256) { ph_weights(p, l + 1, c.lds, c.gw, c.NGW, c.wave, c.lane, 6); ph_bias2(p.WIN_T, NPAD_IN, modn + 0 * D, p.B2IN, c.gw, c.NGW, c.lane); } }
                      else { typedef pg8::EpiResidT<false, true, false> EpiD;
                          EpiD E{p.out, p.HC, p.out, p.HC, modl + 5 * D, nullptr, nullptr, nullptr, nullptr, p.HB, nullptr};
                          FIX_MY_TILES(S); pg8::gemm_phase<EpiD, pg8::StaticOrder, true, true>(c.lds + RING_OFF, g, S, E); } }
#undef FIX_MY_TILES
    }
}

template <int PH> __device__ __forceinline__ void run_from(const Params& p, LAS unsigned char* c, const XcdBarrier& bar, int lo, int hi) {
    if constexpr (PH < N_PHASES) {
        constexpr bool EMPTY_PH = (PH > 0 && ((PH - 1) % PH_PER_LAYER) == 0) || (PH > 0 && ((PH - 1) % PH_PER_LAYER) == 7);
        if (lo <= PH && PH < hi && !EMPTY_PH) { run_phase<PH>(p, c);
#ifdef REP_S
            if constexpr ((PH > 0 && ((PH - 1) % PH_PER_LAYER) == REP_S) || (PH == 0 && REP_S == 9)) { xcd_barrier(bar);
#ifdef REP_NOSTORE
                { const Ctx cc = make_ctx(c); pg8::Gemm g{p.XN, p.WIN_T, M, NPAD_IN, D}; pg8::StaticOrder S; S.init(M, NPAD_IN, cc.G, (int)blockIdx.x);
                  pg8::EpiInprojT<true> E{(bf16*)(p.ws + WS_R2 + 140 * MiB), p.AFB}; pg8::gemm_phase<pg8::EpiInprojT<true>, pg8::StaticOrder, true, true>(cc.lds + RING_OFF, g, S, E); }
#else
                run_phase<PH>(p, c);
#endif
            }
#endif
            if (PH + 1 < hi) xcd_barrier(bar); }
        run_from<PH + 1>(p, c, bar, lo, hi);
    }
}

#ifdef PHASE_PROBE
template <int PH> __global__ void __launch_bounds__(NTHREADS, 2) k_probe(Args args) {
    extern __shared__ __attribute__((aligned(16))) unsigned char lds_raw[];
    run_phase<PH>(args.p, (LAS unsigned char*)lds_raw);
}
template __global__ void k_probe<0>(Args); template __global__ void k_probe<1>(Args); template __global__ void k_probe<2>(Args); template __global__ void k_probe<3>(Args);
template __global__ void k_probe<4>(Args); template __global__ void k_probe<5>(Args); template __global__ void k_probe<6>(Args); template __global__ void k_probe<7>(Args);
template __global__ void k_probe<8>(Args); template __global__ void k_probe<9>(Args); template __global__ void k_probe<12>(Args); template __global__ void k_probe<13>(Args);
#endif

__global__ void __launch_bounds__(NTHREADS, 2) mk_fwd(Args args) {
    extern __shared__ __attribute__((aligned(16))) unsigned char lds_raw[];
    LAS unsigned char* lds = (LAS unsigned char*)lds_raw;
    const Params& p = args.p;
    const int tid = threadIdx.x;
    volatile LAS unsigned* MISC = (volatile LAS unsigned*)(lds + MISC_OFF);
    for (int u = tid; u < (LDS_BYTES - LDSCTL_OFF) / 4; u += NTHREADS) ((LAS unsigned*)(lds + LDSCTL_OFF))[u] = 0u;
    __syncthreads();
    gu32* ctl = (gu32*)(p.ws + WS_CTL);
    XcdBarrier bar = xcd_barrier_post((unsigned*)(ctl + CW_BAR), MISC + 8);
    run_from<0>(p, lds, bar, args.ph_lo, args.ph_hi);
}

#ifndef MK_MULTI
#define MK_MULTI 0
#endif
extern "C" void kernel_launch(void* const* d_in, const int* in_sizes, int n_in, void* d_out, int out_size, void* d_ws, size_t ws_size, hipStream_t stream) {
    static int grid = 0;
    if (grid == 0) {
        if (n_in != 30 || in_sizes[0] != ML * D || out_size != ML * D || ws_size < WS_END) { fprintf(stderr, "kernel_launch: unexpected shapes: n_in %d in0 %d out %d ws %zu (need %zu)\n", n_in, n_in > 0 ? in_sizes[0] : -1, out_size, ws_size, (size_t)WS_END); grid = -1; return; }
        int dev = 0, cus = 0, per_cu = 0;
        if (hipGetDevice(&dev) != hipSuccess || hipDeviceGetAttribute(&cus, hipDeviceAttributeMultiprocessorCount, dev) != hipSuccess) { grid = -1; return; }
        if (hipFuncSetAttribute((const void*)mk_fwd, hipFuncAttributeMaxDynamicSharedMemorySize, LDS_BYTES) != hipSuccess) { fprintf(stderr, "kernel_launch: hipFuncSetAttribute failed\n"); grid = -1; return; }
        if (hipOccupancyMaxActiveBlocksPerMultiprocessor(&per_cu, (const void*)mk_fwd, NTHREADS, LDS_BYTES) != hipSuccess || per_cu < 1) { fprintf(stderr, "kernel_launch: occupancy query reports %d workgroups per CU; nothing launched\n", per_cu); (void)hipGetLastError(); grid = -1; return; }
        (void)hipGetLastError();
        grid = cus;
    }
    if (grid < 0) return;
    if (hipMemsetAsync((char*)d_ws + WS_CTL, 0, CTL_ZERO_BYTES, stream) != hipSuccess) { fprintf(stderr, "kernel_launch: memset failed\n"); return; }
    Args a; memset(&a, 0, sizeof(a));
    Params& p = a.p;
    const float* const* in = (const float* const*)d_in;
    p.x = in[0]; p.c = in[1]; p.ctx = in[2]; p.c_ctx = in[3]; p.norm1 = in[4]; p.norm2 = in[5]; p.w_ada = in[6]; p.b_ada = in[7]; p.w_in = in[8];
    p.qn_a = in[9]; p.kn_a = in[10]; p.rpb_a = in[11]; p.qn_b = in[12]; p.kn_b = in[13]; p.lam_q1 = in[14]; p.lam_k1 = in[15]; p.lam_q2 = in[16]; p.lam_k2 = in[17];
    p.subln_b = in[18]; p.w_a2_f = in[19]; p.b_a_f = in[20]; p.w_a2_b = in[21]; p.b_a_b = in[22]; p.onorm_c = in[23]; p.w_out = in[24]; p.w_g = in[25]; p.w_u = in[26];
    p.conv_w = in[27]; p.conv_b = in[28]; p.w_d = in[29];
    unsigned char* ws = (unsigned char*)d_ws;
    p.out = (float*)d_out; p.ws = ws;
    p.MOD = (float*)(ws + WS_MOD); p.ROPE = (float*)(ws + WS_ROPE); p.HC = (float*)(ws + WS_HC); p.XN = (bf16*)(ws + WS_XN); p.AFB = (bf16*)(ws + WS_AFB);
    p.P = (bf16*)(ws + WS_R1); p.GU = (bf16*)(ws + WS_R1); p.GO = (float*)(ws + WS_GO); p.ALF = (float*)(ws + WS_ALF); p.ALB = (float*)(ws + WS_ALB); p.DT = (float*)(ws + WS_DT); p.US = (float*)(ws + WS_US); p.EA = (bf16*)(ws + WS_EA); p.EU = (bf16*)(ws + WS_EU); p.XN2 = (bf16*)(ws + WS_XN2); p.HB = (bf16*)(ws + WS_HB); p.SS1 = (float*)(ws + WS_SS1); p.SS2 = (float*)(ws + WS_SS2); p.B2IN = (float*)(ws + WS_B2IN); p.B2GU = (float*)(ws + WS_B2GU); p.AD = (float*)(ws + WS_AD); p.ACT = (bf16*)(ws + WS_R2);
    p.WIN_T = (bf16*)(ws + WS_WIN); p.WOUT_T = (bf16*)(ws + WS_WOUT); p.WGU_T = (bf16*)(ws + WS_WGU); p.WD_T = (bf16*)(ws + WS_WD);
#if MK_MULTI
    for (int ph = 0; ph < N_PHASES; ++ph) { a.ph_lo = ph; a.ph_hi = ph + 1; hipLaunchKernelGGL(mk_fwd, dim3(grid), dim3(NTHREADS), LDS_BYTES, stream, a); }
#else
    a.ph_lo = 0; a.ph_hi = N_PHASES;
    hipLaunchKernelGGL(mk_fwd, dim3(grid), dim3(NTHREADS), LDS_BYTES, stream, a);
#endif
    const hipError_t le = hipPeekAtLastError();
    if (le != hipSuccess) fprintf(stderr, "kernel_launch: launch failed: %s\n", hipGetErrorName(le));
}
```
